# Optimizing an MI355X kernel written in HIP

```python
import math
import jax, jax.numpy as jnp
from jax import lax
import numpy as np

D_MODEL = 1024
BATCH = 8
SEQ = 2048
DEPTH = 4

GRID_W = 64
CTX_LEN = 256
N_MIXERS = 4
EPS = 1e-6
ROPE_THETA = 10000.0
Q_BLOCK = 128

FNET_GROUPS = 8
FNET_GROUP_DIM = D_MODEL // FNET_GROUPS
DIFF_HEAD_DIM = 64
DIFF_HEADS = D_MODEL // (2 * DIFF_HEAD_DIM)
HGRN_EXPAND = 128
HGRN_HEADS = D_MODEL // HGRN_EXPAND
HGRN_HEAD_V = D_MODEL // HGRN_HEADS
HGRN_FORGET_DIM = HGRN_HEADS * HGRN_EXPAND
HGRN_CHUNK = 64
GQA_HEAD_DIM = 128
GQA_Q_HEADS = D_MODEL // GQA_HEAD_DIM
GQA_KV_HEADS = 2
GQA_GROUP = GQA_Q_HEADS // GQA_KV_HEADS
D_FF = -(-8 * D_MODEL // (3 * 256)) * 256
N_FNET_LAYERS = len(range(0, DEPTH, N_MIXERS))
N_DIFF_LAYERS = len(range(1, DEPTH, N_MIXERS))
N_HGRN_LAYERS = len(range(2, DEPTH, N_MIXERS))
N_GQA_LAYERS = len(range(3, DEPTH, N_MIXERS))

kernel_name = 'hybrid_interleaved_dit_trunk'


def rms_norm(x, gain):
    xf = x.astype(jnp.float32)
    y = xf * lax.rsqrt(jnp.mean(xf * xf, axis=-1, keepdims=True) + EPS)
    return (y * gain.astype(jnp.float32)).astype(x.dtype)


def modulate(h, shift, scale):
    return h * (1.0 + scale) + shift


def swiglu(h, w_in, w_out):
    gate, up = jnp.split(h @ w_in, 2, axis=-1)
    return (jax.nn.silu(gate) * up) @ w_out


def axial_rope_tables(rows, head_dim):
    row = jnp.repeat(jnp.arange(rows, dtype=jnp.float32), GRID_W)
    col = jnp.tile(jnp.arange(GRID_W, dtype=jnp.float32), rows)
    n_freq = head_dim // 4
    inv_freq = ROPE_THETA ** (-jnp.arange(n_freq, dtype=jnp.float32) / n_freq)
    ang = jnp.concatenate([row[:, None] * inv_freq, col[:, None] * inv_freq], axis=-1)
    return jnp.cos(ang), jnp.sin(ang)


def apply_rope(x, cos, sin):
    shape = (cos.shape[0],) + (1,) * (x.ndim - 3) + (cos.shape[1],)
    cos = cos.reshape(shape)
    sin = sin.reshape(shape)
    x1, x2 = jnp.split(x.astype(jnp.float32), 2, axis=-1)
    return jnp.concatenate([x1 * cos - x2 * sin, x1 * sin + x2 * cos], axis=-1).astype(x.dtype)


def sweep_query_blocks(q, attend):
    b, l = q.shape[:2]
    nb = l // Q_BLOCK
    qb = jnp.moveaxis(q.reshape((b, nb, Q_BLOCK) + q.shape[2:]), 1, 0)
    out = lax.map(attend, qb)
    return jnp.moveaxis(out, 0, 1).reshape((b, l) + out.shape[3:])


def fnet_mixer(h_lat, h_ctx, w_out, b_out, need_ctx):
    def mix(h):
        b, l, _ = h.shape
        hg = h.astype(jnp.float32).reshape(b, l, FNET_GROUPS, FNET_GROUP_DIM)
        y = jnp.fft.fftn(hg, axes=(1, 3), norm='ortho').real
        return y.reshape(b, l, D_MODEL).astype(h.dtype) @ w_out + b_out
    return mix(h_lat), (mix(h_ctx) if need_ctx else None)


def diff_attn_core(q, k, v, lam):
    s = jnp.einsum('bqhcd,bkhcd->bhcqk', q.astype(jnp.float32), k.astype(jnp.float32)) * DIFF_HEAD_DIM ** -0.5
    p = jax.nn.softmax(s, axis=-1)
    w = p[:, :, 0] - lam * p[:, :, 1]
    return jnp.einsum('bhqk,bkhe->bqhe', w, v.astype(jnp.float32)).astype(v.dtype)


def diff_attention_mixer(h_lat, h_ctx, w_in, q_gain, k_gain, lam_par, subln_gain, w_out, layer_idx, rows, need_ctx):
    lam_init = 0.8 - 0.6 * math.exp(-0.3 * layer_idx)
    lp = lam_par.astype(jnp.float32)
    lam = jnp.exp(jnp.sum(lp[0] * lp[1])) - jnp.exp(jnp.sum(lp[2] * lp[3])) + lam_init
    cos, sin = axial_rope_tables(rows, DIFF_HEAD_DIM)

    def project(h, with_q):
        b, l, _ = h.shape
        if with_q:
            q, k, v = jnp.split(h @ w_in, 3, axis=-1)
            q = rms_norm(q.reshape(b, l, DIFF_HEADS, 2, DIFF_HEAD_DIM), q_gain)
        else:
            k, v = jnp.split(h @ w_in[:, D_MODEL:], 2, axis=-1)
            q = None
        k = rms_norm(k.reshape(b, l, DIFF_HEADS, 2, DIFF_HEAD_DIM), k_gain)
        return q, k, v.reshape(b, l, DIFF_HEADS, 2 * DIFF_HEAD_DIM)

    def finish(o):
        b, l = o.shape[:2]
        o = rms_norm(o, subln_gain) * (1.0 - lam_init)
        return o.reshape(b, l, D_MODEL) @ w_out

    q_c, k_c, v_c = project(h_ctx, need_ctx)
    q_l, k_l, v_l = project(h_lat, True)
    q_l = apply_rope(q_l, cos, sin)
    k_l = apply_rope(k_l, cos, sin)
    k_all = jnp.concatenate([k_c, k_l], axis=1)
    v_all = jnp.concatenate([v_c, v_l], axis=1)
    o_lat = finish(sweep_query_blocks(q_l, lambda qb: diff_attn_core(qb, k_all, v_all, lam)))
    o_ctx = finish(diff_attn_core(q_c, k_c, v_c, lam)) if need_ctx else None
    return o_lat, o_ctx


def gla_chunk_scan(q, k, v, log_f, s0):
    b, l, h, dk = q.shape
    dv = v.shape[-1]
    n = l // HGRN_CHUNK

    def chunks(t):
        return jnp.moveaxis(t.reshape((b, n, HGRN_CHUNK) + t.shape[2:]), 1, 0)

    lower = jnp.tril(jnp.ones((HGRN_CHUNK, HGRN_CHUNK), dtype=bool))[None, :, :, None, None]

    def step(s, inp):
        qc, kc, vc, gc = inp
        bc = jnp.cumsum(gc, axis=1)
        decay = jnp.exp(jnp.where(lower, bc[:, :, None] - bc[:, None, :], -jnp.inf))
        scores = jnp.einsum('bthk,bshk,btshk->bhts', qc, kc, decay)
        o = jnp.einsum('bhts,bshv->bthv', scores, vc) + jnp.einsum('bthk,bhkv->bthv', qc * jnp.exp(bc), s)
        b_last = bc[:, -1]
        s = jnp.exp(b_last)[..., None] * s + jnp.einsum('bshk,bshv->bhkv', kc * jnp.exp(b_last[:, None] - bc), vc)
        return s, o

    s_fin, o = lax.scan(step, s0, (chunks(q), chunks(k), chunks(v), chunks(log_f)))
    return jnp.moveaxis(o, 0, 1).reshape(b, l, h, dv), s_fin


def hgrn2_mixer(h_lat, h_ctx, w_in, lower_bound, norm_gain, w_out, layer_idx, need_ctx):
    lbs = jnp.cumsum(jax.nn.softmax(lower_bound.astype(jnp.float32), axis=1), axis=1)
    lb = (lbs[:, layer_idx] - lbs[:, 0]).reshape(2, HGRN_HEADS, HGRN_EXPAND)

    def project(h):
        b, l, _ = h.shape
        q, z_fwd, z_bwd, v, g = jnp.split(h @ w_in, 5, axis=-1)
        q = jax.nn.silu(q).reshape(b, l, HGRN_HEADS, HGRN_EXPAND).astype(jnp.float32)
        v = v.reshape(b, l, HGRN_HEADS, HGRN_HEAD_V).astype(jnp.float32)
        log_f = [jnp.log(lb[d] + (1.0 - lb[d]) * jax.nn.sigmoid(z.reshape(b, l, HGRN_HEADS, HGRN_EXPAND).astype(jnp.float32)))
                 for d, z in enumerate((z_fwd, z_bwd))]
        return q, v, log_f, g

    def run(q, v, lf, s0, reverse):
        if reverse:
            q, v, lf = jnp.flip(q, 1), jnp.flip(v, 1), jnp.flip(lf, 1)
        o, s = gla_chunk_scan(q, -jnp.expm1(lf), v, lf, s0)
        return (jnp.flip(o, 1) if reverse else o), s

    def finish(o, g):
        b, l = o.shape[:2]
        o = rms_norm(o, norm_gain) * jax.nn.silu(g.reshape(b, l, HGRN_HEADS, HGRN_HEAD_V).astype(jnp.float32))
        return o.reshape(b, l, D_MODEL).astype(g.dtype) @ w_out

    q_c, v_c, lf_c, g_c = project(h_ctx)
    q_l, v_l, lf_l, g_l = project(h_lat)
    s0 = jnp.zeros((h_ctx.shape[0], HGRN_HEADS, HGRN_EXPAND, HGRN_HEAD_V), jnp.float32)
    o_ctx_f, s_ctx_f = run(q_c, v_c, lf_c[0], s0, False)
    o_ctx_b, s_ctx_b = run(q_c, v_c, lf_c[1], s0, True)
    o_lat_f, _ = run(q_l, v_l, lf_l[0], s_ctx_f, False)
    o_lat_b, _ = run(q_l, v_l, lf_l[1], s_ctx_b, True)
    o_lat = finish(o_lat_f + o_lat_b, g_l)
    o_ctx = finish(o_ctx_f + o_ctx_b, g_c) if need_ctx else None
    return o_lat, o_ctx


def gqa_core(q, k, v):
    s = jnp.einsum('bqhgd,bkhd->bhgqk', q.astype(jnp.float32), k.astype(jnp.float32)) * GQA_HEAD_DIM ** -0.5
    p = jax.nn.softmax(s, axis=-1)
    return jnp.einsum('bhgqk,bkhd->bqhgd', p, v.astype(jnp.float32)).astype(v.dtype)


def gqa_mixer(h_lat, h_ctx, w_in, q_gain, k_gain, w_out, rows, need_ctx):
    qd = GQA_Q_HEADS * GQA_HEAD_DIM
    cos, sin = axial_rope_tables(rows, GQA_HEAD_DIM)

    def project(h, with_q):
        b, l, _ = h.shape
        if with_q:
            q, kv = jnp.split(h @ w_in, [qd], axis=-1)
            q = rms_norm(q.reshape(b, l, GQA_KV_HEADS, GQA_GROUP, GQA_HEAD_DIM), q_gain)
        else:
            kv = h @ w_in[:, qd:]
            q = None
        k, v = jnp.split(kv, 2, axis=-1)
        k = rms_norm(k.reshape(b, l, GQA_KV_HEADS, GQA_HEAD_DIM), k_gain)
        return q, k, v.reshape(b, l, GQA_KV_HEADS, GQA_HEAD_DIM)

    def finish(o):
        b, l = o.shape[:2]
        return o.reshape(b, l, D_MODEL) @ w_out

    q_c, k_c, v_c = project(h_ctx, need_ctx)
    q_l, k_l, v_l = project(h_lat, True)
    q_l = apply_rope(q_l, cos, sin)
    k_l = apply_rope(k_l, cos, sin)
    k_all = jnp.concatenate([k_c, k_l], axis=1)
    v_all = jnp.concatenate([v_c, v_l], axis=1)
    o_lat = finish(sweep_query_blocks(q_l, lambda qb: gqa_core(qb, k_all, v_all)))
    o_ctx = finish(gqa_core(q_c, k_c, v_c)) if need_ctx else None
    return o_lat, o_ctx


def setup_inputs(seed: int = 0) -> dict:
    key = jax.random.key(seed)
    ks = iter(jax.random.split(key, 32))
    D = D_MODEL

    def nrm(shape, scale):
        return jax.random.normal(next(ks), shape, jnp.float32) * scale

    def gain(shape):
        return 1.0 + nrm(shape, 0.05)

    return {
        'x': nrm((BATCH, SEQ, D), 1.0),
        'c': nrm((BATCH, D), 1.0),
        'ctx': nrm((BATCH, CTX_LEN, D), 1.0),
        'c_ctx': nrm((D,), 1.0),
        'w_ada': nrm((DEPTH, D, 6 * D), 0.5 * D ** -0.5),
        'b_ada': nrm((DEPTH, 6 * D), 0.02),
        'norm_gain': gain((DEPTH, 2, D)),
        'ffn_w_in': nrm((DEPTH, D, 2 * D_FF), D ** -0.5),
        'ffn_w_out': nrm((DEPTH, D_FF, D), D_FF ** -0.5),
        'fnet_w_out': nrm((N_FNET_LAYERS, D, D), D ** -0.5),
        'fnet_b_out': nrm((N_FNET_LAYERS, D), 0.02),
        'diff_w_in': nrm((N_DIFF_LAYERS, D, 3 * D), D ** -0.5),
        'diff_q_gain': gain((N_DIFF_LAYERS, 2, DIFF_HEAD_DIM)),
        'diff_k_gain': gain((N_DIFF_LAYERS, 2, DIFF_HEAD_DIM)),
        'diff_lambda': nrm((N_DIFF_LAYERS, 4, DIFF_HEAD_DIM), 0.1),
        'diff_subln_gain': gain((N_DIFF_LAYERS, 2 * DIFF_HEAD_DIM)),
        'diff_w_out': nrm((N_DIFF_LAYERS, D, D), D ** -0.5),
        'hgrn_w_in': nrm((N_HGRN_LAYERS, D, 5 * D), D ** -0.5),
        'hgrn_lower_bound': nrm((2, DEPTH, HGRN_FORGET_DIM), 1.0),
        'hgrn_norm_gain': gain((N_HGRN_LAYERS, HGRN_HEAD_V)),
        'hgrn_w_out': nrm((N_HGRN_LAYERS, D, D), D ** -0.5),
        'gqa_w_in': nrm((N_GQA_LAYERS, D, (GQA_Q_HEADS + 2 * GQA_KV_HEADS) * GQA_HEAD_DIM), D ** -0.5),
        'gqa_q_gain': gain((N_GQA_LAYERS, GQA_HEAD_DIM)),
        'gqa_k_gain': gain((N_GQA_LAYERS, GQA_HEAD_DIM)),
        'gqa_w_out': nrm((N_GQA_LAYERS, D, D), D ** -0.5),
    }


def reference(x, c, ctx, c_ctx, w_ada, b_ada, norm_gain, ffn_w_in, ffn_w_out, fnet_w_out, fnet_b_out,
              diff_w_in, diff_q_gain, diff_k_gain, diff_lambda, diff_subln_gain, diff_w_out,
              hgrn_w_in, hgrn_lower_bound, hgrn_norm_gain, hgrn_w_out,
              gqa_w_in, gqa_q_gain, gqa_k_gain, gqa_w_out):
    rows = x.shape[1] // GRID_W
    cond_lat = jax.nn.silu(c)[:, None, :]
    cond_ctx = jax.nn.silu(c_ctx)[None, None, :]
    for i in range(DEPTH):
        m, j = i % N_MIXERS, i // N_MIXERS
        need_ctx = i < DEPTH - 1
        sh1, sc1, g1, sh2, sc2, g2 = jnp.split(cond_lat @ w_ada[i] + b_ada[i], 6, axis=-1)
        csh1, csc1, cg1, csh2, csc2, cg2 = jnp.split(cond_ctx @ w_ada[i] + b_ada[i], 6, axis=-1)
        h_lat = modulate(rms_norm(x, norm_gain[i, 0]), sh1, sc1)
        h_ctx = modulate(rms_norm(ctx, norm_gain[i, 0]), csh1, csc1) if (need_ctx or m != 0) else None
        if m == 0:
            o_lat, o_ctx = fnet_mixer(h_lat, h_ctx, fnet_w_out[j], fnet_b_out[j], need_ctx)
        elif m == 1:
            o_lat, o_ctx = diff_attention_mixer(h_lat, h_ctx, diff_w_in[j], diff_q_gain[j], diff_k_gain[j], diff_lambda[j],
                                                diff_subln_gain[j], diff_w_out[j], i, rows, need_ctx)
        elif m == 2:
            o_lat, o_ctx = hgrn2_mixer(h_lat, h_ctx, hgrn_w_in[j], hgrn_lower_bound, hgrn_norm_gain[j], hgrn_w_out[j], i, need_ctx)
        else:
            o_lat, o_ctx = gqa_mixer(h_lat, h_ctx, gqa_w_in[j], gqa_q_gain[j], gqa_k_gain[j], gqa_w_out[j], rows, need_ctx)
        x = x + g1 * o_lat
        x = x + g2 * swiglu(modulate(rms_norm(x, norm_gain[i, 1]), sh2, sc2), ffn_w_in[i], ffn_w_out[i])
        if need_ctx:
            ctx = ctx + cg1 * o_ctx
            ctx = ctx + cg2 * swiglu(modulate(rms_norm(ctx, norm_gain[i, 1]), csh2, csc2), ffn_w_in[i], ffn_w_out[i])
    return x
```

```cpp
#include <hip/hip_runtime.h>
#include <hip/hip_cooperative_groups.h>
#include <cstdint>
#include <cstdio>
namespace cg = cooperative_groups;

#define DI __device__ __forceinline__
#ifndef PHMASK
#define PHMASK 0xFFFF
#endif
#define PH(bit) if ((PHMASK >> (bit)) & 1)
#define OPAQUE_IDS int tx = threadIdx.x; int bx = blockIdx.x; asm volatile("" : "+v"(tx), "+s"(bx));
typedef unsigned short bf16_t;
typedef short bf16x8 __attribute__((ext_vector_type(8)));
typedef short s16x4 __attribute__((ext_vector_type(4)));
typedef float f32x2 __attribute__((ext_vector_type(2)));
typedef float f32x4 __attribute__((ext_vector_type(4)));
typedef float f32x16 __attribute__((ext_vector_type(16)));
typedef unsigned u32x2 __attribute__((ext_vector_type(2)));
typedef unsigned u32x4 __attribute__((ext_vector_type(4)));

constexpr int NB = 8, LC = 256, LL = 2048, LT = 2304, T = NB * LT, D = 1024, DFF = 2816;
constexpr int NTHR = 512;
constexpr int LDS_BYTES = 131072 + 16;
constexpr float EPS = 1e-6f;

constexpr size_t al256(size_t x) { return (x + 255) & ~(size_t)255; }
constexpr size_t WS_CTXRES = 0;
constexpr size_t WS_MOD    = WS_CTXRES + (size_t)NB * LC * D * 4;
constexpr size_t WS_ROPED  = WS_MOD + (size_t)4 * 9 * 6144 * 4;
constexpr size_t WS_ROPEG  = WS_ROPED + (size_t)2048 * 32 * 8;
constexpr size_t WS_LBV    = WS_ROPEG + (size_t)2048 * 64 * 8;
constexpr size_t WS_WFI    = WS_LBV + 2 * 1024 * 4;
constexpr size_t WS_WFO    = WS_WFI + (size_t)5632 * 1024 * 2;
constexpr size_t WS_WMI    = WS_WFO + (size_t)1024 * 2816 * 2;
constexpr size_t WS_WMO    = WS_WMI + (size_t)5120 * 1024 * 2;
constexpr size_t WS_H      = WS_WMO + (size_t)1024 * 1024 * 2;
constexpr size_t WS_P      = WS_H + (size_t)T * D * 2;
constexpr size_t P_PART = 0;
constexpr size_t P_CDT  = P_PART + (size_t)16 * 4 * 9 * 6144 * 4;
constexpr size_t P_WL   = P_CDT + (size_t)2048 * 1024 * 2;
constexpr size_t P_WC   = P_WL + (size_t)2048 * 4096 * 2;
constexpr size_t P_GTL  = P_WC + (size_t)256 * 512 * 2;
constexpr size_t P_GTC  = P_GTL + (size_t)NB * 1024 * 4096 * 2;
constexpr size_t P_YB   = P_GTC + (size_t)NB * 1024 * 512 * 2;
constexpr size_t P_DQK = 0;
constexpr size_t P_DVT = P_DQK + (size_t)T * 2048 * 2;
constexpr size_t P_DO2 = P_DVT + (size_t)NB * 1024 * LT * 2;
constexpr size_t P_HQ  = 0;
constexpr size_t P_HF0 = P_HQ + (size_t)T * D * 2;
constexpr size_t P_HF1 = P_HF0 + (size_t)T * D * 4;
constexpr size_t P_HV  = P_HF1 + (size_t)T * D * 4;
constexpr size_t P_HG  = P_HV + (size_t)T * D * 2;
constexpr size_t P_HOB = P_HG + (size_t)T * D * 2;
constexpr size_t P_HEND = P_HOB + (size_t)T * D * 2;
constexpr size_t P_GQK = 0;
constexpr size_t P_GVT = P_GQK + (size_t)T * 1280 * 2;
constexpr size_t P_ACT = 0;
constexpr size_t P_PARTF = P_ACT + (size_t)T * DFF * 2;
constexpr size_t P_PARTO = 0;
constexpr size_t WS_BAR = WS_P + P_HEND;
constexpr size_t WS_EB  = WS_BAR + 16384;
constexpr size_t WS_END = WS_EB + (size_t)2 * NB * 144 * D * 4;

struct Params {
    const float* in[25];
    float* out;
    unsigned char* ws;
};

DI bf16_t f2bf(float x) { unsigned u = __float_as_uint(x); u += 0x7fffu + ((u >> 16) & 1u); return (bf16_t)(u >> 16); }
DI float bf2f(bf16_t v) { return __uint_as_float(((unsigned)v) << 16); }
typedef __bf16 bf16x2_t __attribute__((ext_vector_type(2)));
DI unsigned pack2(float lo, float hi) { const f32x2 v = (f32x2){lo, hi}; return __builtin_bit_cast(unsigned, __builtin_convertvector(v, bf16x2_t)); }
DI float bflo(unsigned w) { return __uint_as_float(w << 16); }
DI float bfhi(unsigned w) { return __uint_as_float(w & 0xffff0000u); }
DI float silu_f(float x) { return x / (1.f + __expf(-x)); }
DI float sigmoid_f(float x) { return 1.f / (1.f + __expf(-x)); }
DI float wave_sum(float v) {
    v += __shfl_xor(v, 32); v += __shfl_xor(v, 16); v += __shfl_xor(v, 8); v += __shfl_xor(v, 4); v += __shfl_xor(v, 2); v += __shfl_xor(v, 1);
    return v;
}
DI float* resid_row(const Params& p, int row) {
    const int b = row / LT, pos = row - b * LT;
    return pos < LC ? (float*)(p.ws + WS_CTXRES) + ((size_t)(b * LC + pos)) * D : p.out + ((size_t)(b * LL + pos - LC)) * D;
}
DI int cond_idx(int row) { const int b = row / LT, pos = row - b * LT; return pos < LC ? 8 : b; }

constexpr int BM = 256, BK = 64, HALF = 128, HTB = HALF * BK * 2;
DI int lds_byte(int r, int c) { int st = (r >> 4) * 2 + (c >> 5), rr = r & 15, cc = c & 31, ob = rr * 64 + cc * 2; return st * 1024 + (ob ^ (((ob >> 9) & 1) << 5)); }
DI void stage_rc(int b, int& R, int& C) { int st = b / 1024, sb = b % 1024, swz = sb ^ (((sb >> 9) & 1) << 5); R = (st >> 1) * 16 + swz / 64; C = (st & 1) * 32 + (swz % 64) / 2; }

typedef f32x4 AccT[2][2][4][2];

struct Tile { const bf16_t* A; const bf16_t* Bt; int lda, ldb, K, brow, bcol; };
#define LAS __attribute__((address_space(3)))
template <class Get, class Epi>
DI void gemm_loop(int ntiles, int ld, char* shm, const Get& get, const Epi& epi) {
    int tx = threadIdx.x, bx = blockIdx.x; asm volatile("" : "+v"(tx), "+s"(bx));
    if (!((PHMASK >> 7) & 1)) return;
    LAS unsigned char* lds = (LAS unsigned char*)shm;
    const int tid = tx, wid = __builtin_amdgcn_readfirstlane(tid >> 6), lane = tid & 63, wr = wid >> 2, wc = wid & 3, fr = lane & 15, fq = lane >> 4;
    unsigned voffA[2], voffB[2];
#pragma unroll
    for (int i = 0; i < 2; ++i) { int R, C; stage_rc(tid * 16 + i * 8192, R, C); const int rho = R & 31, Rb = (R & ~31) + 8 * ((rho & 15) >> 2) + 4 * (rho >> 4) + (rho & 3);
        voffA[i] = (unsigned)(R * ld + C) * 2u; voffB[i] = (unsigned)(Rb * ld + C) * 2u; }
    const size_t kstep = (size_t)(BK * 2), hstep = (size_t)HALF * ld * 2;
    const unsigned ldsw = (unsigned)wid * 1024u;
    const int aoff = lds_byte(wr * 64 + fr, fq * 8), boff = lds_byte(wc * 32 + fr, fq * 8);
#define G_SA(b, h) (((b) * 2 + (h)) * HTB)
#define G_SB(b, h) ((4 + (b) * 2 + (h)) * HTB)
#define G_STAGE(bufoff, gbase, voff) do { _Pragma("unroll") for (int _i = 0; _i < 2; ++_i) \
        __builtin_amdgcn_global_load_lds((const unsigned*)((const char*)(gbase) + voff[_i]), (LAS unsigned*)(lds + (bufoff) + ldsw + _i * 8192), 16, 0, 0); } while (0)
#define G_LDA(dst, b, h) do { _Pragma("unroll") for (int m = 0; m < 4; ++m) _Pragma("unroll") for (int k = 0; k < 2; ++k) dst[m][k] = *(const LAS bf16x8*)(lds + G_SA(b, h) + aoff + m * 2048 + k * 1024); } while (0)
#define G_LDB(dst, b, h) do { _Pragma("unroll") for (int n = 0; n < 2; ++n) _Pragma("unroll") for (int k = 0; k < 2; ++k) dst[n][k] = *(const LAS bf16x8*)(lds + G_SB(b, h) + boff + n * 2048 + k * 1024); } while (0)
#define G_MMA(ai, bj, At_, Bt_) do { __builtin_amdgcn_s_setprio(1); _Pragma("unroll") for (int m = 0; m < 4; ++m) _Pragma("unroll") for (int n = 0; n < 2; ++n) _Pragma("unroll") for (int k = 0; k < 2; ++k) \
        acc[ai][bj][m][n] = __builtin_amdgcn_mfma_f32_16x16x32_bf16(Bt_[n][k], At_[m][k], acc[ai][bj][m][n], 0, 0, 0); __builtin_amdgcn_s_setprio(0); } while (0)
#define WAIT_V(n) asm volatile("s_waitcnt vmcnt(" #n ")" ::: "memory")
#define WAIT_L(n) asm volatile("s_waitcnt lgkmcnt(" #n ")" ::: "memory")
#define BAR __builtin_amdgcn_s_barrier()
#define SCHED __builtin_amdgcn_sched_barrier(0)
    int L = bx; if (L >= ntiles) return;
    Tile cur = get(L), nxt = cur;
    AccT acc;
#define G_ZERO _Pragma("unroll") for (int a = 0; a < 2; ++a) _Pragma("unroll") for (int b = 0; b < 2; ++b) _Pragma("unroll") for (int m = 0; m < 4; ++m) _Pragma("unroll") for (int n = 0; n < 2; ++n) acc[a][b][m][n] = (f32x4){0.f, 0.f, 0.f, 0.f}
    G_ZERO;
    bf16x8 At[4][2], B0[2][2], B1[2][2];
    const char* cA = (const char*)cur.A + (size_t)cur.brow * ld * 2; const char* cB = (const char*)cur.Bt + (size_t)cur.bcol * ld * 2;
    G_STAGE(G_SB(0, 0), cB, voffB); G_STAGE(G_SB(0, 1), cB + hstep, voffB); G_STAGE(G_SA(0, 0), cA, voffA); G_STAGE(G_SA(0, 1), cA + hstep, voffA);
    if (wr == 1) BAR;
    WAIT_V(2); BAR;
    G_STAGE(G_SB(1, 0), cB + kstep, voffB); G_STAGE(G_SA(1, 0), cA + kstep, voffA); G_STAGE(G_SB(1, 1), cB + hstep + kstep, voffB);
    WAIT_V(6); BAR;
    for (;;) {
        const int Ln = L + gridDim.x; const bool has_next = Ln < ntiles; if (has_next) nxt = get(Ln);
        const char* nA = has_next ? (const char*)nxt.A + (size_t)nxt.brow * ld * 2 : cA; const char* nB = has_next ? (const char*)nxt.Bt + (size_t)nxt.bcol * ld * 2 : cB;
        const int nt = cur.K / BK;
        for (int t = 0; t < nt; t += 2) {
            const bool last = (t == nt - 2);
            const char* a1 = cA + (size_t)(t + 1) * kstep;
            const char* a2 = last ? nA : cA + (size_t)(t + 2) * kstep; const char* b2 = last ? nB : cB + (size_t)(t + 2) * kstep;
            const char* a3 = a2 + kstep; const char* b3 = b2 + kstep;
            G_LDB(B0, 0, 0); G_LDB(B1, 0, 1); SCHED; G_LDA(At, 0, 0); G_STAGE(G_SA(1, 1), a1 + hstep, voffA);
            WAIT_V(8); WAIT_L(0); BAR; G_MMA(0, 0, At, B0); G_MMA(0, 1, At, B1); BAR; SCHED;
            G_LDA(At, 0, 1); G_STAGE(G_SB(0, 0), b2, voffB); G_STAGE(G_SB(0, 1), b2 + hstep, voffB); G_STAGE(G_SA(0, 0), a2, voffA);
            WAIT_V(8); WAIT_L(0); BAR; G_MMA(1, 0, At, B0); G_MMA(1, 1, At, B1); BAR; SCHED;
            G_LDB(B0, 1, 0); G_LDB(B1, 1, 1); SCHED; G_LDA(At, 1, 0); G_STAGE(G_SA(0, 1), a2 + hstep, voffA);
            WAIT_V(8); WAIT_L(0); BAR; G_MMA(0, 0, At, B0); G_MMA(0, 1, At, B1); BAR; SCHED;
            G_LDA(At, 1, 1); G_STAGE(G_SB(1, 0), b3, voffB); G_STAGE(G_SB(1, 1), b3 + hstep, voffB); G_STAGE(G_SA(1, 0), a3, voffA);
            WAIT_V(8); WAIT_L(0); BAR; G_MMA(1, 0, At, B0); G_MMA(1, 1, At, B1); BAR; SCHED;
        }
        if (wr == 0) BAR;
        { int tx2 = threadIdx.x, brow2 = cur.brow, bcol2 = cur.bcol, Lo = L; asm volatile("" : "+v"(tx2), "+s"(brow2), "+s"(bcol2), "+s"(Lo));
          const int wid2 = tx2 >> 6, lane2 = tx2 & 63; epi(Lo, acc, brow2, bcol2, wid2 >> 2, wid2 & 3, lane2 & 15, lane2 >> 4); }
        if (!has_next) break;
        G_ZERO;
        cur = nxt; cA = nA; cB = nB; L = Ln;
        if (wr == 1) BAR;
    }
    WAIT_V(0);
    BAR;
#undef G_SA
#undef G_SB
#undef G_STAGE
#undef G_LDA
#undef G_LDB
#undef G_MMA
#undef G_ZERO
}
DI void tile_map(int L, int nM, int nN, int& pm, int& pn) {
    const int nwg = nM * nN; int wgid = L;
    { const int q = nwg / 8, r = nwg % 8, xcd = wgid % 8, off = wgid / 8; wgid = (xcd < r ? xcd * (q + 1) : r * (q + 1) + (xcd - r) * q) + off; }
    const int nig = 8 * nN, gid = wgid / nig, fm = gid * 8, gsz = (nM - fm) < 8 ? (nM - fm) : 8;
    pm = fm + ((wgid % nig) % gsz); pn = (wgid % nig) / gsz;
}

#define EPI_LOOP_ROWS _Pragma("unroll") for (int ai = 0; ai < 2; ++ai) _Pragma("unroll") for (int m = 0; m < 4; ++m)
#define EPI_LOOP_BJ _Pragma("unroll") for (int bj = 0; bj < 2; ++bj)
DI u32x4 pack8(const f32x4 a, const f32x4 b) { return (u32x4){pack2(a[0], a[1]), pack2(a[2], a[3]), pack2(b[0], b[1]), pack2(b[2], b[3])}; }

struct EpiBf16 {
    bf16_t* C; size_t ldc;
    DI void operator()(const AccT& acc, int brow, int bcol, int wr, int wc, int fr, int fq) const {
        EPI_LOOP_ROWS { const size_t row = brow + ai * 128 + wr * 64 + m * 16 + fr;
            EPI_LOOP_BJ { const int col = bcol + bj * 128 + wc * 32 + fq * 8; *(u32x4*)(C + row * ldc + col) = pack8(acc[ai][bj][m][0], acc[ai][bj][m][1]); } }
    }
};
struct EpiFnet1 {
    bf16_t* GtL; bf16_t* GtC; int b;
    DI void operator()(const AccT& acc, int brow, int bcol, int wr, int wc, int fr, int fq) const {
        const int cs = brow >= 1024; const bool isctx = bcol < LC;
        EPI_LOOP_ROWS { const int ch = brow + ai * 128 + wr * 64 + m * 16 + fr - cs * 1024;
            bf16_t* dst = isctx ? GtC + ((size_t)(b * 1024 + ch)) * 512 + cs * 256 : GtL + ((size_t)(b * 1024 + ch)) * 4096 + cs * 2048 - LC;
            EPI_LOOP_BJ { const int col = bcol + bj * 128 + wc * 32 + fq * 8; *(u32x4*)(dst + col) = pack8(acc[ai][bj][m][0], acc[ai][bj][m][1]); } }
    }
};
struct EpiResid {
    float* base; const float* src; const float* gate; const float* bias; bool rmw;
    DI void operator()(const AccT& acc, int brow, int bcol, int wr, int wc, int fr, int fq) const {
        EPI_LOOP_BJ { const int col = bcol + bj * 128 + wc * 32 + fq * 8;
            const f32x4 g0 = *(const f32x4*)(gate + col), g1 = *(const f32x4*)(gate + col + 4); f32x4 b0 = (f32x4){0.f, 0.f, 0.f, 0.f}, b1 = b0; if (bias) { b0 = *(const f32x4*)(bias + col); b1 = *(const f32x4*)(bias + col + 4); }
            EPI_LOOP_ROWS { const size_t eo = (size_t)(ai * 128 + wr * 64 + m * 16 + fr) * D + col; float* q = base + eo;
                f32x4 x0 = (f32x4){0.f, 0.f, 0.f, 0.f}, x1 = x0; if (rmw) { x0 = *(const f32x4*)(src + eo); x1 = *(const f32x4*)(src + eo + 4); }
                x0 += g0 * (acc[ai][bj][m][0] + b0); x1 += g1 * (acc[ai][bj][m][1] + b1); *(f32x4*)q = x0; *(f32x4*)(q + 4) = x1; } }
    }
};
struct EpiSwiglu {
    bf16_t* ACT;
    DI void operator()(const AccT& acc, int brow, int bcol, int wr, int wc, int fr, int fq) const {
        const int col = (bcol >> 1) + wc * 32 + fq * 8;
        EPI_LOOP_ROWS { const size_t row = brow + ai * 128 + wr * 64 + m * 16 + fr; f32x4 o[2];
#pragma unroll
            for (int n = 0; n < 2; ++n) { const f32x4 g = acc[ai][0][m][n], u = acc[ai][1][m][n];
#pragma unroll
                for (int j = 0; j < 4; ++j) o[n][j] = silu_f(g[j]) * u[j]; }
            *(u32x4*)(ACT + row * DFF + col) = pack8(o[0], o[1]); }
    }
};
template <int CTRL> DI float dpp_f(float x) { return __int_as_float(__builtin_amdgcn_update_dpp(0, __float_as_int(x), CTRL, 0xF, 0xF, true)); }
struct EpiHgrn {
    unsigned char* P; const float* lbv; unsigned char* ebase;
    DI void operator()(const AccT& acc, int brow, int bcol, int wr, int wc, int fr, int fq) const {
        const int seg = bcol >> 10, cb = bcol & 1023;
        EPI_LOOP_BJ { const int col = cb + bj * 128 + wc * 32 + fq * 8;
            if (seg == 1 || seg == 2) {
                const int dir = seg - 1;
                const f32x4 lb0 = *(const f32x4*)(lbv + dir * 1024 + col), lb1 = *(const f32x4*)(lbv + dir * 1024 + col + 4);
                bf16_t* EK = (bf16_t*)(P + (dir ? P_HF1 : P_HF0)); float* EBp = (float*)(ebase);
                const int lane_ = fq * 16 + fr;
#pragma unroll
                for (int ai = 0; ai < 2; ++ai)
#pragma unroll
                for (int mp = 0; mp < 2; ++mp) {
                    const size_t row0 = brow + ai * 128 + wr * 64 + mp * 32 + fr, row1 = row0 + 16;
                    float fa[8], fb[8], xa[8], xb[8];
#pragma unroll
                    for (int j = 0; j < 4; ++j) { fa[j] = lb0[j] + (1.f - lb0[j]) * sigmoid_f(acc[ai][bj][2 * mp][0][j]); fa[4 + j] = lb1[j] + (1.f - lb1[j]) * sigmoid_f(acc[ai][bj][2 * mp][1][j]);
                                                  fb[j] = lb0[j] + (1.f - lb0[j]) * sigmoid_f(acc[ai][bj][2 * mp + 1][0][j]); fb[4 + j] = lb1[j] + (1.f - lb1[j]) * sigmoid_f(acc[ai][bj][2 * mp + 1][1][j]); }
#pragma unroll
                    for (int j = 0; j < 8; ++j) { float x = __logf(fa[j]), y = __logf(fb[j]);
                        if (dir == 0) { x += dpp_f<0x111>(x); x += dpp_f<0x112>(x); x += dpp_f<0x114>(x); x += dpp_f<0x118>(x);
                                        y += dpp_f<0x111>(y); y += dpp_f<0x112>(y); y += dpp_f<0x114>(y); y += dpp_f<0x118>(y);
                                        y += __shfl(x, (lane_ & 48) | 15); }
                        else { x += dpp_f<0x101>(x); x += dpp_f<0x102>(x); x += dpp_f<0x104>(x); x += dpp_f<0x108>(x);
                               y += dpp_f<0x101>(y); y += dpp_f<0x102>(y); y += dpp_f<0x104>(y); y += dpp_f<0x108>(y);
                               x += __shfl(y, lane_ & 48); }
                        xa[j] = x; xb[j] = y; }
                    f32x4 e0, e1, k0, k1;
#pragma unroll
                    for (int j = 0; j < 4; ++j) { e0[j] = __expf(xa[j]); e1[j] = __expf(xa[4 + j]); k0[j] = (1.f - fa[j]) * __expf(fminf(-xa[j], 80.f)); k1[j] = (1.f - fa[4 + j]) * __expf(fminf(-xa[4 + j], 80.f)); }
                    *(u32x4*)(EK + row0 * 2048 + col) = pack8(e0, e1); *(u32x4*)(EK + row0 * 2048 + 1024 + col) = pack8(k0, k1);
                    if (dir == 1 && fr == 0) { const int b_ = (int)(row0 / LT), pos = (int)(row0 - (size_t)b_ * LT); const int tau = pos < LC ? LC - 1 - pos : LT + LC - 1 - pos;
                        float* ep = EBp + ((size_t)(NB + b_) * 72 + (tau >> 5)) * D + col; *(f32x4*)ep = e0; *(f32x4*)(ep + 4) = e1; }
#pragma unroll
                    for (int j = 0; j < 4; ++j) { e0[j] = __expf(xb[j]); e1[j] = __expf(xb[4 + j]); k0[j] = (1.f - fb[j]) * __expf(fminf(-xb[j], 80.f)); k1[j] = (1.f - fb[4 + j]) * __expf(fminf(-xb[4 + j], 80.f)); }
                    *(u32x4*)(EK + row1 * 2048 + col) = pack8(e0, e1); *(u32x4*)(EK + row1 * 2048 + 1024 + col) = pack8(k0, k1);
                    if (dir == 0 && fr == 15) { const int b_ = (int)(row1 / LT), pos = (int)(row1 - (size_t)b_ * LT);
                        float* ep = EBp + ((size_t)b_ * 72 + (pos >> 5)) * D + col; *(f32x4*)ep = e0; *(f32x4*)(ep + 4) = e1; }
                }
            } else {
                bf16_t* C = (bf16_t*)(P + (seg == 0 ? P_HQ : (seg == 3 ? P_HV : P_HG)));
                EPI_LOOP_ROWS { const size_t row = brow + ai * 128 + wr * 64 + m * 16 + fr; f32x4 v0 = acc[ai][bj][m][0], v1 = acc[ai][bj][m][1];
                    if (seg == 0) {
#pragma unroll
                        for (int j = 0; j < 4; ++j) { v0[j] = silu_f(v0[j]); v1[j] = silu_f(v1[j]); } }
                    *(u32x4*)(C + row * D + col) = pack8(v0, v1); }
            } }
    }
};

template <class Epi>
DI void gemm_phase(const bf16_t* A, int lda, const bf16_t* Bt, int ldb, int N, int K, bool lat_only, char* shm, const Epi& epi) {
    const int nM = lat_only ? 64 : 72, nN = N / BM;
    gemm_loop(nM * nN, lda, shm, [&](int L) { int pm, pn; tile_map(L, nM, nN, pm, pn); if (lat_only) pm = (pm >> 3) * 9 + 1 + (pm & 7); return Tile{A, Bt, lda, ldb, K, pm * BM, pn * BM}; },
              [&](int, const AccT& acc, int brow, int bcol, int wr, int wc, int fr, int fq) { epi(acc, brow, bcol, wr, wc, fr, fq); });
}
template <int S>
DI void gemm_resid(const bf16_t* A, const bf16_t* Bt, int K, bool with_ctx, float* out, const float* xin, const float* gate, const float* bias, float* part, char* shm) {
    const int U = K / 128, ub = U / S, ur = U % S;
    gemm_loop(256 + (with_ctx ? 32 * S : 0), K, shm,
              [&](int L) { if (L < 256) { int pm, pn; tile_map(L, 64, 4, pm, pn); pm = (pm >> 3) * 9 + 1 + (pm & 7); return Tile{A, Bt, K, K, K, pm * BM, pn * BM}; }
                           const int v = L - 256, s = v % S, tt = v / S, b = tt >> 2, pn = tt & 3; const int u0 = s * ub + (s < ur ? s : ur), nu = ub + (s < ur ? 1 : 0);
                           return Tile{A + u0 * 128, Bt + u0 * 128, K, K, nu * 128, b * LT, pn * BM}; },
              [&](int L, const AccT& acc, int brow, int bcol, int wr, int wc, int fr, int fq) {
                  const int b = brow / LT; EpiResid e;
                  if (L < 256) { const size_t ro = ((size_t)(b * LL + (brow - b * LT) - LC)) * D; e.base = out + ro; e.src = xin + ro; e.gate = gate + (size_t)b * 6144; e.bias = bias; e.rmw = true; }
                  else { const int s = (L - 256) % S; e.base = part + ((size_t)s * NB * LC + b * LC) * D; e.src = e.base; e.gate = gate + (size_t)8 * 6144; e.bias = s == 0 ? bias : nullptr; e.rmw = false; }
                  e(acc, brow, bcol, wr, wc, fr, fq); });
}

DI void conv_T(const float* __restrict__ src, int ldsrc, int c0, int K, int N, bf16_t* __restrict__ dst, int mode, char* shm) {
    OPAQUE_IDS
    float* tile = (float*)shm;
    const int nk = K / 64, ns = N / 256, tid = tx;
    for (int L = bx; L < nk * ns; L += gridDim.x) {
        const int tk = L % nk, ts = L / nk, n0 = ts * 256;
        __syncthreads();
        f32x4 v[8];
#pragma unroll
        for (int i = 0; i < 8; ++i) { const int e = tid + i * NTHR, kk = e >> 6, n4 = (e & 63) * 4;
            const int scol = mode == 1 ? ((n4 >> 7) ? 2816 + ts * 128 + (n4 & 127) : ts * 128 + n4) : c0 + n0 + n4;
            v[i] = *(const f32x4*)(src + (size_t)(tk * 64 + kk) * ldsrc + scol); }
#pragma unroll
        for (int i = 0; i < 8; ++i) { const int e = tid + i * NTHR, kk = e >> 6, n4 = (e & 63) * 4; *(f32x4*)(tile + kk * 260 + (n4 ^ (((kk >> 3) & 7) << 3))) = v[i]; }
        __syncthreads();
#pragma unroll
        for (int i = 0; i < 4; ++i) { const int n = (tid >> 3) + 64 * i, m = tid & 7, kc = m * 8; const float* tp = tile + kc * 260 + (n ^ (m << 3)); u32x4 w;
            w.x = pack2(tp[0], tp[260]); w.y = pack2(tp[2 * 260], tp[3 * 260]); w.z = pack2(tp[4 * 260], tp[5 * 260]); w.w = pack2(tp[6 * 260], tp[7 * 260]);
            *(u32x4*)(dst + (size_t)(n0 + n) * K + tk * 64 + kc) = w; }
    }
    __syncthreads();
}
DI void convert_layer(const Params& p, int i, char* shm) {
    bf16_t* wfi = (bf16_t*)(p.ws + WS_WFI); bf16_t* wfo = (bf16_t*)(p.ws + WS_WFO); bf16_t* wmi = (bf16_t*)(p.ws + WS_WMI); bf16_t* wmo = (bf16_t*)(p.ws + WS_WMO);
    conv_T(p.in[7] + (size_t)i * D * 2 * DFF, 2 * DFF, 0, D, 2 * DFF, wfi, 1, shm);
    conv_T(p.in[8] + (size_t)i * DFF * D, D, 0, DFF, D, wfo, 0, shm);
    if (i == 0) { conv_T(p.in[9], D, 0, D, D, wmo, 0, shm); }
    else if (i == 1) { conv_T(p.in[11], 3 * D, 0, D, 3 * D, wmi, 0, shm); conv_T(p.in[16], D, 0, D, D, wmo, 0, shm); }
    else if (i == 2) { conv_T(p.in[17], 5 * D, 0, D, 5 * D, wmi, 0, shm); conv_T(p.in[20], D, 0, D, D, wmo, 0, shm); }
    else { conv_T(p.in[21], 1536, 0, D, 1536, wmi, 0, shm); conv_T(p.in[24], D, 0, D, D, wmo, 0, shm); }
}

DI void prologue(const Params& p, char* shm) {
    OPAQUE_IDS
    const size_t gtid = (size_t)bx * NTHR + tx, gn = (size_t)gridDim.x * NTHR;
    { float* cond = (float*)shm;
      float* part = (float*)(p.ws + WS_P + P_PART);
      for (int it = bx; it < 4 * 16 * 12; it += gridDim.x) {
          const int cb = it % 12, ks = (it / 12) % 16, Ly = it / (12 * 16);
          __syncthreads();
          for (int e = tx; e < 9 * 64; e += NTHR) { const int ci = e >> 6, k = ks * 64 + (e & 63); const float v = ci < 8 ? p.in[1][ci * D + k] : p.in[3][k]; cond[e] = silu_f(v); }
          __syncthreads();
          const int col = cb * 512 + tx; const float* w = p.in[4] + ((size_t)Ly * D + ks * 64) * 6144 + col;
          float a[9];
#pragma unroll
          for (int c = 0; c < 9; ++c) a[c] = 0.f;
          for (int k = 0; k < 64; ++k) { const float wv = w[(size_t)k * 6144];
#pragma unroll
              for (int c = 0; c < 9; ++c) a[c] += cond[c * 64 + k] * wv; }
#pragma unroll
          for (int c = 0; c < 9; ++c) part[(((size_t)ks * 4 + Ly) * 9 + c) * 6144 + col] = a[c];
      }
      __syncthreads(); }
    { f32x2* rd = (f32x2*)(p.ws + WS_ROPED); f32x2* rg = (f32x2*)(p.ws + WS_ROPEG);
      for (size_t i = gtid; i < (size_t)2048 * 32; i += gn) { const int pos = (int)(i >> 5), pp = (int)(i & 31); const int j = pp & 15; const float inv = exp2f(-(float)j * (13.287712379549449f / 16.f));
          const float ang = (float)(pp < 16 ? (pos >> 6) : (pos & 63)) * inv; float s, c; sincosf(ang, &s, &c); rd[i] = (f32x2){c, s}; }
      for (size_t i = gtid; i < (size_t)2048 * 64; i += gn) { const int pos = (int)(i >> 6), pp = (int)(i & 63); const int j = pp & 31; const float inv = exp2f(-(float)j * (13.287712379549449f / 32.f));
          const float ang = (float)(pp < 32 ? (pos >> 6) : (pos & 63)) * inv; float s, c; sincosf(ang, &s, &c); rg[i] = (f32x2){c, s}; } }
    { float* lbv = (float*)(p.ws + WS_LBV); const float* lbp = p.in[18];
      for (size_t i = gtid; i < 2048; i += gn) { const int d = (int)(i >> 10), c = (int)(i & 1023); const float* q = lbp + (size_t)d * 4 * 1024 + c;
          const float v0 = q[0], v1 = q[1024], v2 = q[2048], v3 = q[3072]; const float mx = fmaxf(fmaxf(v0, v1), fmaxf(v2, v3));
          const float e0 = expf(v0 - mx), e1 = expf(v1 - mx), e2 = expf(v2 - mx), e3 = expf(v3 - mx); lbv[i] = (e1 + e2) / (e0 + e1 + e2 + e3); } }
    { bf16_t* cdt = (bf16_t*)(p.ws + WS_P + P_CDT); bf16_t* wl = (bf16_t*)(p.ws + WS_P + P_WL); bf16_t* wc = (bf16_t*)(p.ws + WS_P + P_WC);
      const float sc128 = 0.08838834764831845f, sc2048 = 0.022097086912079608f, sc256 = 0.0625f;
      for (size_t i = gtid; i < (size_t)2048 * 1024; i += gn) { const int m = (int)(i >> 10), k = (int)(i & 1023); const int cs = m >> 10, ch = m & 1023; float v = 0.f;
          if ((ch >> 7) == (k >> 7)) { const int e = ((ch & 127) * (k & 127)) & 127; const float a = (float)e * (2.f / 128.f); v = (cs ? sinpif(a) : cospif(a)) * sc128; }
          cdt[i] = f2bf(v); }
      for (size_t i = gtid; i < (size_t)2048 * 4096; i += gn) { const int kf = (int)(i >> 12), kk = (int)(i & 4095); const int cs = kk >> 11, t = kk & 2047; const int e = (kf * t) & 2047;
          const float a = (float)e * (2.f / 2048.f); wl[i] = f2bf((cs ? -sinpif(a) : cospif(a)) * sc2048); }
      for (size_t i = gtid; i < (size_t)256 * 512; i += gn) { const int kf = (int)(i >> 9), kk = (int)(i & 511); const int cs = kk >> 8, t = kk & 255; const int e = (kf * t) & 255;
          const float a = (float)e * (2.f / 256.f); wc[i] = f2bf((cs ? -sinpif(a) : cospif(a)) * sc256); } }
    convert_layer(p, 0, shm);
}
DI void mod_reduce(const Params& p) {
    OPAQUE_IDS
    const size_t gtid = (size_t)bx * NTHR + tx, gn = (size_t)gridDim.x * NTHR;
    const float* part = (const float*)(p.ws + WS_P + P_PART); float* mod = (float*)(p.ws + WS_MOD);
    for (size_t i = gtid; i < (size_t)4 * 9 * 6144; i += gn) { const int col = (int)(i % 6144), Ly = (int)(i / (9 * 6144));
        float a = p.in[5][(size_t)Ly * 6144 + col];
        for (int ks = 0; ks < 16; ++ks) a += part[(size_t)ks * 4 * 9 * 6144 + i];
        mod[i] = a; }
}

DI void norm_phase(const Params& p, int layer, int which, bool lat_only, const float* __restrict__ part, int npart, int srcmode) {
    OPAQUE_IDS
    const int lane = tx & 63, gw = bx * 8 + (tx >> 6);
    const float* gain = p.in[6] + ((size_t)layer * 2 + which) * D; const float* mod = (const float*)(p.ws + WS_MOD) + (size_t)layer * 9 * 6144;
    bf16_t* H = (bf16_t*)(p.ws + WS_H);
    f32x4 gm[4], sh[4]; int cur_ci = -1;
    const int nw = gridDim.x * 8;
    for (int vw = gw; vw < NB * 256; vw += nw)
    for (int i0 = 0; i0 < 9; i0 += 3) {
        const int r0 = (vw >> 8) * LT + (vw & 255) + 256 * i0;
        f32x4 v[3][4]; float ss[3]; bool ok[3];
#pragma unroll
        for (int q = 0; q < 3; ++q) {
            const int row = r0 + 256 * q; const int b = row / LT, pos = row - b * LT;
            ok[q] = !(lat_only && pos < LC); ss[q] = 0.f;
            if (ok[q]) {
                float* x = resid_row(p, row);
                const float* xs = (srcmode == 1 || (srcmode == 2 && pos < LC)) ? (pos < LC ? p.in[2] + ((size_t)(b * LC + pos)) * D : p.in[0] + ((size_t)(b * LL + pos - LC)) * D) : x;
#pragma unroll
                for (int j = 0; j < 4; ++j) v[q][j] = *(const f32x4*)(xs + j * 256 + lane * 4);
                if (part != nullptr && pos < LC) {
                    f32x4 a[4];
#pragma unroll
                    for (int j = 0; j < 4; ++j) a[j] = (f32x4){0.f, 0.f, 0.f, 0.f};
                    const float* pp = part + (size_t)(b * LC + pos) * D + lane * 4;
                    for (int s = 0; s < npart; ++s) {
#pragma unroll
                        for (int j = 0; j < 4; ++j) a[j] += *(const f32x4*)(pp + (size_t)s * NB * LC * D + j * 256); }
#pragma unroll
                    for (int j = 0; j < 4; ++j) { v[q][j] += a[j]; *(f32x4*)(x + j * 256 + lane * 4) = v[q][j]; }
                }
#pragma unroll
                for (int j = 0; j < 4; ++j) ss[q] += v[q][j][0] * v[q][j][0] + v[q][j][1] * v[q][j][1] + v[q][j][2] * v[q][j][2] + v[q][j][3] * v[q][j][3];
            }
        }
        ss[0] = wave_sum(ss[0]); ss[1] = wave_sum(ss[1]); ss[2] = wave_sum(ss[2]);
#pragma unroll
        for (int q = 0; q < 3; ++q) {
            if (!ok[q]) continue;
            const int row = r0 + 256 * q; const int ci = cond_idx(row);
            if (ci != cur_ci) { cur_ci = ci; const float* mo = mod + (size_t)ci * 6144 + which * 3072;
#pragma unroll
                for (int j = 0; j < 4; ++j) { const int col = j * 256 + lane * 4; gm[j] = *(const f32x4*)(gain + col) * (1.f + *(const f32x4*)(mo + 1024 + col)); sh[j] = *(const f32x4*)(mo + col); } }
            const float r = rsqrtf(ss[q] * (1.f / 1024.f) + EPS);
#pragma unroll
            for (int j = 0; j < 4; ++j) { const int col = j * 256 + lane * 4; const f32x4 y = v[q][j] * r * gm[j] + sh[j];
                *(u32x2*)(H + (size_t)row * D + col) = (u32x2){pack2(y[0], y[1]), pack2(y[2], y[3])}; }
        }
    }
}

template <int HS>
DI void qknorm_phase(bf16_t* QK, int RL, int nqseg, const float* qgain, const float* kgain, int gain_mod, const f32x2* rope, float qscale, bool konly) {
    OPAQUE_IDS
    const int lane = tx & 63, gw = bx * 8 + (tx >> 6), nw = gridDim.x * 8;
    const int seg = lane >> 1, half = lane & 1; const bool isq = seg < nqseg; const bool act = lane * HS < RL && !(konly && isq);
    const float* gn = (isq ? qgain : kgain) + (gain_mod ? (seg % gain_mod) * 2 * HS : 0) + half * HS;
    for (int row = gw; row < T; row += nw) {
        const int b = row / LT, pos = row - b * LT;
        float x[HS]; float ss = 0.f;
        bf16_t* ptr = QK + (size_t)row * RL + lane * HS;
        if (act) {
#pragma unroll
            for (int c = 0; c < HS / 8; ++c) { const u32x4 w = *(const u32x4*)(ptr + c * 8);
                x[c * 8 + 0] = bflo(w.x); x[c * 8 + 1] = bfhi(w.x); x[c * 8 + 2] = bflo(w.y); x[c * 8 + 3] = bfhi(w.y);
                x[c * 8 + 4] = bflo(w.z); x[c * 8 + 5] = bfhi(w.z); x[c * 8 + 6] = bflo(w.w); x[c * 8 + 7] = bfhi(w.w); }
        } else {
#pragma unroll
            for (int e = 0; e < HS; ++e) x[e] = 0.f;
        }
#pragma unroll
        for (int e = 0; e < HS; ++e) ss += x[e] * x[e];
        ss += dpp_f<0xB1>(ss);
        float r = rsqrtf(ss * (1.f / (2 * HS)) + EPS); if (isq) r *= qscale;
        const bool lat = pos >= LC; const f32x2* rp = rope + (size_t)(lat ? pos - LC : 0) * HS;
#pragma unroll
        for (int e = 0; e < HS; ++e) {
            float v = x[e] * r * (act ? gn[e] : 0.f);
            const float o = dpp_f<0xB1>(v);
            if (lat) { const f32x2 cs = rp[e]; v = half ? (o * cs[1] + v * cs[0]) : (v * cs[0] - o * cs[1]); }
            x[e] = v;
        }
        if (act) {
#pragma unroll
            for (int c = 0; c < HS / 8; ++c) { u32x4 w; w.x = pack2(x[c * 8], x[c * 8 + 1]); w.y = pack2(x[c * 8 + 2], x[c * 8 + 3]); w.z = pack2(x[c * 8 + 4], x[c * 8 + 5]); w.w = pack2(x[c * 8 + 6], x[c * 8 + 7]);
                *(u32x4*)(ptr + c * 8) = w; }
        }
    }
}

DI float half_swap_max(float x) { const unsigned u = __float_as_uint(x); const auto r = __builtin_amdgcn_permlane32_swap(u, u, false, false); return fmaxf(__uint_as_float(r[0]), __uint_as_float(r[1])); }
DI float half_swap_sum(float x) { const unsigned u = __float_as_uint(x); const auto r = __builtin_amdgcn_permlane32_swap(u, u, false, false); return __uint_as_float(r[0]) + __uint_as_float(r[1]); }
#define MFMA32(a, b, c) __builtin_amdgcn_mfma_f32_32x32x16_bf16((a), (b), (c), 0, 0, 0)
template <int DQK, int MODE>
DI void attn_phase(const bf16_t* __restrict__ QK, int ldq, const bf16_t* __restrict__ Vt, int VC, bf16_t* __restrict__ O, int ldo, int nhu, bool skip_ctx, const float* __restrict__ qgain, const f32x2* __restrict__ rope, float qscale, char* shm) {
    OPAQUE_IDS
    constexpr int KS = DQK * 2 + 16, VS = 144, KCH = DQK / 8, NKC = 64 * KCH / NTHR;
    constexpr int BUFB = 64 * KS + 128 * VS;
    char* Kl = shm; char* Vl = shm + 64 * KS;
    const int tid = tx, w = tid >> 6, lane = tid & 63, r = lane & 31, h = lane >> 5;
    const int nlat = NB * nhu * 8, nunits = nlat + (skip_ctx ? 0 : NB * nhu);
    for (int u = bx; u < nunits; u += gridDim.x) {
        int qt, hu, b;
        if (u < nlat) { qt = 1 + (u & 7); hu = (u >> 3) % nhu; b = (u >> 3) / nhu; } else { const int v = u - nlat; qt = 0; hu = v % nhu; b = v / nhu; }
        const int qoff = hu * DQK, koff = 1024 + (MODE == 0 ? hu * 64 : (hu >> 2) * 128), voff = (MODE == 0 ? (hu >> 1) : (hu >> 2)) * 128, ooff = hu * 128;
        const int nkt = qt == 0 ? 4 : 36;
        const size_t qrow = (size_t)b * LT + qt * 256 + w * 32 + r;
        bf16x8 qf[DQK / 16];
#pragma unroll
        for (int ks = 0; ks < DQK / 16; ++ks) qf[ks] = *(const bf16x8*)(QK + qrow * ldq + qoff + ks * 16 + h * 8);
        {
            float ss = 0.f;
#pragma unroll
            for (int ks = 0; ks < DQK / 16; ++ks) { const u32x4 wq = __builtin_bit_cast(u32x4, qf[ks]);
                const float a0 = bflo(wq.x), a1 = bfhi(wq.x), a2 = bflo(wq.y), a3 = bfhi(wq.y), a4 = bflo(wq.z), a5 = bfhi(wq.z), a6 = bflo(wq.w), a7 = bfhi(wq.w);
                ss += a0 * a0 + a1 * a1 + a2 * a2 + a3 * a3 + a4 * a4 + a5 * a5 + a6 * a6 + a7 * a7; }
            ss += __shfl_xor(ss, 32);
            const float rr = rsqrtf(ss * (1.f / DQK) + EPS) * qscale; int go = (MODE == 0 ? (hu & 1) * 64 : 0) + h * 8; asm volatile("" : "+v"(go));
            const float* gq = qgain + go; const f32x2* rp = rope + (size_t)((qt > 0 ? qt - 1 : 0) * 256 + w * 32 + r) * (DQK / 2) + h * 8;
#pragma unroll
            for (int ks = 0; ks < DQK / 32; ++ks) {
                const u32x4 wa = __builtin_bit_cast(u32x4, qf[ks]), wb = __builtin_bit_cast(u32x4, qf[ks + DQK / 32]);
                float xa[8] = {bflo(wa.x), bfhi(wa.x), bflo(wa.y), bfhi(wa.y), bflo(wa.z), bfhi(wa.z), bflo(wa.w), bfhi(wa.w)};
                float xb[8] = {bflo(wb.x), bfhi(wb.x), bflo(wb.y), bfhi(wb.y), bflo(wb.z), bfhi(wb.z), bflo(wb.w), bfhi(wb.w)};
#pragma unroll
                for (int j = 0; j < 8; ++j) { float x1 = xa[j] * rr * gq[ks * 16 + j], x2 = xb[j] * rr * gq[(ks + DQK / 32) * 16 + j];
                    if (qt > 0) { const f32x2 cs = rp[ks * 16 + j]; const float y1 = x1 * cs[0] - x2 * cs[1], y2 = x1 * cs[1] + x2 * cs[0]; x1 = y1; x2 = y2; }
                    xa[j] = x1; xb[j] = x2; }
                qf[ks] = __builtin_bit_cast(bf16x8, (u32x4){pack2(xa[0], xa[1]), pack2(xa[2], xa[3]), pack2(xa[4], xa[5]), pack2(xa[6], xa[7])});
                qf[ks + DQK / 32] = __builtin_bit_cast(bf16x8, (u32x4){pack2(xb[0], xb[1]), pack2(xb[2], xb[3]), pack2(xb[4], xb[5]), pack2(xb[6], xb[7])});
            }
        }
        f32x16 oacc[4];
#pragma unroll
        for (int t = 0; t < 4; ++t)
#pragma unroll
            for (int i = 0; i < 16; ++i) oacc[t][i] = 0.f;
        float mrun = -1e30f, lsum = 0.f;
        const bf16_t* kbase = QK + (size_t)b * LT * ldq + koff; const bf16_t* vbase = Vt + ((size_t)b * VC + voff) * LT;
        u32x4 kreg[NKC], vreg[2];
#define ATT_LOAD(kt) do { _Pragma("unroll") for (int i = 0; i < NKC; ++i) { const int c = tid + i * NTHR, key = c / KCH, part = c % KCH; \
                kreg[i] = *(const u32x4*)(kbase + (size_t)((kt) * 64 + key) * ldq + part * 8); } \
            _Pragma("unroll") for (int i = 0; i < 2; ++i) { const int c = tid + i * NTHR, dv = c >> 3, part = c & 7; \
                vreg[i] = *(const u32x4*)(vbase + (size_t)dv * LT + (kt) * 64 + part * 8); } } while (0)
        ATT_LOAD(0);
#define ATT_STORE(buf) do { char* Kw = Kl + (buf) * BUFB; char* Vw = Vl + (buf) * BUFB; \
            _Pragma("unroll") for (int i = 0; i < NKC; ++i) { const int c = tid + i * NTHR, key = c / KCH, part = c % KCH; *(u32x4*)(Kw + key * KS + part * 16) = kreg[i]; } \
            _Pragma("unroll") for (int i = 0; i < 2; ++i) { const int c = tid + i * NTHR, dv = c >> 3, part = c & 7; char* vp_ = Vw + dv * VS + (part >> 1) * 32 + (part & 1) * 8; \
                *(u32x2*)(vp_) = (u32x2){vreg[i].x, vreg[i].y}; *(u32x2*)(vp_ + 16) = (u32x2){vreg[i].z, vreg[i].w}; } } while (0)
        __syncthreads();
        ATT_STORE(0);
        __syncthreads();
        for (int kt = 0; kt < nkt; ++kt) {
            const char* Kc = Kl + (kt & 1) * BUFB; const char* Vc = Vl + (kt & 1) * BUFB;
            if (kt + 1 < nkt) ATT_LOAD(kt + 1);
            f32x16 st0, st1;
#pragma unroll
            for (int i = 0; i < 16; ++i) { st0[i] = 0.f; st1[i] = 0.f; }
#pragma unroll
            for (int ks = 0; ks < DQK / 16; ++ks) {
                const bf16x8 a0 = *(const bf16x8*)(Kc + r * KS + ks * 32 + h * 16), a1 = *(const bf16x8*)(Kc + (32 + r) * KS + ks * 32 + h * 16);
                st0 = MFMA32(a0, qf[ks], st0); st1 = MFMA32(a1, qf[ks], st1);
            }
            float mx = st0[0];
#pragma unroll
            for (int i = 0; i < 16; ++i) mx = __builtin_fmaxf(__builtin_fmaxf(mx, st0[i]), st1[i]);
            mx = half_swap_max(mx);
            if (__any(mx > mrun + 8.f)) {
                const float mnew = fmaxf(mrun, mx), alpha = __builtin_amdgcn_exp2f(mrun - mnew); mrun = mnew; lsum *= alpha;
#pragma unroll
                for (int t = 0; t < 4; ++t)
#pragma unroll
                    for (int i = 0; i < 16; ++i) oacc[t][i] *= alpha;
            }
            { const f32x2 m2 = (f32x2){mrun, mrun}; f32x2 ps2 = (f32x2){0.f, 0.f};
#pragma unroll
              for (int i = 0; i < 16; i += 2) {
                  f32x2 a = (f32x2){st0[i], st0[i + 1]} - m2, c = (f32x2){st1[i], st1[i + 1]} - m2;
                  a[0] = __builtin_amdgcn_exp2f(a[0]); a[1] = __builtin_amdgcn_exp2f(a[1]); c[0] = __builtin_amdgcn_exp2f(c[0]); c[1] = __builtin_amdgcn_exp2f(c[1]);
                  ps2 += a; ps2 += c; st0[i] = a[0]; st0[i + 1] = a[1]; st1[i] = c[0]; st1[i + 1] = c[1]; }
              lsum += ps2[0] + ps2[1]; }
#pragma unroll
            for (int kb = 0; kb < 2; ++kb)
#pragma unroll
                for (int s = 0; s < 2; ++s) {
                    u32x4 pw;
                    if (kb == 0) { pw.x = pack2(st0[8 * s], st0[8 * s + 1]); pw.y = pack2(st0[8 * s + 2], st0[8 * s + 3]); pw.z = pack2(st0[8 * s + 4], st0[8 * s + 5]); pw.w = pack2(st0[8 * s + 6], st0[8 * s + 7]); }
                    else { pw.x = pack2(st1[8 * s], st1[8 * s + 1]); pw.y = pack2(st1[8 * s + 2], st1[8 * s + 3]); pw.z = pack2(st1[8 * s + 4], st1[8 * s + 5]); pw.w = pack2(st1[8 * s + 6], st1[8 * s + 7]); }
                    const bf16x8 pb = __builtin_bit_cast(bf16x8, pw);
#pragma unroll
                    for (int t = 0; t < 4; ++t) {
                        const bf16x8 a = *(const bf16x8*)(Vc + (32 * t + r) * VS + (kb * 2 + s) * 32 + h * 16);
                        oacc[t] = MFMA32(a, pb, oacc[t]);
                    }
                }
            if (kt + 1 < nkt) ATT_STORE((kt + 1) & 1);
            __syncthreads();
        }
#undef ATT_STORE
#undef ATT_LOAD
        const float l = half_swap_sum(lsum), inv = 1.f / l;
        bf16_t* op = O + qrow * ldo + ooff;
#pragma unroll
        for (int t = 0; t < 4; ++t)
#pragma unroll
            for (int g = 0; g < 4; g += 2) {
                const unsigned ax = pack2(oacc[t][4 * g] * inv, oacc[t][4 * g + 1] * inv), ay = pack2(oacc[t][4 * g + 2] * inv, oacc[t][4 * g + 3] * inv);
                const unsigned bx_ = pack2(oacc[t][4 * g + 4] * inv, oacc[t][4 * g + 5] * inv), by_ = pack2(oacc[t][4 * g + 6] * inv, oacc[t][4 * g + 7] * inv);
                const auto sx = __builtin_amdgcn_permlane32_swap(ax, bx_, false, false); const auto sy = __builtin_amdgcn_permlane32_swap(ay, by_, false, false);
                *(u32x4*)(op + 32 * t + 8 * (g + h)) = (u32x4){sx[0], sy[0], sx[1], sy[1]}; }
    }
    __syncthreads();
}

template <int MODE>
DI void headnorm_phase(const Params& p, const bf16_t* __restrict__ A0, const bf16_t* __restrict__ A1, const bf16_t* __restrict__ G, const float* gain, float lam, float outscale) {
    OPAQUE_IDS
    const int lane = tx & 63, gw = bx * 8 + (tx >> 6), nw = gridDim.x * 8;
    bf16_t* H = (bf16_t*)(p.ws + WS_H); const int hh = lane >> 3, d0 = (lane & 7) * 16;
    for (int row = gw; row < T; row += nw) {
        float x[16];
#pragma unroll
        for (int c = 0; c < 2; ++c) {
            u32x4 a, b2;
            if (MODE == 0) { a = *(const u32x4*)(A0 + (size_t)row * 2048 + hh * 256 + d0 + c * 8); b2 = *(const u32x4*)(A0 + (size_t)row * 2048 + hh * 256 + 128 + d0 + c * 8); }
            else { a = *(const u32x4*)(A0 + (size_t)row * D + hh * 128 + d0 + c * 8); b2 = *(const u32x4*)(A1 + (size_t)row * D + hh * 128 + d0 + c * 8); }
            const float s = MODE == 0 ? -lam : 1.f;
            x[c * 8 + 0] = bflo(a.x) + s * bflo(b2.x); x[c * 8 + 1] = bfhi(a.x) + s * bfhi(b2.x); x[c * 8 + 2] = bflo(a.y) + s * bflo(b2.y); x[c * 8 + 3] = bfhi(a.y) + s * bfhi(b2.y);
            x[c * 8 + 4] = bflo(a.z) + s * bflo(b2.z); x[c * 8 + 5] = bfhi(a.z) + s * bfhi(b2.z); x[c * 8 + 6] = bflo(a.w) + s * bflo(b2.w); x[c * 8 + 7] = bfhi(a.w) + s * bfhi(b2.w);
        }
        float ss = 0.f;
#pragma unroll
        for (int e = 0; e < 16; ++e) ss += x[e] * x[e];
        ss += __shfl_xor(ss, 1); ss += __shfl_xor(ss, 2); ss += __shfl_xor(ss, 4);
        const float r = rsqrtf(ss * (1.f / 128.f) + EPS) * outscale;
#pragma unroll
        for (int c = 0; c < 2; ++c) {
            float y[8];
#pragma unroll
            for (int e = 0; e < 8; ++e) y[e] = x[c * 8 + e] * r * gain[d0 + c * 8 + e];
            if (MODE == 1) { const u32x4 g = *(const u32x4*)(G + (size_t)row * D + hh * 128 + d0 + c * 8);
                y[0] *= silu_f(bflo(g.x)); y[1] *= silu_f(bfhi(g.x)); y[2] *= silu_f(bflo(g.y)); y[3] *= silu_f(bfhi(g.y));
                y[4] *= silu_f(bflo(g.z)); y[5] *= silu_f(bfhi(g.z)); y[6] *= silu_f(bflo(g.w)); y[7] *= silu_f(bfhi(g.w)); }
            u32x4 wv; wv.x = pack2(y[0], y[1]); wv.y = pack2(y[2], y[3]); wv.z = pack2(y[4], y[5]); wv.w = pack2(y[6], y[7]);
            *(u32x4*)(H + (size_t)row * D + hh * 128 + d0 + c * 8) = wv;
        }
    }
}

DI float dpp_x1(float x) { return __int_as_float(__builtin_amdgcn_update_dpp(0, __float_as_int(x), 0xB1, 0xF, 0xF, true)); }
DI float dpp_x2(float x) { return __int_as_float(__builtin_amdgcn_update_dpp(0, __float_as_int(x), 0x4E, 0xF, 0xF, true)); }
DI void hgrn_scan(const Params& p, char* shm) {
    OPAQUE_IDS
    constexpr int TCH = 32;
    const unsigned char* P = p.ws + WS_P;
    const bf16_t* Qh = (const bf16_t*)(P + P_HQ); const bf16_t* V = (const bf16_t*)(P + P_HV);
    float* fL = (float*)shm; float* qL = fL + TCH * 128; float* vL = qL + TCH * 128; float* pL = vL + TCH * 64;
    const int tid = tx, w = tid >> 6, lane = tid & 63, kg = lane & 3, vg = lane >> 2;
    for (int u = bx; u < 256; u += gridDim.x) {
        const int slice = u & 1, dir = (u >> 1) & 1, head = (u >> 2) & 7, b = u >> 5;
        const float* F = (const float*)(P + (dir ? P_HF1 : P_HF0)); bf16_t* Oo = dir ? (bf16_t*)(p.ws + WS_P + P_HOB) : (bf16_t*)(p.ws + WS_H);
        f32x2 s[4][2];
#pragma unroll
        for (int i = 0; i < 4; ++i) { s[i][0] = (f32x2){0.f, 0.f}; s[i][1] = (f32x2){0.f, 0.f}; }
        const int ltok = tid >> 5, lk4 = (tid & 31) * 4, vtok = tid >> 4, lv4 = (tid & 15) * 4;
        f32x4 fr[2]; u32x2 qr[2]; u32x2 vr;
#define HG_ROW(tau) ((size_t)b * LT + (dir == 0 ? (tau) : ((tau) < LC ? (LC - 1 - (tau)) : (LT + LC - 1 - (tau)))))
#define HG_LOAD(ch) do { _Pragma("unroll") for (int i_ = 0; i_ < 2; ++i_) { const size_t row = HG_ROW((ch) * TCH + ltok + 16 * i_); fr[i_] = *(const f32x4*)(F + row * D + head * 128 + lk4); \
            qr[i_] = *(const u32x2*)(Qh + row * D + head * 128 + lk4); } \
            { const size_t row = HG_ROW((ch) * TCH + vtok); vr = *(const u32x2*)(V + row * D + head * 128 + slice * 64 + lv4); } } while (0)
        HG_LOAD(0);
        for (int ch = 0; ch < LT / TCH; ++ch) {
            __syncthreads();
#pragma unroll
            for (int i_ = 0; i_ < 2; ++i_) { *(f32x4*)(fL + (ltok + 16 * i_) * 128 + lk4) = fr[i_];
                *(f32x4*)(qL + (ltok + 16 * i_) * 128 + lk4) = (f32x4){bflo(qr[i_].x), bfhi(qr[i_].x), bflo(qr[i_].y), bfhi(qr[i_].y)}; }
            *(f32x4*)(vL + vtok * 64 + lv4) = (f32x4){bflo(vr.x), bfhi(vr.x), bflo(vr.y), bfhi(vr.y)};
            __syncthreads();
            if (ch + 1 < LT / TCH) HG_LOAD(ch + 1);
#pragma unroll 4
            for (int tok = 0; tok < TCH; ++tok) {
                const f32x4 f4 = *(const f32x4*)(fL + tok * 128 + w * 16 + kg * 4), q4 = *(const f32x4*)(qL + tok * 128 + w * 16 + kg * 4), v4 = *(const f32x4*)(vL + tok * 64 + vg * 4);
                const f32x2 va = (f32x2){v4[0], v4[1]}, vb = (f32x2){v4[2], v4[3]}; f32x2 oa = (f32x2){0.f, 0.f}, ob = (f32x2){0.f, 0.f};
#pragma unroll
                for (int ki = 0; ki < 4; ++ki) { const f32x2 f2 = (f32x2){f4[ki], f4[ki]}, q2 = (f32x2){q4[ki], q4[ki]};
                    f32x2 d = s[ki][0] - va; s[ki][0] = f2 * d + va; oa += s[ki][0] * q2;
                    d = s[ki][1] - vb; s[ki][1] = f2 * d + vb; ob += s[ki][1] * q2; }
                f32x4 o4 = (f32x4){oa[0], oa[1], ob[0], ob[1]};
#pragma unroll
                for (int e = 0; e < 4; ++e) { o4[e] += dpp_x1(o4[e]); o4[e] += dpp_x2(o4[e]); }
                if (kg == 0) *(f32x4*)(pL + (w * TCH + tok) * 64 + vg * 4) = o4;
            }
            __syncthreads();
            { f32x4 a = (f32x4){0.f, 0.f, 0.f, 0.f};
#pragma unroll
              for (int ww = 0; ww < 8; ++ww) a += *(const f32x4*)(pL + (ww * TCH + vtok) * 64 + lv4);
              const size_t row = HG_ROW(ch * TCH + vtok); *(u32x2*)(Oo + row * D + head * 128 + slice * 64 + lv4) = (u32x2){pack2(a[0], a[1]), pack2(a[2], a[3])}; }
        }
#undef HG_LOAD
#undef HG_ROW
    }
    __syncthreads();
}

#define HG_ROW(b, dir, tau) ((size_t)(b) * LT + ((dir) == 0 ? (tau) : ((tau) < LC ? (LC - 1 - (tau)) : (LT + LC - 1 - (tau)))))
#define HG_MINROW(b, dir, c) ((dir) == 0 ? HG_ROW(b, 0, (c) * 16) : HG_ROW(b, 1, (c) * 16 + 15))
DI void hgrn_prep(const Params& p) {
    OPAQUE_IDS
    unsigned char* P = p.ws + WS_P; const bf16_t* Qh = (const bf16_t*)(P + P_HQ); float* EB = (float*)(p.ws + WS_EB);
    const int col2 = tx * 2;
    for (int it = bx; it < 2 * NB * 144; it += gridDim.x) {
        const int dir = it & 1, rem = it >> 1, c = rem % 144, b = rem / 144;
        float* F = (float*)(P + (dir ? P_HF1 : P_HF0));
        f32x2 f2[16]; unsigned q2[16];
#pragma unroll
        for (int t = 0; t < 16; ++t) { const size_t row = HG_ROW(b, dir, c * 16 + t); f2[t] = *(const f32x2*)(F + row * D + col2); q2[t] = *(const unsigned*)(Qh + row * D + col2); }
        unsigned qt[16], k0[8], k1[8]; float run0 = 0.f, run1 = 0.f, ka = 0.f, kb = 0.f;
#pragma unroll
        for (int t = 0; t < 16; ++t) {
            run0 += __logf(f2[t][0]); run1 += __logf(f2[t][1]);
            qt[t] = pack2(bflo(q2[t]) * __expf(run0), bfhi(q2[t]) * __expf(run1));
            const float a = (1.f - f2[t][0]) * __expf(fminf(-run0, 80.f)), bq = (1.f - f2[t][1]) * __expf(fminf(-run1, 80.f));
            if (t & 1) { k0[t >> 1] = pack2(ka, a); k1[t >> 1] = pack2(kb, bq); } else { ka = a; kb = bq; }
        }
        __syncthreads();
        unsigned char* base = (unsigned char*)F + HG_MINROW(b, dir, c) * 4096;
#pragma unroll
        for (int t = 0; t < 16; ++t) *(unsigned*)(base + t * 2048 + col2 * 2) = qt[t];
        *(u32x4*)(base + 32768 + col2 * 32) = (u32x4){k0[0], k0[1], k0[2], k0[3]}; *(u32x4*)(base + 32768 + col2 * 32 + 16) = (u32x4){k0[4], k0[5], k0[6], k0[7]};
        *(u32x4*)(base + 32768 + col2 * 32 + 32) = (u32x4){k1[0], k1[1], k1[2], k1[3]}; *(u32x4*)(base + 32768 + col2 * 32 + 48) = (u32x4){k1[4], k1[5], k1[6], k1[7]};
        *(f32x2*)(EB + ((size_t)(dir * NB + b) * 144 + c) * D + col2) = (f32x2){__expf(run0), __expf(run1)};
        __syncthreads();
    }
}
DI void hgrn_scan_mfma(const Params& p, char* shm) {
    OPAQUE_IDS
    constexpr int C = 32, QS = 272;
    const unsigned char* P = p.ws + WS_P;
    const bf16_t* V = (const bf16_t*)(P + P_HV); const float* EB = (const float*)(p.ws + WS_EB); const bf16_t* Qh = (const bf16_t*)(P + P_HQ);
    char* QtL = shm;
    char* VL = QtL + C * QS;
    char* KtL = VL + C * QS;
    float* eBL = (float*)(KtL + C * QS);
    const int tid = tx, w = tid >> 6, lane = tid & 63, l15 = lane & 15, g = lane >> 4;
    for (int u = bx; u < 128; u += gridDim.x) {
        const int dir = u & 1, head = (u >> 1) & 7, b = u >> 4;
        const unsigned char* Fb = P + (dir ? P_HF1 : P_HF0); bf16_t* Oo = dir ? (bf16_t*)(p.ws + WS_P + P_HOB) : (bf16_t*)(p.ws + WS_H);
        f32x4 S[8];
#pragma unroll
        for (int kt = 0; kt < 8; ++kt) S[kt] = (f32x4){0.f, 0.f, 0.f, 0.f};
        const int lt = tid >> 4, lp = tid & 15;
        u32x4 ra0, ra1, ra2, ra3, ra4, rb0, rb1, rb2, rb3, rb4;
#define HG_LOAD(ch, r0, r1, r2, r3, r4) do { const size_t row_ = HG_ROW(b, dir, (ch) * C + lt); const unsigned char* fr_ = Fb + row_ * 4096; \
            r0 = *(const u32x4*)(Qh + row_ * D + head * 128 + lp * 8); r1 = *(const u32x4*)(fr_ + (head * 128 + lp * 8) * 2); r2 = *(const u32x4*)(V + row_ * D + head * 128 + lp * 8); \
            r3 = *(const u32x4*)(fr_ + (1024 + head * 128 + lp * 8) * 2); \
            if (tid < 32) r4 = *(const u32x4*)(EB + ((size_t)(dir * NB + b) * 72 + (ch)) * D + head * 128 + tid * 4); } while (0)
#define HG_QE(qw, ew) pack2(bflo(qw) * bflo(ew), bfhi(qw) * bfhi(ew))
#define HG_STAGE(ch, r0, r1, r2, r3, r4) do { __syncthreads(); \
            *(u32x4*)(QtL + lt * QS + lp * 16) = (u32x4){HG_QE(r0.x, r1.x), HG_QE(r0.y, r1.y), HG_QE(r0.z, r1.z), HG_QE(r0.w, r1.w)}; *(u32x4*)(VL + lt * QS + lp * 16) = r2; \
            *(u32x4*)(KtL + lt * QS + lp * 16) = r3; if (tid < 32) *(u32x4*)((char*)eBL + tid * 16) = r4; \
            __syncthreads(); \
            if ((ch) + 2 < LT / C) HG_LOAD((ch) + 2, r0, r1, r2, r3, r4); } while (0)
        HG_LOAD(0, ra0, ra1, ra2, ra3, ra4); HG_LOAD(1, rb0, rb1, rb2, rb3, rb4);
        for (int ch2 = 0; ch2 < LT / C; ch2 += 2) {
#pragma unroll
          for (int hh = 0; hh < 2; ++hh) {
            const int ch = ch2 + hh;
            if (hh == 0) HG_STAGE(ch, ra0, ra1, ra2, ra3, ra4); else HG_STAGE(ch, rb0, rb1, rb2, rb3, rb4);
            { const bf16_t* kt16 = (const bf16_t*)KtL; const bf16_t* v16 = (const bf16_t*)VL; const int vcol = w * 16 + l15;
#define HG_U2(arr, r_a, r_b, c_) ((unsigned)(arr)[(r_a) * (QS / 2) + (c_)] | ((unsigned)(arr)[(r_b) * (QS / 2) + (c_)] << 16))
              const bf16x8 vf = __builtin_bit_cast(bf16x8, (u32x4){HG_U2(v16, g * 4 + 0, g * 4 + 1, vcol), HG_U2(v16, g * 4 + 2, g * 4 + 3, vcol), HG_U2(v16, 16 + g * 4 + 0, 16 + g * 4 + 1, vcol), HG_U2(v16, 16 + g * 4 + 2, 16 + g * 4 + 3, vcol)});
              f32x4 sc00 = (f32x4){0.f, 0.f, 0.f, 0.f}, sc01 = sc00, sc11 = sc00, o0 = sc00, o1 = sc00;
#pragma unroll
              for (int kc = 0; kc < 4; ++kc) {
                  const bf16x8 aK0 = *(const bf16x8*)(KtL + l15 * QS + kc * 64 + g * 16), aK1 = *(const bf16x8*)(KtL + (16 + l15) * QS + kc * 64 + g * 16);
                  const bf16x8 bQ0 = *(const bf16x8*)(QtL + l15 * QS + kc * 64 + g * 16), bQ1 = *(const bf16x8*)(QtL + (16 + l15) * QS + kc * 64 + g * 16);
                  sc00 = __builtin_amdgcn_mfma_f32_16x16x32_bf16(aK0, bQ0, sc00, 0, 0, 0);
                  sc01 = __builtin_amdgcn_mfma_f32_16x16x32_bf16(aK0, bQ1, sc01, 0, 0, 0);
                  sc11 = __builtin_amdgcn_mfma_f32_16x16x32_bf16(aK1, bQ1, sc11, 0, 0, 0);
                  const int kp = kc;
                  const u32x2 qa0 = *(const u32x2*)(QtL + l15 * QS + ((2 * kp) * 16 + g * 4) * 2), qb0 = *(const u32x2*)(QtL + l15 * QS + ((2 * kp + 1) * 16 + g * 4) * 2);
                  const u32x2 qa1 = *(const u32x2*)(QtL + (16 + l15) * QS + ((2 * kp) * 16 + g * 4) * 2), qb1 = *(const u32x2*)(QtL + (16 + l15) * QS + ((2 * kp + 1) * 16 + g * 4) * 2);
                  const bf16x8 sw = __builtin_bit_cast(bf16x8, (u32x4){pack2(S[2 * kp][0], S[2 * kp][1]), pack2(S[2 * kp][2], S[2 * kp][3]), pack2(S[2 * kp + 1][0], S[2 * kp + 1][1]), pack2(S[2 * kp + 1][2], S[2 * kp + 1][3])});
                  o0 = __builtin_amdgcn_mfma_f32_16x16x32_bf16(__builtin_bit_cast(bf16x8, (u32x4){qa0.x, qa0.y, qb0.x, qb0.y}), sw, o0, 0, 0, 0);
                  o1 = __builtin_amdgcn_mfma_f32_16x16x32_bf16(__builtin_bit_cast(bf16x8, (u32x4){qa1.x, qa1.y, qb1.x, qb1.y}), sw, o1, 0, 0, 0); }
#pragma unroll
              for (int r = 0; r < 4; ++r) if (g * 4 + r > l15) { sc00[r] = 0.f; sc11[r] = 0.f; }
              o0 = __builtin_amdgcn_mfma_f32_16x16x32_bf16(__builtin_bit_cast(bf16x8, (u32x4){pack2(sc00[0], sc00[1]), pack2(sc00[2], sc00[3]), 0u, 0u}), vf, o0, 0, 0, 0);
              o1 = __builtin_amdgcn_mfma_f32_16x16x32_bf16(__builtin_bit_cast(bf16x8, (u32x4){pack2(sc01[0], sc01[1]), pack2(sc01[2], sc01[3]), pack2(sc11[0], sc11[1]), pack2(sc11[2], sc11[3])}), vf, o1, 0, 0, 0);
#pragma unroll
              for (int r = 0; r < 4; ++r) { const size_t rw0 = HG_ROW(b, dir, ch * C + g * 4 + r), rw1 = HG_ROW(b, dir, ch * C + 16 + g * 4 + r);
                  Oo[rw0 * D + head * 128 + vcol] = (bf16_t)(pack2(o0[r], 0.f) & 0xffffu); Oo[rw1 * D + head * 128 + vcol] = (bf16_t)(pack2(o1[r], 0.f) & 0xffffu); }
#pragma unroll
              for (int kt = 0; kt < 8; ++kt) { const f32x4 dcy = *(const f32x4*)(eBL + kt * 16 + g * 4); const int kcol = kt * 16 + l15;
                  const bf16x8 kl = __builtin_bit_cast(bf16x8, (u32x4){HG_U2(kt16, g * 4 + 0, g * 4 + 1, kcol), HG_U2(kt16, g * 4 + 2, g * 4 + 3, kcol), HG_U2(kt16, 16 + g * 4 + 0, 16 + g * 4 + 1, kcol), HG_U2(kt16, 16 + g * 4 + 2, 16 + g * 4 + 3, kcol)});
                  S[kt] = __builtin_amdgcn_mfma_f32_16x16x32_bf16(kl, vf, S[kt], 0, 0, 0) * dcy; }
#undef HG_U2
            }
          }
        }
#undef HG_STAGE
#undef HG_QE
#undef HG_LOAD
    }
    __syncthreads();
}

#define XB_TMO      128
#define XB_XCNT(j)  (256  + 64 * (j))
#define XB_XSUB(j)  (1280 + 64 * (j))
#define XB_XGEN(j)  (2304 + 64 * (j))
#define XB_TOP      3328
#define XB_TOPGEN   3392
#define XCD_BAR_WORDS 3456
#define XB_SPIN_CAP (1u << 22)
DI unsigned xb_ld(unsigned* p)              { return __hip_atomic_load(p, __ATOMIC_RELAXED, __HIP_MEMORY_SCOPE_AGENT); }
DI unsigned xb_add(unsigned* p, unsigned v) { return __hip_atomic_fetch_add(p, v, __ATOMIC_RELAXED, __HIP_MEMORY_SCOPE_AGENT); }
DI unsigned xb_xcc_id() { return (unsigned)__builtin_amdgcn_s_getreg((3 << 11) | 20) & 0xFu; }
#define XB_SPIN(cond, bar) do { unsigned _sp = 0; while (cond) { __builtin_amdgcn_s_sleep(1); \
    if ((++_sp & 255u) == 0u) { if (xb_ld(&(bar)[XB_TMO])) break; if (_sp > XB_SPIN_CAP) { atomicAdd(&(bar)[XB_TMO], 1u); break; } } } } while (0)
struct XcdBarrier { unsigned* bar; unsigned x; volatile LAS unsigned* st; };
DI XcdBarrier xcd_barrier_post(unsigned* bar, volatile LAS unsigned* st) {
    XcdBarrier b; b.bar = bar; b.x = xb_xcc_id(); b.st = st;
    if (threadIdx.x == 0) (void)xb_add(&bar[XB_XCNT(b.x)], 1u);
    return b;
}
DI void xcd_barrier_complete(unsigned* bar, unsigned x, unsigned& nloc, unsigned& nx) {
    const unsigned G = gridDim.x * gridDim.y * gridDim.z;
    unsigned sum, cnt, mine, sp = 0u;
    for (;;) {
        sum = 0u; cnt = 0u; mine = 0u;
#pragma unroll
        for (unsigned j = 0; j < 16; ++j) { const unsigned c = xb_ld(&bar[XB_XCNT(j)]); sum += c; cnt += (c > 0u) ? 1u : 0u; mine = (j == x) ? c : mine; }
        if (sum == G) break;
        __builtin_amdgcn_s_sleep(1);
        if ((++sp & 255u) == 0u) { if (xb_ld(&bar[XB_TMO])) break; if (sp > XB_SPIN_CAP) { atomicAdd(&bar[XB_TMO], 1u); break; } }
    }
    nloc = mine > 0u ? mine : 1u; nx = cnt > 0u ? cnt : 1u;
}
DI void xcd_barrier(const XcdBarrier& b) {
    asm volatile("s_waitcnt vmcnt(0)" ::: "memory");
    __syncthreads();
    if (threadIdx.x == 0) {
        unsigned* bar = b.bar;
        __builtin_amdgcn_s_waitcnt(0);
        unsigned nloc = b.st[0], nx = b.st[1];
        if (nloc == 0u) { xcd_barrier_complete(bar, b.x, nloc, nx); b.st[0] = nloc; b.st[1] = nx; }
        const unsigned old = xb_add(&bar[XB_XSUB(b.x)], 1u);
        const unsigned gen = old / nloc;
        if (old + 1u == (gen + 1u) * nloc) {
            __builtin_amdgcn_fence(__ATOMIC_RELEASE, "agent");
            asm volatile("s_waitcnt vmcnt(0)" ::: "memory");
            const unsigned og = xb_add(&bar[XB_TOP], 1u);
            const unsigned tg = og / nx;
            if (og + 1u == (tg + 1u) * nx) xb_add(&bar[XB_TOPGEN], 1u);
            else XB_SPIN(xb_ld(&bar[XB_TOPGEN]) == tg, bar);
            __builtin_amdgcn_fence(__ATOMIC_ACQUIRE, "agent");
            xb_add(&bar[XB_XGEN(b.x)], 1u);
            asm volatile("s_waitcnt vmcnt(0)" ::: "memory");
        } else {
            XB_SPIN(xb_ld(&bar[XB_XGEN(b.x)]) == gen, bar);
            __builtin_amdgcn_fence(__ATOMIC_ACQUIRE, "agent");
            asm volatile("s_waitcnt vmcnt(0)" ::: "memory");
        }
    }
    __syncthreads();
}

template <int layer>
DI void layer_body(const Params& p, const XcdBarrier& xb, char* shm) {
    unsigned char* P = p.ws + WS_P;
    bf16_t* H = (bf16_t*)(p.ws + WS_H);
    bf16_t* wfi = (bf16_t*)(p.ws + WS_WFI); bf16_t* wfo = (bf16_t*)(p.ws + WS_WFO); bf16_t* wmi = (bf16_t*)(p.ws + WS_WMI); bf16_t* wmo = (bf16_t*)(p.ws + WS_WMO);
    const float* modall = (const float*)(p.ws + WS_MOD);
    float* ctxres = (float*)(p.ws + WS_CTXRES);
    (void)wmi; (void)H;
        const float* mod = modall + (size_t)layer * 9 * 6144;
        const bool last = layer == 3;
        PH(0) if (layer > 0) convert_layer(p, layer, shm);
        PH(1) norm_phase(p, layer, 0, false, layer > 0 ? (const float*)(P + P_PARTF) : nullptr, 8, layer == 0 ? 1 : 0);
        xcd_barrier(xb);
        if constexpr (layer == 0) {
            { const bf16_t* cdt = (const bf16_t*)(P + P_CDT); bf16_t* gtl = (bf16_t*)(P + P_GTL); bf16_t* gtc = (bf16_t*)(P + P_GTC);
              gemm_loop(NB * 72, 1024, shm,
                  [&](int L) { const int b = L / 72, r2 = L % 72, pm = r2 / 9, pn = r2 % 9, k0 = (pm & 3) * 256; return Tile{cdt + k0, H + (size_t)b * LT * D + k0, 1024, D, 256, pm * 256, pn * 256}; },
                  [&](int L, const AccT& acc, int brow, int bcol, int wr, int wc, int fr, int fq) { EpiFnet1 e{gtl, gtc, L / 72}; e(acc, brow, bcol, wr, wc, fr, fq); }); }
            xcd_barrier(xb);
            { const bf16_t* wl = (const bf16_t*)(P + P_WL); const bf16_t* wc = (const bf16_t*)(P + P_WC); bf16_t* Yb = (bf16_t*)(P + P_YB);
              const bf16_t* gtl = (const bf16_t*)(P + P_GTL); const bf16_t* gtc = (const bf16_t*)(P + P_GTC);
              gemm_loop(NB * 32, 4096, shm,
                  [&](int L) { const int b = L >> 5, pm = (L >> 2) & 7, pn = L & 3; return Tile{wl, gtl + (size_t)b * 1024 * 4096, 4096, 4096, 4096, pm * 256, pn * 256}; },
                  [&](int L, const AccT& acc, int brow, int bcol, int wr, int wc_, int fr, int fq) { EpiBf16 e{Yb + ((size_t)(L >> 5) * LT + LC) * D, (size_t)D}; e(acc, brow, bcol, wr, wc_, fr, fq); });
              gemm_loop(NB * 4, 512, shm,
                  [&](int L) { const int b = L >> 2, pn = L & 3; return Tile{wc, gtc + (size_t)b * 1024 * 512, 512, 512, 512, 0, pn * 256}; },
                  [&](int L, const AccT& acc, int brow, int bcol, int wr, int wc_, int fr, int fq) { EpiBf16 e{Yb + ((size_t)(L >> 2) * LT) * D, (size_t)D}; e(acc, brow, bcol, wr, wc_, fr, fq); }); }
            xcd_barrier(xb);
            gemm_resid<4>((const bf16_t*)(P + P_YB), wmo, D, true, p.out, p.in[0], mod + 2 * 1024, p.in[10], (float*)(P + P_PARTO), shm);
        } else if constexpr (layer == 1) {
            { bf16_t* QK = (bf16_t*)(P + P_DQK); bf16_t* Vt = (bf16_t*)(P + P_DVT); const int n1 = 72 * 8, n2 = NB * 4 * 9;
              gemm_loop(n1 + n2, D, shm,
                  [&](int L) { if (L < n1) { int pm, pn; tile_map(L, 72, 8, pm, pn); return Tile{H, wmi, D, D, D, pm * 256, pn * 256}; }
                               const int v = L - n1, b = v / 36, r2 = v % 36, pm = r2 / 9, pn = r2 % 9; return Tile{wmi + (size_t)2048 * D, H + (size_t)b * LT * D, D, D, D, pm * 256, pn * 256}; },
                  [&](int L, const AccT& acc, int brow, int bcol, int wr, int wc, int fr, int fq) {
                      if (L < n1) { EpiBf16 e{QK, (size_t)2048}; e(acc, brow, bcol, wr, wc, fr, fq); }
                      else { EpiBf16 e{Vt + (size_t)((L - n1) / 36) * 1024 * LT, (size_t)LT}; e(acc, brow, bcol, wr, wc, fr, fq); } }); }
            xcd_barrier(xb);
            PH(2) qknorm_phase<32>((bf16_t*)(P + P_DQK), 2048, 16, p.in[12], p.in[13], 2, (const f32x2*)(p.ws + WS_ROPED), 0.125f * 1.4426950408889634f, true);
            xcd_barrier(xb);
            PH(4) attn_phase<64, 0>((const bf16_t*)(P + P_DQK), 2048, (const bf16_t*)(P + P_DVT), 1024, (bf16_t*)(P + P_DO2), 2048, 16, false, p.in[12], (const f32x2*)(p.ws + WS_ROPED), 0.125f * 1.4426950408889634f, shm);
            xcd_barrier(xb);
            { const float* lp = p.in[14]; float s01 = 0.f, s23 = 0.f;
              for (int e = 0; e < 64; ++e) { s01 += lp[e] * lp[64 + e]; s23 += lp[128 + e] * lp[192 + e]; }
              const float lam_init = 0.8f - 0.6f * expf(-0.3f * 1.f); const float lam = expf(s01) - expf(s23) + lam_init;
              PH(1) headnorm_phase<0>(p, (const bf16_t*)(P + P_DO2), nullptr, nullptr, p.in[15], lam, 1.f - lam_init); }
            xcd_barrier(xb);
            gemm_resid<4>(H, wmo, D, true, p.out, p.out, mod + 2 * 1024, nullptr, (float*)(P + P_PARTO), shm);
        } else if constexpr (layer == 2) {
            { EpiHgrn e{P, (const float*)(p.ws + WS_LBV), p.ws + WS_EB}; gemm_phase(H, D, wmi, D, 5 * D, D, false, shm, e); }
            xcd_barrier(xb);
            PH(6) hgrn_scan_mfma(p, shm);
            xcd_barrier(xb);
            PH(1) headnorm_phase<1>(p, H, (const bf16_t*)(P + P_HOB), (const bf16_t*)(P + P_HG), p.in[19], 0.f, 1.f);
            xcd_barrier(xb);
            gemm_resid<4>(H, wmo, D, true, p.out, p.out, mod + 2 * 1024, nullptr, (float*)(P + P_PARTO), shm);
        } else {
            { bf16_t* QK = (bf16_t*)(P + P_GQK); bf16_t* Vt = (bf16_t*)(P + P_GVT); const int n1 = 72 * 5, n2 = NB * 9;
              gemm_loop(n1 + n2, D, shm,
                  [&](int L) { if (L < n1) { int pm, pn; tile_map(L, 72, 5, pm, pn); return Tile{H, wmi, D, D, D, pm * 256, pn * 256}; }
                               const int v = L - n1, b = v / 9, pn = v % 9; return Tile{wmi + (size_t)1280 * D, H + (size_t)b * LT * D, D, D, D, 0, pn * 256}; },
                  [&](int L, const AccT& acc, int brow, int bcol, int wr, int wc, int fr, int fq) {
                      if (L < n1) { EpiBf16 e{QK, (size_t)1280}; e(acc, brow, bcol, wr, wc, fr, fq); }
                      else { EpiBf16 e{Vt + (size_t)((L - n1) / 9) * 256 * LT, (size_t)LT}; e(acc, brow, bcol, wr, wc, fr, fq); } }); }
            xcd_barrier(xb);
            PH(3) qknorm_phase<64>((bf16_t*)(P + P_GQK), 1280, 8, p.in[22], p.in[23], 0, (const f32x2*)(p.ws + WS_ROPEG), 0.08838834764831845f * 1.4426950408889634f, true);
            xcd_barrier(xb);
            PH(5) attn_phase<128, 1>((const bf16_t*)(P + P_GQK), 1280, (const bf16_t*)(P + P_GVT), 256, H, D, 8, true, p.in[22], (const f32x2*)(p.ws + WS_ROPEG), 0.08838834764831845f * 1.4426950408889634f, shm);
            xcd_barrier(xb);
            gemm_resid<4>(H, wmo, D, false, p.out, p.out, mod + 2 * 1024, nullptr, (float*)(P + P_PARTO), shm);
        }
        xcd_barrier(xb);
        PH(1) norm_phase(p, layer, 1, last, last ? nullptr : (const float*)(P + P_PARTO), 4, layer == 0 ? 2 : 0);
        xcd_barrier(xb);
        { EpiSwiglu e{(bf16_t*)(P + P_ACT)}; gemm_phase(H, D, wfi, D, 2 * DFF, D, last, shm, e); }
        xcd_barrier(xb);
        gemm_resid<8>((const bf16_t*)(P + P_ACT), wfo, DFF, !last, p.out, p.out, mod + 5 * 1024, nullptr, (float*)(P + P_PARTF), shm);
        if constexpr (layer < 3) xcd_barrier(xb);
    }

__global__ void __launch_bounds__(NTHR) fwd_megakernel(Params p) {
    extern __shared__ __attribute__((aligned(16))) char shm[];
    cg::grid_group grid = cg::this_grid();
    if (threadIdx.x < 4) ((unsigned*)(shm + 131072))[threadIdx.x] = 0u;
    __syncthreads();
    const XcdBarrier xb = xcd_barrier_post((unsigned*)(p.ws + WS_BAR), (volatile LAS unsigned*)(shm + 131072));
    PH(0) prologue(p, shm);
    if (p.ws == nullptr) grid.sync();
    xcd_barrier(xb);
    PH(0) mod_reduce(p);
    xcd_barrier(xb);
    layer_body<0>(p, xb, shm);
    layer_body<1>(p, xb, shm);
    layer_body<2>(p, xb, shm);
    layer_body<3>(p, xb, shm);
}

extern "C" void kernel_launch(void* const* d_in, const int* in_sizes, int n_in, void* d_out, int out_size, void* d_ws, size_t ws_size, hipStream_t stream) {
    static int grid_blocks = 0;
    if (grid_blocks == 0) {
        if (n_in != 25 || ws_size < WS_END) { fprintf(stderr, "kernel_launch: need 25 inputs and %zu bytes of workspace (got %d, %zu)\n", (size_t)WS_END, n_in, ws_size); grid_blocks = -1; return; }
        int dev = 0, cus = 0, per_cu = 0;
        hipGetDevice(&dev);
        hipDeviceGetAttribute(&cus, hipDeviceAttributeMultiprocessorCount, dev);
        if (hipFuncSetAttribute((const void*)fwd_megakernel, hipFuncAttributeMaxDynamicSharedMemorySize, LDS_BYTES) != hipSuccess) { fprintf(stderr, "kernel_launch: hipFuncSetAttribute failed\n"); grid_blocks = -1; return; }
        if (hipOccupancyMaxActiveBlocksPerMultiprocessor(&per_cu, (const void*)fwd_megakernel, NTHR, LDS_BYTES) != hipSuccess || per_cu < 1) { fprintf(stderr, "kernel_launch: occupancy query says %d blocks/CU\n", per_cu); grid_blocks = -1; return; }
        grid_blocks = cus;
    }
    if (grid_blocks < 0) return;
    if (hipMemsetAsync((char*)d_ws + WS_BAR, 0, 16384, stream) != hipSuccess) { fprintf(stderr, "kernel_launch: memset of barrier words failed\n"); return; }
    Params p{};
    for (int i = 0; i < 25; ++i) p.in[i] = (const float*)d_in[i];
    p.out = (float*)d_out; p.ws = (unsigned char*)d_ws;
    void* args[] = {&p};
    hipError_t e = hipLaunchCooperativeKernel((const void*)fwd_megakernel, dim3(grid_blocks), dim3(NTHR), args, LDS_BYTES, stream);
    if (e != hipSuccess) fprintf(stderr, "cooperative launch failed: %s (grid %d)\n", hipGetErrorString(e), grid_blocks);
}
```

```cpp
#include <hip/hip_runtime.h>
#include <hip/hip_cooperative_groups.h>
#include <cstdint>
#include <cstdio>
namespace cg = cooperative_groups;

#define DI __device__ __forceinline__
#ifndef PHMASK
#define PHMASK 0xFFFF
#endif
#define PH(bit) if ((PHMASK >> (bit)) & 1)
#define OPAQUE_IDS int tx = threadIdx.x; int bx = blockIdx.x; asm volatile("" : "+v"(tx), "+s"(bx));
typedef unsigned short bf16_t;
typedef short bf16x8 __attribute__((ext_vector_type(8)));
typedef short s16x4 __attribute__((ext_vector_type(4)));
typedef float f32x2 __attribute__((ext_vector_type(2)));
typedef float f32x4 __attribute__((ext_vector_type(4)));
typedef float f32x16 __attribute__((ext_vector_type(16)));
typedef unsigned u32x2 __attribute__((ext_vector_type(2)));
typedef unsigned u32x4 __attribute__((ext_vector_type(4)));

constexpr int NB = 8, LC = 256, LL = 2048, LT = 2304, T = NB * LT, D = 1024, DFF = 2816;
constexpr int NTHR = 512;
constexpr int LDS_BYTES = 131072 + 16;
constexpr float EPS = 1e-6f;

constexpr size_t al256(size_t x) { return (x + 255) & ~(size_t)255; }
constexpr size_t WS_CTXRES = 0;
constexpr size_t WS_MOD    = WS_CTXRES + (size_t)NB * LC * D * 4;
constexpr size_t WS_ROPED  = WS_MOD + (size_t)4 * 9 * 6144 * 4;
constexpr size_t WS_ROPEG  = WS_ROPED + (size_t)2048 * 32 * 8;
constexpr size_t WS_LBV    = WS_ROPEG + (size_t)2048 * 64 * 8;
constexpr size_t WS_WFI    = WS_LBV + 2 * 1024 * 4;
constexpr size_t WS_WFO    = WS_WFI + (size_t)5632 * 1024 * 2;
constexpr size_t WS_WMI    = WS_WFO + (size_t)1024 * 2816 * 2;
constexpr size_t WS_WMO    = WS_WMI + (size_t)5120 * 1024 * 2;
constexpr size_t WS_H      = WS_WMO + (size_t)1024 * 1024 * 2;
constexpr size_t WS_P      = WS_H + (size_t)T * D * 2;
constexpr size_t P_PART = 0;
constexpr size_t P_CDT  = P_PART + (size_t)16 * 4 * 9 * 6144 * 4;
constexpr size_t P_WL   = P_CDT + (size_t)2048 * 1024 * 2;
constexpr size_t P_WC   = P_WL + (size_t)2048 * 4096 * 2;
constexpr size_t P_GTL  = P_WC + (size_t)256 * 512 * 2;
constexpr size_t P_GTC  = P_GTL + (size_t)NB * 1024 * 4096 * 2;
constexpr size_t P_YB   = P_GTC + (size_t)NB * 1024 * 512 * 2;
constexpr size_t P_DQK = 0;
constexpr size_t P_DVT = P_DQK + (size_t)T * 2048 * 2;
constexpr size_t P_DO2 = P_DVT + (size_t)NB * 1024 * LT * 2;
constexpr size_t P_HQ  = 0;
constexpr size_t P_HF0 = P_HQ + (size_t)T * D * 2;
constexpr size_t P_HF1 = P_HF0 + (size_t)T * D * 4;
constexpr size_t P_HV  = P_HF1 + (size_t)T * D * 4;
constexpr size_t P_HG  = P_HV + (size_t)T * D * 2;
constexpr size_t P_HOB = P_HG + (size_t)T * D * 2;
constexpr size_t P_HEND = P_HOB + (size_t)T * D * 2;
constexpr size_t P_GQK = 0;
constexpr size_t P_GVT = P_GQK + (size_t)T * 1280 * 2;
constexpr size_t P_ACT = 0;
constexpr size_t P_PARTF = P_ACT + (size_t)T * DFF * 2;
constexpr size_t P_PARTO = 0;
constexpr size_t WS_BAR = WS_P + P_HEND;
constexpr size_t WS_EB  = WS_BAR + 16384;
constexpr size_t WS_END = WS_EB + (size_t)2 * NB * 144 * D * 4;

struct Params {
    const float* in[25];
    float* out;
    unsigned char* ws;
};

DI bf16_t f2bf(float x) { unsigned u = __float_as_uint(x); u += 0x7fffu + ((u >> 16) & 1u); return (bf16_t)(u >> 16); }
DI float bf2f(bf16_t v) { return __uint_as_float(((unsigned)v) << 16); }
typedef __bf16 bf16x2_t __attribute__((ext_vector_type(2)));
DI unsigned pack2(float lo, float hi) { const f32x2 v = (f32x2){lo, hi}; return __builtin_bit_cast(unsigned, __builtin_convertvector(v, bf16x2_t)); }
DI float bflo(unsigned w) { return __uint_as_float(w << 16); }
DI float bfhi(unsigned w) { return __uint_as_float(w & 0xffff0000u); }
DI float silu_f(float x) { return x / (1.f + __expf(-x)); }
DI float sigmoid_f(float x) { return 1.f / (1.f + __expf(-x)); }
DI float wave_sum(float v) {
    v += __shfl_xor(v, 32); v += __shfl_xor(v, 16); v += __shfl_xor(v, 8); v += __shfl_xor(v, 4); v += __shfl_xor(v, 2); v += __shfl_xor(v, 1);
    return v;
}
DI float* resid_row(const Params& p, int row) {
    const int b = row / LT, pos = row - b * LT;
    return pos < LC ? (float*)(p.ws + WS_CTXRES) + ((size_t)(b * LC + pos)) * D : p.out + ((size_t)(b * LL + pos - LC)) * D;
}
DI int cond_idx(int row) { const int b = row / LT, pos = row - b * LT; return pos < LC ? 8 : b; }

constexpr int BM = 256, BK = 64, HALF = 128, HTB = HALF * BK * 2;
DI int lds_byte(int r, int c) { int st = (r >> 4) * 2 + (c >> 5), rr = r & 15, cc = c & 31, ob = rr * 64 + cc * 2; return st * 1024 + (ob ^ (((ob >> 9) & 1) << 5)); }
DI void stage_rc(int b, int& R, int& C) { int st = b / 1024, sb = b % 1024, swz = sb ^ (((sb >> 9) & 1) << 5); R = (st >> 1) * 16 + swz / 64; C = (st & 1) * 32 + (swz % 64) / 2; }

typedef f32x4 AccT[2][2][4][2];

struct Tile { const bf16_t* A; const bf16_t* Bt; int lda, ldb, K, brow, bcol; };
#define LAS __attribute__((address_space(3)))
template <class Get, class Epi>
DI void gemm_loop(int ntiles, int ld, char* shm, const Get& get, const Epi& epi) {
    int tx = threadIdx.x, bx = blockIdx.x; asm volatile("" : "+v"(tx), "+s"(bx));
    if (!((PHMASK >> 7) & 1)) return;
    LAS unsigned char* lds = (LAS unsigned char*)shm;
    const int tid = tx, wid = __builtin_amdgcn_readfirstlane(tid >> 6), lane = tid & 63, wr = wid >> 2, wc = wid & 3, fr = lane & 15, fq = lane >> 4;
    unsigned voffA[2], voffB[2];
#pragma unroll
    for (int i = 0; i < 2; ++i) { int R, C; stage_rc(tid * 16 + i * 8192, R, C); const int rho = R & 31, Rb = (R & ~31) + 8 * ((rho & 15) >> 2) + 4 * (rho >> 4) + (rho & 3);
        voffA[i] = (unsigned)(R * ld + C) * 2u; voffB[i] = (unsigned)(Rb * ld + C) * 2u; }
    const size_t kstep = (size_t)(BK * 2), hstep = (size_t)HALF * ld * 2;
    const unsigned ldsw = (unsigned)wid * 1024u;
    const int aoff = lds_byte(wr * 64 + fr, fq * 8), boff = lds_byte(wc * 32 + fr, fq * 8);
#define G_SA(b, h) (((b) * 2 + (h)) * HTB)
#define G_SB(b, h) ((4 + (b) * 2 + (h)) * HTB)
#define G_STAGE(bufoff, gbase, voff) do { _Pragma("unroll") for (int _i = 0; _i < 2; ++_i) \
        __builtin_amdgcn_global_load_lds((const unsigned*)((const char*)(gbase) + voff[_i]), (LAS unsigned*)(lds + (bufoff) + ldsw + _i * 8192), 16, 0, 0); } while (0)
#define G_LDA(dst, b, h) do { _Pragma("unroll") for (int m = 0; m < 4; ++m) _Pragma("unroll") for (int k = 0; k < 2; ++k) dst[m][k] = *(const LAS bf16x8*)(lds + G_SA(b, h) + aoff + m * 2048 + k * 1024); } while (0)
#define G_LDB(dst, b, h) do { _Pragma("unroll") for (int n = 0; n < 2; ++n) _Pragma("unroll") for (int k = 0; k < 2; ++k) dst[n][k] = *(const LAS bf16x8*)(lds + G_SB(b, h) + boff + n * 2048 + k * 1024); } while (0)
#define G_MMA(ai, bj, At_, Bt_) do { __builtin_amdgcn_s_setprio(1); _Pragma("unroll") for (int m = 0; m < 4; ++m) _Pragma("unroll") for (int n = 0; n < 2; ++n) _Pragma("unroll") for (int k = 0; k < 2; ++k) \
        acc[ai][bj][m][n] = __builtin_amdgcn_mfma_f32_16x16x32_bf16(Bt_[n][k], At_[m][k], acc[ai][bj][m][n], 0, 0, 0); __builtin_amdgcn_s_setprio(0); } while (0)
#define WAIT_V(n) asm volatile("s_waitcnt vmcnt(" #n ")" ::: "memory")
#define WAIT_L(n) asm volatile("s_waitcnt lgkmcnt(" #n ")" ::: "memory")
#define BAR __builtin_amdgcn_s_barrier()
#define SCHED __builtin_amdgcn_sched_barrier(0)
    int L = bx; if (L >= ntiles) return;
    Tile cur = get(L), nxt = cur;
    AccT acc;
#define G_ZERO _Pragma("unroll") for (int a = 0; a < 2; ++a) _Pragma("unroll") for (int b = 0; b < 2; ++b) _Pragma("unroll") for (int m = 0; m < 4; ++m) _Pragma("unroll") for (int n = 0; n < 2; ++n) acc[a][b][m][n] = (f32x4){0.f, 0.f, 0.f, 0.f}
    G_ZERO;
    bf16x8 At[4][2], B0[2][2], B1[2][2];
    const char* cA = (const char*)cur.A + (size_t)cur.brow * ld * 2; const char* cB = (const char*)cur.Bt + (size_t)cur.bcol * ld * 2;
    G_STAGE(G_SB(0, 0), cB, voffB); G_STAGE(G_SB(0, 1), cB + hstep, voffB); G_STAGE(G_SA(0, 0), cA, voffA); G_STAGE(G_SA(0, 1), cA + hstep, voffA);
    if (wr == 1) BAR;
    WAIT_V(2); BAR;
    G_STAGE(G_SB(1, 0), cB + kstep, voffB); G_STAGE(G_SA(1, 0), cA + kstep, voffA); G_STAGE(G_SB(1, 1), cB + hstep + kstep, voffB);
    WAIT_V(6); BAR;
    for (;;) {
        const int Ln = L + gridDim.x; const bool has_next = Ln < ntiles; if (has_next) nxt = get(Ln);
        const char* nA = has_next ? (const char*)nxt.A + (size_t)nxt.brow * ld * 2 : cA; const char* nB = has_next ? (const char*)nxt.Bt + (size_t)nxt.bcol * ld * 2 : cB;
        const int nt = cur.K / BK;
        for (int t = 0; t < nt; t += 2) {
            const bool last = (t == nt - 2);
            const char* a1 = cA + (size_t)(t + 1) * kstep;
            const char* a2 = last ? nA : cA + (size_t)(t + 2) * kstep; const char* b2 = last ? nB : cB + (size_t)(t + 2) * kstep;
            const char* a3 = a2 + kstep; const char* b3 = b2 + kstep;
            G_LDB(B0, 0, 0); G_LDB(B1, 0, 1); SCHED; G_LDA(At, 0, 0); G_STAGE(G_SA(1, 1), a1 + hstep, voffA);
            WAIT_V(8); WAIT_L(0); BAR; G_MMA(0, 0, At, B0); G_MMA(0, 1, At, B1); BAR; SCHED;
            G_LDA(At, 0, 1); G_STAGE(G_SB(0, 0), b2, voffB); G_STAGE(G_SB(0, 1), b2 + hstep, voffB); G_STAGE(G_SA(0, 0), a2, voffA);
            WAIT_V(8); WAIT_L(0); BAR; G_MMA(1, 0, At, B0); G_MMA(1, 1, At, B1); BAR; SCHED;
            G_LDB(B0, 1, 0); G_LDB(B1, 1, 1); SCHED; G_LDA(At, 1, 0); G_STAGE(G_SA(0, 1), a2 + hstep, voffA);
            WAIT_V(8); WAIT_L(0); BAR; G_MMA(0, 0, At, B0); G_MMA(0, 1, At, B1); BAR; SCHED;
            G_LDA(At, 1, 1); G_STAGE(G_SB(1, 0), b3, voffB); G_STAGE(G_SB(1, 1), b3 + hstep, voffB); G_STAGE(G_SA(1, 0), a3, voffA);
            WAIT_V(8); WAIT_L(0); BAR; G_MMA(1, 0, At, B0); G_MMA(1, 1, At, B1); BAR; SCHED;
        }
        if (wr == 0) BAR;
        { int tx2 = threadIdx.x, brow2 = cur.brow, bcol2 = cur.bcol, Lo = L; asm volatile("" : "+v"(tx2), "+s"(brow2), "+s"(bcol2), "+s"(Lo));
          const int wid2 = tx2 >> 6, lane2 = tx2 & 63; epi(Lo, acc, brow2, bcol2, wid2 >> 2, wid2 & 3, lane2 & 15, lane2 >> 4); }
        if (!has_next) break;
        G_ZERO;
        cur = nxt; cA = nA; cB = nB; L = Ln;
        if (wr == 1) BAR;
    }
    WAIT_V(0);
    BAR;
#undef G_SA
#undef G_SB
#undef G_STAGE
#undef G_LDA
#undef G_LDB
#undef G_MMA
#undef G_ZERO
}
DI void tile_map(int L, int nM, int nN, int& pm, int& pn) {
    const int nwg = nM * nN; int wgid = L;
    { const int q = nwg / 8, r = nwg % 8, xcd = wgid % 8, off = wgid / 8; wgid = (xcd < r ? xcd * (q + 1) : r * (q + 1) + (xcd - r) * q) + off; }
    const int nig = 8 * nN, gid = wgid / nig, fm = gid * 8, gsz = (nM - fm) < 8 ? (nM - fm) : 8;
    pm = fm + ((wgid % nig) % gsz); pn = (wgid % nig) / gsz;
}

#define EPI_LOOP_ROWS _Pragma("unroll") for (int ai = 0; ai < 2; ++ai) _Pragma("unroll") for (int m = 0; m < 4; ++m)
#define EPI_LOOP_BJ _Pragma("unroll") for (int bj = 0; bj < 2; ++bj)
DI u32x4 pack8(const f32x4 a, const f32x4 b) { return (u32x4){pack2(a[0], a[1]), pack2(a[2], a[3]), pack2(b[0], b[1]), pack2(b[2], b[3])}; }

struct EpiBf16 {
    bf16_t* C; size_t ldc;
    DI void operator()(const AccT& acc, int brow, int bcol, int wr, int wc, int fr, int fq) const {
        EPI_LOOP_ROWS { const size_t row = brow + ai * 128 + wr * 64 + m * 16 + fr;
            EPI_LOOP_BJ { const int col = bcol + bj * 128 + wc * 32 + fq * 8; *(u32x4*)(C + row * ldc + col) = pack8(acc[ai][bj][m][0], acc[ai][bj][m][1]); } }
    }
};
struct EpiFnet1 {
    bf16_t* GtL; bf16_t* GtC; int b;
    DI void operator()(const AccT& acc, int brow, int bcol, int wr, int wc, int fr, int fq) const {
        const int cs = brow >= 1024; const bool isctx = bcol < LC;
        EPI_LOOP_ROWS { const int ch = brow + ai * 128 + wr * 64 + m * 16 + fr - cs * 1024;
            bf16_t* dst = isctx ? GtC + ((size_t)(b * 1024 + ch)) * 512 + cs * 256 : GtL + ((size_t)(b * 1024 + ch)) * 4096 + cs * 2048 - LC;
            EPI_LOOP_BJ { const int col = bcol + bj * 128 + wc * 32 + fq * 8; *(u32x4*)(dst + col) = pack8(acc[ai][bj][m][0], acc[ai][bj][m][1]); } }
    }
};
struct EpiResid {
    float* base; const float* src; const float* gate; const float* bias; bool rmw;
    DI void operator()(const AccT& acc, int brow, int bcol, int wr, int wc, int fr, int fq) const {
        EPI_LOOP_BJ { const int col = bcol + bj * 128 + wc * 32 + fq * 8;
            const f32x4 g0 = *(const f32x4*)(gate + col), g1 = *(const f32x4*)(gate + col + 4); f32x4 b0 = (f32x4){0.f, 0.f, 0.f, 0.f}, b1 = b0; if (bias) { b0 = *(const f32x4*)(bias + col); b1 = *(const f32x4*)(bias + col + 4); }
            EPI_LOOP_ROWS { const size_t eo = (size_t)(ai * 128 + wr * 64 + m * 16 + fr) * D + col; float* q = base + eo;
                f32x4 x0 = (f32x4){0.f, 0.f, 0.f, 0.f}, x1 = x0; if (rmw) { x0 = *(const f32x4*)(src + eo); x1 = *(const f32x4*)(src + eo + 4); }
                x0 += g0 * (acc[ai][bj][m][0] + b0); x1 += g1 * (acc[ai][bj][m][1] + b1); *(f32x4*)q = x0; *(f32x4*)(q + 4) = x1; } }
    }
};
struct EpiSwiglu {
    bf16_t* ACT;
    DI void operator()(const AccT& acc, int brow, int bcol, int wr, int wc, int fr, int fq) const {
        const int col = (bcol >> 1) + wc * 32 + fq * 8;
        EPI_LOOP_ROWS { const size_t row = brow + ai * 128 + wr * 64 + m * 16 + fr; f32x4 o[2];
#pragma unroll
            for (int n = 0; n < 2; ++n) { const f32x4 g = acc[ai][0][m][n], u = acc[ai][1][m][n];
#pragma unroll
                for (int j = 0; j < 4; ++j) o[n][j] = silu_f(g[j]) * u[j]; }
            *(u32x4*)(ACT + row * DFF + col) = pack8(o[0], o[1]); }
    }
};
template <int CTRL> DI float dpp_f(float x) { return __int_as_float(__builtin_amdgcn_update_dpp(0, __float_as_int(x), CTRL, 0xF, 0xF, true)); }
struct EpiHgrn {
    unsigned char* P; const float* lbv; unsigned char* ebase;
    DI void operator()(const AccT& acc, int brow, int bcol, int wr, int wc, int fr, int fq) const {
        const int seg = bcol >> 10, cb = bcol & 1023;
        EPI_LOOP_BJ { const int col = cb + bj * 128 + wc * 32 + fq * 8;
            if (seg == 1 || seg == 2) {
                const int dir = seg - 1;
                const f32x4 lb0 = *(const f32x4*)(lbv + dir * 1024 + col), lb1 = *(const f32x4*)(lbv + dir * 1024 + col + 4);
                bf16_t* EK = (bf16_t*)(P + (dir ? P_HF1 : P_HF0)); float* EBp = (float*)(ebase);
                const int lane_ = fq * 16 + fr;
#pragma unroll
                for (int ai = 0; ai < 2; ++ai)
#pragma unroll
                for (int mp = 0; mp < 2; ++mp) {
                    const size_t row0 = brow + ai * 128 + wr * 64 + mp * 32 + fr, row1 = row0 + 16;
                    float fa[8], fb[8], xa[8], xb[8];
#pragma unroll
                    for (int j = 0; j < 4; ++j) { fa[j] = lb0[j] + (1.f - lb0[j]) * sigmoid_f(acc[ai][bj][2 * mp][0][j]); fa[4 + j] = lb1[j] + (1.f - lb1[j]) * sigmoid_f(acc[ai][bj][2 * mp][1][j]);
                                                  fb[j] = lb0[j] + (1.f - lb0[j]) * sigmoid_f(acc[ai][bj][2 * mp + 1][0][j]); fb[4 + j] = lb1[j] + (1.f - lb1[j]) * sigmoid_f(acc[ai][bj][2 * mp + 1][1][j]); }
#pragma unroll
                    for (int j = 0; j < 8; ++j) { float x = __logf(fa[j]), y = __logf(fb[j]);
                        if (dir == 0) { x += dpp_f<0x111>(x); x += dpp_f<0x112>(x); x += dpp_f<0x114>(x); x += dpp_f<0x118>(x);
                                        y += dpp_f<0x111>(y); y += dpp_f<0x112>(y); y += dpp_f<0x114>(y); y += dpp_f<0x118>(y);
                                        y += __shfl(x, (lane_ & 48) | 15); }
                        else { x += dpp_f<0x101>(x); x += dpp_f<0x102>(x); x += dpp_f<0x104>(x); x += dpp_f<0x108>(x);
                               y += dpp_f<0x101>(y); y += dpp_f<0x102>(y); y += dpp_f<0x104>(y); y += dpp_f<0x108>(y);
                               x += __shfl(y, lane_ & 48); }
                        xa[j] = x; xb[j] = y; }
                    f32x4 e0, e1, k0, k1;
#pragma unroll
                    for (int j = 0; j < 4; ++j) { e0[j] = __expf(xa[j]); e1[j] = __expf(xa[4 + j]); k0[j] = (1.f - fa[j]) * __expf(fminf(-xa[j], 80.f)); k1[j] = (1.f - fa[4 + j]) * __expf(fminf(-xa[4 + j], 80.f)); }
                    *(u32x4*)(EK + row0 * 2048 + col) = pack8(e0, e1); *(u32x4*)(EK + row0 * 2048 + 1024 + col) = pack8(k0, k1);
                    if (dir == 1 && fr == 0) { const int b_ = (int)(row0 / LT), pos = (int)(row0 - (size_t)b_ * LT); const int tau = pos < LC ? LC - 1 - pos : LT + LC - 1 - pos;
                        float* ep = EBp + ((size_t)(NB + b_) * 72 + (tau >> 5)) * D + col; *(f32x4*)ep = e0; *(f32x4*)(ep + 4) = e1; }
#pragma unroll
                    for (int j = 0; j < 4; ++j) { e0[j] = __expf(xb[j]); e1[j] = __expf(xb[4 + j]); k0[j] = (1.f - fb[j]) * __expf(fminf(-xb[j], 80.f)); k1[j] = (1.f - fb[4 + j]) * __expf(fminf(-xb[4 + j], 80.f)); }
                    *(u32x4*)(EK + row1 * 2048 + col) = pack8(e0, e1); *(u32x4*)(EK + row1 * 2048 + 1024 + col) = pack8(k0, k1);
                    if (dir == 0 && fr == 15) { const int b_ = (int)(row1 / LT), pos = (int)(row1 - (size_t)b_ * LT);
                        float* ep = EBp + ((size_t)b_ * 72 + (pos >> 5)) * D + col; *(f32x4*)ep = e0; *(f32x4*)(ep + 4) = e1; }
                }
            } else {
                bf16_t* C = (bf16_t*)(P + (seg == 0 ? P_HQ : (seg == 3 ? P_HV : P_HG)));
                EPI_LOOP_ROWS { const size_t row = brow + ai * 128 + wr * 64 + m * 16 + fr; f32x4 v0 = acc[ai][bj][m][0], v1 = acc[ai][bj][m][1];
                    if (seg == 0) {
#pragma unroll
                        for (int j = 0; j < 4; ++j) { v0[j] = silu_f(v0[j]); v1[j] = silu_f(v1[j]); } }
                    *(u32x4*)(C + row * D + col) = pack8(v0, v1); }
            } }
    }
};

template <class Epi>
DI void gemm_phase(const bf16_t* A, int lda, const bf16_t* Bt, int ldb, int N, int K, bool lat_only, char* shm, const Epi& epi) {
    const int nM = lat_only ? 64 : 72, nN = N / BM;
    gemm_loop(nM * nN, lda, shm, [&](int L) { int pm, pn; tile_map(L, nM, nN, pm, pn); if (lat_only) pm = (pm >> 3) * 9 + 1 + (pm & 7); return Tile{A, Bt, lda, ldb, K, pm * BM, pn * BM}; },
              [&](int, const AccT& acc, int brow, int bcol, int wr, int wc, int fr, int fq) { epi(acc, brow, bcol, wr, wc, fr, fq); });
}
template <int S>
DI void gemm_resid(const bf16_t* A, const bf16_t* Bt, int K, bool with_ctx, float* out, const float* xin, const float* gate, const float* bias, float* part, char* shm) {
    const int U = K / 128, ub = U / S, ur = U % S;
    gemm_loop(256 + (with_ctx ? 32 * S : 0), K, shm,
              [&](int L) { if (L < 256) { int pm, pn; tile_map(L, 64, 4, pm, pn); pm = (pm >> 3) * 9 + 1 + (pm & 7); return Tile{A, Bt, K, K, K, pm * BM, pn * BM}; }
                           const int v = L - 256, s = v % S, tt = v / S, b = tt >> 2, pn = tt & 3; const int u0 = s * ub + (s < ur ? s : ur), nu = ub + (s < ur ? 1 : 0);
                           return Tile{A + u0 * 128, Bt + u0 * 128, K, K, nu * 128, b * LT, pn * BM}; },
              [&](int L, const AccT& acc, int brow, int bcol, int wr, int wc, int fr, int fq) {
                  const int b = brow / LT; EpiResid e;
                  if (L < 256) { const size_t ro = ((size_t)(b * LL + (brow - b * LT) - LC)) * D; e.base = out + ro; e.src = xin + ro; e.gate = gate + (size_t)b * 6144; e.bias = bias; e.rmw = true; }
                  else { const int s = (L - 256) % S; e.base = part + ((size_t)s * NB * LC + b * LC) * D; e.src = e.base; e.gate = gate + (size_t)8 * 6144; e.bias = s == 0 ? bias : nullptr; e.rmw = false; }
                  e(acc, brow, bcol, wr, wc, fr, fq); });
}

DI void conv_T(const float* __restrict__ src, int ldsrc, int c0, int K, int N, bf16_t* __restrict__ dst, int mode, char* shm) {
    OPAQUE_IDS
    float* tile = (float*)shm;
    const int nk = K / 64, ns = N / 256, tid = tx;
    for (int L = bx; L < nk * ns; L += gridDim.x) {
        const int tk = L % nk, ts = L / nk, n0 = ts * 256;
        __syncthreads();
        f32x4 v[8];
#pragma unroll
        for (int i = 0; i < 8; ++i) { const int e = tid + i * NTHR, kk = e >> 6, n4 = (e & 63) * 4;
            const int scol = mode == 1 ? ((n4 >> 7) ? 2816 + ts * 128 + (n4 & 127) : ts * 128 + n4) : c0 + n0 + n4;
            v[i] = *(const f32x4*)(src + (size_t)(tk * 64 + kk) * ldsrc + scol); }
#pragma unroll
        for (int i = 0; i < 8; ++i) { const int e = tid + i * NTHR, kk = e >> 6, n4 = (e & 63) * 4; *(f32x4*)(tile + kk * 260 + (n4 ^ (((kk >> 3) & 7) << 3))) = v[i]; }
        __syncthreads();
#pragma unroll
        for (int i = 0; i < 4; ++i) { const int n = (tid >> 3) + 64 * i, m = tid & 7, kc = m * 8; const float* tp = tile + kc * 260 + (n ^ (m << 3)); u32x4 w;
            w.x = pack2(tp[0], tp[260]); w.y = pack2(tp[2 * 260], tp[3 * 260]); w.z = pack2(tp[4 * 260], tp[5 * 260]); w.w = pack2(tp[6 * 260], tp[7 * 260]);
            *(u32x4*)(dst + (size_t)(n0 + n) * K + tk * 64 + kc) = w; }
    }
    __syncthreads();
}
DI void convert_layer(const Params& p, int i, char* shm) {
    bf16_t* wfi = (bf16_t*)(p.ws + WS_WFI); bf16_t* wfo = (bf16_t*)(p.ws + WS_WFO); bf16_t* wmi = (bf16_t*)(p.ws + WS_WMI); bf16_t* wmo = (bf16_t*)(p.ws + WS_WMO);
    conv_T(p.in[7] + (size_t)i * D * 2 * DFF, 2 * DFF, 0, D, 2 * DFF, wfi, 1, shm);
    conv_T(p.in[8] + (size_t)i * DFF * D, D, 0, DFF, D, wfo, 0, shm);
    if (i == 0) { conv_T(p.in[9], D, 0, D, D, wmo, 0, shm); }
    else if (i == 1) { conv_T(p.in[11], 3 * D, 0, D, 3 * D, wmi, 0, shm); conv_T(p.in[16], D, 0, D, D, wmo, 0, shm); }
    else if (i == 2) { conv_T(p.in[17], 5 * D, 0, D, 5 * D, wmi, 0, shm); conv_T(p.in[20], D, 0, D, D, wmo, 0, shm); }
    else { conv_T(p.in[21], 1536, 0, D, 1536, wmi, 0, shm); conv_T(p.in[24], D, 0, D, D, wmo, 0, shm); }
}

DI void prologue(const Params& p, char* shm) {
    OPAQUE_IDS
    const size_t gtid = (size_t)bx * NTHR + tx, gn = (size_t)gridDim.x * NTHR;
    { float* cond = (float*)shm;
      float* part = (float*)(p.ws + WS_P + P_PART);
      for (int it = bx; it < 4 * 16 * 12; it += gridDim.x) {
          const int cb = it % 12, ks = (it / 12) % 16, Ly = it / (12 * 16);
          __syncthreads();
          for (int e = tx; e < 9 * 64; e += NTHR) { const int ci = e >> 6, k = ks * 64 + (e & 63); const float v = ci < 8 ? p.in[1][ci * D + k] : p.in[3][k]; cond[e] = silu_f(v); }
          __syncthreads();
          const int col = cb * 512 + tx; const float* w = p.in[4] + ((size_t)Ly * D + ks * 64) * 6144 + col;
          float a[9];
#pragma unroll
          for (int c = 0; c < 9; ++c) a[c] = 0.f;
          for (int k = 0; k < 64; ++k) { const float wv = w[(size_t)k * 6144];
#pragma unroll
              for (int c = 0; c < 9; ++c) a[c] += cond[c * 64 + k] * wv; }
#pragma unroll
          for (int c = 0; c < 9; ++c) part[(((size_t)ks * 4 + Ly) * 9 + c) * 6144 + col] = a[c];
      }
      __syncthreads(); }
    { f32x2* rd = (f32x2*)(p.ws + WS_ROPED); f32x2* rg = (f32x2*)(p.ws + WS_ROPEG);
      for (size_t i = gtid; i < (size_t)2048 * 32; i += gn) { const int pos = (int)(i >> 5), pp = (int)(i & 31); const int j = pp & 15; const float inv = exp2f(-(float)j * (13.287712379549449f / 16.f));
          const float ang = (float)(pp < 16 ? (pos >> 6) : (pos & 63)) * inv; float s, c; sincosf(ang, &s, &c); rd[i] = (f32x2){c, s}; }
      for (size_t i = gtid; i < (size_t)2048 * 64; i += gn) { const int pos = (int)(i >> 6), pp = (int)(i & 63); const int j = pp & 31; const float inv = exp2f(-(float)j * (13.287712379549449f / 32.f));
          const float ang = (float)(pp < 32 ? (pos >> 6) : (pos & 63)) * inv; float s, c; sincosf(ang, &s, &c); rg[i] = (f32x2){c, s}; } }
    { float* lbv = (float*)(p.ws + WS_LBV); const float* lbp = p.in[18];
      for (size_t i = gtid; i < 2048; i += gn) { const int d = (int)(i >> 10), c = (int)(i & 1023); const float* q = lbp + (size_t)d * 4 * 1024 + c;
          const float v0 = q[0], v1 = q[1024], v2 = q[2048], v3 = q[3072]; const float mx = fmaxf(fmaxf(v0, v1), fmaxf(v2, v3));
          const float e0 = expf(v0 - mx), e1 = expf(v1 - mx), e2 = expf(v2 - mx), e3 = expf(v3 - mx); lbv[i] = (e1 + e2) / (e0 + e1 + e2 + e3); } }
    { bf16_t* cdt = (bf16_t*)(p.ws + WS_P + P_CDT); bf16_t* wl = (bf16_t*)(p.ws + WS_P + P_WL); bf16_t* wc = (bf16_t*)(p.ws + WS_P + P_WC);
      const float sc128 = 0.08838834764831845f, sc2048 = 0.022097086912079608f, sc256 = 0.0625f;
      for (size_t i = gtid; i < (size_t)2048 * 1024; i += gn) { const int m = (int)(i >> 10), k = (int)(i & 1023); const int cs = m >> 10, ch = m & 1023; float v = 0.f;
          if ((ch >> 7) == (k >> 7)) { const int e = ((ch & 127) * (k & 127)) & 127; const float a = (float)e * (2.f / 128.f); v = (cs ? sinpif(a) : cospif(a)) * sc128; }
          cdt[i] = f2bf(v); }
      for (size_t i = gtid; i < (size_t)2048 * 4096; i += gn) { const int kf = (int)(i >> 12), kk = (int)(i & 4095); const int cs = kk >> 11, t = kk & 2047; const int e = (kf * t) & 2047;
          const float a = (float)e * (2.f / 2048.f); wl[i] = f2bf((cs ? -sinpif(a) : cospif(a)) * sc2048); }
      for (size_t i = gtid; i < (size_t)256 * 512; i += gn) { const int kf = (int)(i >> 9), kk = (int)(i & 511); const int cs = kk >> 8, t = kk & 255; const int e = (kf * t) & 255;
          const float a = (float)e * (2.f / 256.f); wc[i] = f2bf((cs ? -sinpif(a) : cospif(a)) * sc256); } }
    convert_layer(p, 0, shm);
}
DI void mod_reduce(const Params& p) {
    OPAQUE_IDS
    const size_t gtid = (size_t)bx * NTHR + tx, gn = (size_t)gridDim.x * NTHR;
    const float* part = (const float*)(p.ws + WS_P + P_PART); float* mod = (float*)(p.ws + WS_MOD);
    for (size_t i = gtid; i < (size_t)4 * 9 * 6144; i += gn) { const int col = (int)(i % 6144), Ly = (int)(i / (9 * 6144));
        float a = p.in[5][(size_t)Ly * 6144 + col];
        for (int ks = 0; ks < 16; ++ks) a += part[(size_t)ks * 4 * 9 * 6144 + i];
        mod[i] = a; }
}

DI void norm_phase(const Params& p, int layer, int which, bool lat_only, const float* __restrict__ part, int npart, int srcmode) {
    OPAQUE_IDS
    const int lane = tx & 63, gw = bx * 8 + (tx >> 6);
    const float* gain = p.in[6] + ((size_t)layer * 2 + which) * D; const float* mod = (const float*)(p.ws + WS_MOD) + (size_t)layer * 9 * 6144;
    bf16_t* H = (bf16_t*)(p.ws + WS_H);
    f32x4 gm[4], sh[4]; int cur_ci = -1;
    const int nw = gridDim.x * 8;
    for (int vw = gw; vw < NB * 256; vw += nw)
    for (int i0 = 0; i0 < 9; i0 += 3) {
        const int r0 = (vw >> 8) * LT + (vw & 255) + 256 * i0;
        f32x4 v[3][4]; float ss[3]; bool ok[3];
#pragma unroll
        for (int q = 0; q < 3; ++q) {
            const int row = r0 + 256 * q; const int b = row / LT, pos = row - b * LT;
            ok[q] = !(lat_only && pos < LC); ss[q] = 0.f;
            if (ok[q]) {
                float* x = resid_row(p, row);
                const float* xs = (srcmode == 1 || (srcmode == 2 && pos < LC)) ? (pos < LC ? p.in[2] + ((size_t)(b * LC + pos)) * D : p.in[0] + ((size_t)(b * LL + pos - LC)) * D) : x;
#pragma unroll
                for (int j = 0; j < 4; ++j) v[q][j] = *(const f32x4*)(xs + j * 256 + lane * 4);
                if (part != nullptr && pos < LC) {
                    f32x4 a[4];
#pragma unroll
                    for (int j = 0; j < 4; ++j) a[j] = (f32x4){0.f, 0.f, 0.f, 0.f};
                    const float* pp = part + (size_t)(b * LC + pos) * D + lane * 4;
                    for (int s = 0; s < npart; ++s) {
#pragma unroll
                        for (int j = 0; j < 4; ++j) a[j] += *(const f32x4*)(pp + (size_t)s * NB * LC * D + j * 256); }
#pragma unroll
                    for (int j = 0; j < 4; ++j) { v[q][j] += a[j]; *(f32x4*)(x + j * 256 + lane * 4) = v[q][j]; }
                }
#pragma unroll
                for (int j = 0; j < 4; ++j) ss[q] += v[q][j][0] * v[q][j][0] + v[q][j][1] * v[q][j][1] + v[q][j][2] * v[q][j][2] + v[q][j][3] * v[q][j][3];
            }
        }
        ss[0] = wave_sum(ss[0]); ss[1] = wave_sum(ss[1]); ss[2] = wave_sum(ss[2]);
#pragma unroll
        for (int q = 0; q < 3; ++q) {
            if (!ok[q]) continue;
            const int row = r0 + 256 * q; const int ci = cond_idx(row);
            if (ci != cur_ci) { cur_ci = ci; const float* mo = mod + (size_t)ci * 6144 + which * 3072;
#pragma unroll
                for (int j = 0; j < 4; ++j) { const int col = j * 256 + lane * 4; gm[j] = *(const f32x4*)(gain + col) * (1.f + *(const f32x4*)(mo + 1024 + col)); sh[j] = *(const f32x4*)(mo + col); } }
            const float r = rsqrtf(ss[q] * (1.f / 1024.f) + EPS);
#pragma unroll
            for (int j = 0; j < 4; ++j) { const int col = j * 256 + lane * 4; const f32x4 y = v[q][j] * r * gm[j] + sh[j];
                *(u32x2*)(H + (size_t)row * D + col) = (u32x2){pack2(y[0], y[1]), pack2(y[2], y[3])}; }
        }
    }
}

template <int HS>
DI void qknorm_phase(bf16_t* QK, int RL, const float* kgain, int gain_mod, const f32x2* rope) {
    OPAQUE_IDS
    const int lane = tx & 63, gw = bx * 8 + (tx >> 6), nw = gridDim.x * 8;
    const int lpr = (RL - 1024) / HS, rpw = 64 / lpr, rsub = lane / lpr, kl = lane - rsub * lpr, seg = kl >> 1, half = kl & 1;
    const float* gn = kgain + (gain_mod ? (seg % gain_mod) * 2 * HS : 0) + half * HS;
    for (int row0 = gw * rpw; row0 < T; row0 += nw * rpw) {
        const int row = row0 + rsub; const bool act = row < T; const int rowc = act ? row : T - 1;
        const int b = rowc / LT, pos = rowc - b * LT;
        float x[HS]; float ss = 0.f;
        bf16_t* ptr = QK + (size_t)rowc * RL + 1024 + kl * HS;
#pragma unroll
        for (int c = 0; c < HS / 8; ++c) { const u32x4 w = *(const u32x4*)(ptr + c * 8);
            x[c * 8 + 0] = bflo(w.x); x[c * 8 + 1] = bfhi(w.x); x[c * 8 + 2] = bflo(w.y); x[c * 8 + 3] = bfhi(w.y);
            x[c * 8 + 4] = bflo(w.z); x[c * 8 + 5] = bfhi(w.z); x[c * 8 + 6] = bflo(w.w); x[c * 8 + 7] = bfhi(w.w); }
#pragma unroll
        for (int e = 0; e < HS; ++e) ss += x[e] * x[e];
        ss += dpp_f<0xB1>(ss);
        const float r = rsqrtf(ss * (1.f / (2 * HS)) + EPS);
        const bool lat = pos >= LC; const f32x2* rp = rope + (size_t)(lat ? pos - LC : 0) * HS;
#pragma unroll
        for (int e = 0; e < HS; ++e) {
            float v = x[e] * r * gn[e];
            const float o = dpp_f<0xB1>(v);
            if (lat) { const f32x2 cs = rp[e]; v = half ? (o * cs[1] + v * cs[0]) : (v * cs[0] - o * cs[1]); }
            x[e] = v;
        }
        if (act) {
#pragma unroll
            for (int c = 0; c < HS / 8; ++c) { u32x4 w; w.x = pack2(x[c * 8], x[c * 8 + 1]); w.y = pack2(x[c * 8 + 2], x[c * 8 + 3]); w.z = pack2(x[c * 8 + 4], x[c * 8 + 5]); w.w = pack2(x[c * 8 + 6], x[c * 8 + 7]);
                *(u32x4*)(ptr + c * 8) = w; }
        }
    }
}
DI float half_swap_max(float x) { const unsigned u = __float_as_uint(x); const auto r = __builtin_amdgcn_permlane32_swap(u, u, false, false); return fmaxf(__uint_as_float(r[0]), __uint_as_float(r[1])); }
DI float half_swap_sum(float x) { const unsigned u = __float_as_uint(x); const auto r = __builtin_amdgcn_permlane32_swap(u, u, false, false); return __uint_as_float(r[0]) + __uint_as_float(r[1]); }
#define MFMA32(a, b, c) __builtin_amdgcn_mfma_f32_32x32x16_bf16((a), (b), (c), 0, 0, 0)
template <int DQK, int MODE>
DI void attn_phase(const bf16_t* __restrict__ QK, int ldq, const bf16_t* __restrict__ Vt, int VC, bf16_t* __restrict__ O, int ldo, int nhu, bool skip_ctx, const float* __restrict__ qgain, const f32x2* __restrict__ rope, float qscale, char* shm) {
    OPAQUE_IDS
    constexpr int KS = DQK * 2 + 16, VS = 144, KCH = DQK / 8, NKC = 64 * KCH / NTHR;
    constexpr int BUFB = 64 * KS + 128 * VS;
    char* Kl = shm; char* Vl = shm + 64 * KS;
    const int tid = tx, w = tid >> 6, lane = tid & 63, r = lane & 31, h = lane >> 5;
    const int nlat = NB * nhu * 8, nunits = nlat + (skip_ctx ? 0 : NB * nhu);
    for (int u = bx; u < nunits; u += gridDim.x) {
        int qt, hu, b;
        if (u < nlat) { qt = 1 + (u & 7); hu = (u >> 3) % nhu; b = (u >> 3) / nhu; } else { const int v = u - nlat; qt = 0; hu = v % nhu; b = v / nhu; }
        const int qoff = hu * DQK, koff = 1024 + (MODE == 0 ? hu * 64 : (hu >> 2) * 128), voff = (MODE == 0 ? (hu >> 1) : (hu >> 2)) * 128, ooff = hu * 128;
        const int nkt = qt == 0 ? 4 : 36;
        const size_t qrow = (size_t)b * LT + qt * 256 + w * 32 + r;
        bf16x8 qf[DQK / 16];
#pragma unroll
        for (int ks = 0; ks < DQK / 16; ++ks) qf[ks] = *(const bf16x8*)(QK + qrow * ldq + qoff + ks * 16 + h * 8);
        {
            float ss = 0.f;
#pragma unroll
            for (int ks = 0; ks < DQK / 16; ++ks) { const u32x4 wq = __builtin_bit_cast(u32x4, qf[ks]);
                const float a0 = bflo(wq.x), a1 = bfhi(wq.x), a2 = bflo(wq.y), a3 = bfhi(wq.y), a4 = bflo(wq.z), a5 = bfhi(wq.z), a6 = bflo(wq.w), a7 = bfhi(wq.w);
                ss += a0 * a0 + a1 * a1 + a2 * a2 + a3 * a3 + a4 * a4 + a5 * a5 + a6 * a6 + a7 * a7; }
            ss += __shfl_xor(ss, 32);
            const float rr = rsqrtf(ss * (1.f / DQK) + EPS) * qscale; int go = (MODE == 0 ? (hu & 1) * 64 : 0) + h * 8; asm volatile("" : "+v"(go));
            const float* gq = qgain + go; const f32x2* rp = rope + (size_t)((qt > 0 ? qt - 1 : 0) * 256 + w * 32 + r) * (DQK / 2) + h * 8;
#pragma unroll
            for (int ks = 0; ks < DQK / 32; ++ks) {
                const u32x4 wa = __builtin_bit_cast(u32x4, qf[ks]), wb = __builtin_bit_cast(u32x4, qf[ks + DQK / 32]);
                float xa[8] = {bflo(wa.x), bfhi(wa.x), bflo(wa.y), bfhi(wa.y), bflo(wa.z), bfhi(wa.z), bflo(wa.w), bfhi(wa.w)};
                float xb[8] = {bflo(wb.x), bfhi(wb.x), bflo(wb.y), bfhi(wb.y), bflo(wb.z), bfhi(wb.z), bflo(wb.w), bfhi(wb.w)};
#pragma unroll
                for (int j = 0; j < 8; ++j) { float x1 = xa[j] * rr * gq[ks * 16 + j], x2 = xb[j] * rr * gq[(ks + DQK / 32) * 16 + j];
                    if (qt > 0) { const f32x2 cs = rp[ks * 16 + j]; const float y1 = x1 * cs[0] - x2 * cs[1], y2 = x1 * cs[1] + x2 * cs[0]; x1 = y1; x2 = y2; }
                    xa[j] = x1; xb[j] = x2; }
                qf[ks] = __builtin_bit_cast(bf16x8, (u32x4){pack2(xa[0], xa[1]), pack2(xa[2], xa[3]), pack2(xa[4], xa[5]), pack2(xa[6], xa[7])});
                qf[ks + DQK / 32] = __builtin_bit_cast(bf16x8, (u32x4){pack2(xb[0], xb[1]), pack2(xb[2], xb[3]), pack2(xb[4], xb[5]), pack2(xb[6], xb[7])});
            }
        }
        f32x16 oacc[4];
#pragma unroll
        for (int t = 0; t < 4; ++t)
#pragma unroll
            for (int i = 0; i < 16; ++i) oacc[t][i] = 0.f;
        float mrun = -1e30f, lsum = 0.f;
        const bf16_t* kbase = QK + (size_t)b * LT * ldq + koff; const bf16_t* vbase = Vt + ((size_t)b * VC + voff) * LT;
        u32x4 kreg[NKC], vreg[2];
#define ATT_LOAD(kt) do { _Pragma("unroll") for (int i = 0; i < NKC; ++i) { const int c = tid + i * NTHR, key = c / KCH, part = c % KCH; \
                kreg[i] = *(const u32x4*)(kbase + (size_t)((kt) * 64 + key) * ldq + part * 8); } \
            _Pragma("unroll") for (int i = 0; i < 2; ++i) { const int c = tid + i * NTHR, dv = c >> 3, part = c & 7; \
                vreg[i] = *(const u32x4*)(vbase + (size_t)dv * LT + (kt) * 64 + part * 8); } } while (0)
        ATT_LOAD(0);
#define ATT_STORE(buf) do { char* Kw = Kl + (buf) * BUFB; char* Vw = Vl + (buf) * BUFB; \
            _Pragma("unroll") for (int i = 0; i < NKC; ++i) { const int c = tid + i * NTHR, key = c / KCH, part = c % KCH; *(u32x4*)(Kw + key * KS + part * 16) = kreg[i]; } \
            _Pragma("unroll") for (int i = 0; i < 2; ++i) { const int c = tid + i * NTHR, dv = c >> 3, part = c & 7; char* vp_ = Vw + dv * VS + (part >> 1) * 32 + (part & 1) * 8; \
                *(u32x2*)(vp_) = (u32x2){vreg[i].x, vreg[i].y}; *(u32x2*)(vp_ + 16) = (u32x2){vreg[i].z, vreg[i].w}; } } while (0)
        __syncthreads();
        ATT_STORE(0);
        __syncthreads();
        for (int kt = 0; kt < nkt; ++kt) {
            const char* Kc = Kl + (kt & 1) * BUFB; const char* Vc = Vl + (kt & 1) * BUFB;
            if (kt + 1 < nkt) ATT_LOAD(kt + 1);
            f32x16 st0, st1;
#pragma unroll
            for (int i = 0; i < 16; ++i) { st0[i] = 0.f; st1[i] = 0.f; }
#pragma unroll
            for (int ks = 0; ks < DQK / 16; ++ks) {
                const bf16x8 a0 = *(const bf16x8*)(Kc + r * KS + ks * 32 + h * 16), a1 = *(const bf16x8*)(Kc + (32 + r) * KS + ks * 32 + h * 16);
                st0 = MFMA32(a0, qf[ks], st0); st1 = MFMA32(a1, qf[ks], st1);
            }
            float mx = st0[0];
#pragma unroll
            for (int i = 0; i < 16; ++i) mx = __builtin_fmaxf(__builtin_fmaxf(mx, st0[i]), st1[i]);
            mx = half_swap_max(mx);
            if (__any(mx > mrun + 8.f)) {
                const float mnew = fmaxf(mrun, mx), alpha = __builtin_amdgcn_exp2f(mrun - mnew); mrun = mnew; lsum *= alpha;
#pragma unroll
                for (int t = 0; t < 4; ++t)
#pragma unroll
                    for (int i = 0; i < 16; ++i) oacc[t][i] *= alpha;
            }
            { const f32x2 m2 = (f32x2){mrun, mrun}; f32x2 ps2 = (f32x2){0.f, 0.f};
#pragma unroll
              for (int i = 0; i < 16; i += 2) {
                  f32x2 a = (f32x2){st0[i], st0[i + 1]} - m2, c = (f32x2){st1[i], st1[i + 1]} - m2;
                  a[0] = __builtin_amdgcn_exp2f(a[0]); a[1] = __builtin_amdgcn_exp2f(a[1]); c[0] = __builtin_amdgcn_exp2f(c[0]); c[1] = __builtin_amdgcn_exp2f(c[1]);
                  ps2 += a; ps2 += c; st0[i] = a[0]; st0[i + 1] = a[1]; st1[i] = c[0]; st1[i + 1] = c[1]; }
              lsum += ps2[0] + ps2[1]; }
#pragma unroll
            for (int kb = 0; kb < 2; ++kb)
#pragma unroll
                for (int s = 0; s < 2; ++s) {
                    u32x4 pw;
                    if (kb == 0) { pw.x = pack2(st0[8 * s], st0[8 * s + 1]); pw.y = pack2(st0[8 * s + 2], st0[8 * s + 3]); pw.z = pack2(st0[8 * s + 4], st0[8 * s + 5]); pw.w = pack2(st0[8 * s + 6], st0[8 * s + 7]); }
                    else { pw.x = pack2(st1[8 * s], st1[8 * s + 1]); pw.y = pack2(st1[8 * s + 2], st1[8 * s + 3]); pw.z = pack2(st1[8 * s + 4], st1[8 * s + 5]); pw.w = pack2(st1[8 * s + 6], st1[8 * s + 7]); }
                    const bf16x8 pb = __builtin_bit_cast(bf16x8, pw);
#pragma unroll
                    for (int t = 0; t < 4; ++t) {
                        const bf16x8 a = *(const bf16x8*)(Vc + (32 * t + r) * VS + (kb * 2 + s) * 32 + h * 16);
                        oacc[t] = MFMA32(a, pb, oacc[t]);
                    }
                }
            if (kt + 1 < nkt) ATT_STORE((kt + 1) & 1);
            __syncthreads();
        }
#undef ATT_STORE
#undef ATT_LOAD
        const float l = half_swap_sum(lsum), inv = 1.f / l;
        bf16_t* op = O + qrow * ldo + ooff;
#pragma unroll
        for (int t = 0; t < 4; ++t)
#pragma unroll
            for (int g = 0; g < 4; g += 2) {
                const unsigned ax = pack2(oacc[t][4 * g] * inv, oacc[t][4 * g + 1] * inv), ay = pack2(oacc[t][4 * g + 2] * inv, oacc[t][4 * g + 3] * inv);
                const unsigned bx_ = pack2(oacc[t][4 * g + 4] * inv, oacc[t][4 * g + 5] * inv), by_ = pack2(oacc[t][4 * g + 6] * inv, oacc[t][4 * g + 7] * inv);
                const auto sx = __builtin_amdgcn_permlane32_swap(ax, bx_, false, false); const auto sy = __builtin_amdgcn_permlane32_swap(ay, by_, false, false);
                *(u32x4*)(op + 32 * t + 8 * (g + h)) = (u32x4){sx[0], sy[0], sx[1], sy[1]}; }
    }
    __syncthreads();
}

template <int MODE>
DI void headnorm_phase(const Params& p, const bf16_t* __restrict__ A0, const bf16_t* __restrict__ A1, const bf16_t* __restrict__ G, const float* gain, float lam, float outscale) {
    OPAQUE_IDS
    const int lane = tx & 63, gw = bx * 8 + (tx >> 6), nw = gridDim.x * 8;
    bf16_t* H = (bf16_t*)(p.ws + WS_H); const int hh = lane >> 3, d0 = (lane & 7) * 16;
    for (int row = gw; row < T; row += nw) {
        float x[16];
#pragma unroll
        for (int c = 0; c < 2; ++c) {
            u32x4 a, b2;
            if (MODE == 0) { a = *(const u32x4*)(A0 + (size_t)row * 2048 + hh * 256 + d0 + c * 8); b2 = *(const u32x4*)(A0 + (size_t)row * 2048 + hh * 256 + 128 + d0 + c * 8); }
            else { a = *(const u32x4*)(A0 + (size_t)row * D + hh * 128 + d0 + c * 8); b2 = *(const u32x4*)(A1 + (size_t)row * D + hh * 128 + d0 + c * 8); }
            const float s = MODE == 0 ? -lam : 1.f;
            x[c * 8 + 0] = bflo(a.x) + s * bflo(b2.x); x[c * 8 + 1] = bfhi(a.x) + s * bfhi(b2.x); x[c * 8 + 2] = bflo(a.y) + s * bflo(b2.y); x[c * 8 + 3] = bfhi(a.y) + s * bfhi(b2.y);
            x[c * 8 + 4] = bflo(a.z) + s * bflo(b2.z); x[c * 8 + 5] = bfhi(a.z) + s * bfhi(b2.z); x[c * 8 + 6] = bflo(a.w) + s * bflo(b2.w); x[c * 8 + 7] = bfhi(a.w) + s * bfhi(b2.w);
        }
        float ss = 0.f;
#pragma unroll
        for (int e = 0; e < 16; ++e) ss += x[e] * x[e];
        ss += __shfl_xor(ss, 1); ss += __shfl_xor(ss, 2); ss += __shfl_xor(ss, 4);
        const float r = rsqrtf(ss * (1.f / 128.f) + EPS) * outscale;
#pragma unroll
        for (int c = 0; c < 2; ++c) {
            float y[8];
#pragma unroll
            for (int e = 0; e < 8; ++e) y[e] = x[c * 8 + e] * r * gain[d0 + c * 8 + e];
            if (MODE == 1) { const u32x4 g = *(const u32x4*)(G + (size_t)row * D + hh * 128 + d0 + c * 8);
                y[0] *= silu_f(bflo(g.x)); y[1] *= silu_f(bfhi(g.x)); y[2] *= silu_f(bflo(g.y)); y[3] *= silu_f(bfhi(g.y));
                y[4] *= silu_f(bflo(g.z)); y[5] *= silu_f(bfhi(g.z)); y[6] *= silu_f(bflo(g.w)); y[7] *= silu_f(bfhi(g.w)); }
            u32x4 wv; wv.x = pack2(y[0], y[1]); wv.y = pack2(y[2], y[3]); wv.z = pack2(y[4], y[5]); wv.w = pack2(y[6], y[7]);
            *(u32x4*)(H + (size_t)row * D + hh * 128 + d0 + c * 8) = wv;
        }
    }
}

DI float dpp_x1(float x) { return __int_as_float(__builtin_amdgcn_update_dpp(0, __float_as_int(x), 0xB1, 0xF, 0xF, true)); }
DI float dpp_x2(float x) { return __int_as_float(__builtin_amdgcn_update_dpp(0, __float_as_int(x), 0x4E, 0xF, 0xF, true)); }
DI void hgrn_scan(const Params& p, char* shm) {
    OPAQUE_IDS
    constexpr int TCH = 32;
    const unsigned char* P = p.ws + WS_P;
    const bf16_t* Qh = (const bf16_t*)(P + P_HQ); const bf16_t* V = (const bf16_t*)(P + P_HV);
    float* fL = (float*)shm; float* qL = fL + TCH * 128; float* vL = qL + TCH * 128; float* pL = vL + TCH * 64;
    const int tid = tx, w = tid >> 6, lane = tid & 63, kg = lane & 3, vg = lane >> 2;
    for (int u = bx; u < 256; u += gridDim.x) {
        const int slice = u & 1, dir = (u >> 1) & 1, head = (u >> 2) & 7, b = u >> 5;
        const float* F = (const float*)(P + (dir ? P_HF1 : P_HF0)); bf16_t* Oo = dir ? (bf16_t*)(p.ws + WS_P + P_HOB) : (bf16_t*)(p.ws + WS_H);
        f32x2 s[4][2];
#pragma unroll
        for (int i = 0; i < 4; ++i) { s[i][0] = (f32x2){0.f, 0.f}; s[i][1] = (f32x2){0.f, 0.f}; }
        const int ltok = tid >> 5, lk4 = (tid & 31) * 4, vtok = tid >> 4, lv4 = (tid & 15) * 4;
        f32x4 fr[2]; u32x2 qr[2]; u32x2 vr;
#define HG_ROW(tau) ((size_t)b * LT + (dir == 0 ? (tau) : ((tau) < LC ? (LC - 1 - (tau)) : (LT + LC - 1 - (tau)))))
#define HG_LOAD(ch) do { _Pragma("unroll") for (int i_ = 0; i_ < 2; ++i_) { const size_t row = HG_ROW((ch) * TCH + ltok + 16 * i_); fr[i_] = *(const f32x4*)(F + row * D + head * 128 + lk4); \
            qr[i_] = *(const u32x2*)(Qh + row * D + head * 128 + lk4); } \
            { const size_t row = HG_ROW((ch) * TCH + vtok); vr = *(const u32x2*)(V + row * D + head * 128 + slice * 64 + lv4); } } while (0)
        HG_LOAD(0);
        for (int ch = 0; ch < LT / TCH; ++ch) {
            __syncthreads();
#pragma unroll
            for (int i_ = 0; i_ < 2; ++i_) { *(f32x4*)(fL + (ltok + 16 * i_) * 128 + lk4) = fr[i_];
                *(f32x4*)(qL + (ltok + 16 * i_) * 128 + lk4) = (f32x4){bflo(qr[i_].x), bfhi(qr[i_].x), bflo(qr[i_].y), bfhi(qr[i_].y)}; }
            *(f32x4*)(vL + vtok * 64 + lv4) = (f32x4){bflo(vr.x), bfhi(vr.x), bflo(vr.y), bfhi(vr.y)};
            __syncthreads();
            if (ch + 1 < LT / TCH) HG_LOAD(ch + 1);
#pragma unroll 4
            for (int tok = 0; tok < TCH; ++tok) {
                const f32x4 f4 = *(const f32x4*)(fL + tok * 128 + w * 16 + kg * 4), q4 = *(const f32x4*)(qL + tok * 128 + w * 16 + kg * 4), v4 = *(const f32x4*)(vL + tok * 64 + vg * 4);
                const f32x2 va = (f32x2){v4[0], v4[1]}, vb = (f32x2){v4[2], v4[3]}; f32x2 oa = (f32x2){0.f, 0.f}, ob = (f32x2){0.f, 0.f};
#pragma unroll
                for (int ki = 0; ki < 4; ++ki) { const f32x2 f2 = (f32x2){f4[ki], f4[ki]}, q2 = (f32x2){q4[ki], q4[ki]};
                    f32x2 d = s[ki][0] - va; s[ki][0] = f2 * d + va; oa += s[ki][0] * q2;
                    d = s[ki][1] - vb; s[ki][1] = f2 * d + vb; ob += s[ki][1] * q2; }
                f32x4 o4 = (f32x4){oa[0], oa[1], ob[0], ob[1]};
#pragma unroll
                for (int e = 0; e < 4; ++e) { o4[e] += dpp_x1(o4[e]); o4[e] += dpp_x2(o4[e]); }
                if (kg == 0) *(f32x4*)(pL + (w * TCH + tok) * 64 + vg * 4) = o4;
            }
            __syncthreads();
            { f32x4 a = (f32x4){0.f, 0.f, 0.f, 0.f};
#pragma unroll
              for (int ww = 0; ww < 8; ++ww) a += *(const f32x4*)(pL + (ww * TCH + vtok) * 64 + lv4);
              const size_t row = HG_ROW(ch * TCH + vtok); *(u32x2*)(Oo + row * D + head * 128 + slice * 64 + lv4) = (u32x2){pack2(a[0], a[1]), pack2(a[2], a[3])}; }
        }
#undef HG_LOAD
#undef HG_ROW
    }
    __syncthreads();
}

#define HG_ROW(b, dir, tau) ((size_t)(b) * LT + ((dir) == 0 ? (tau) : ((tau) < LC ? (LC - 1 - (tau)) : (LT + LC - 1 - (tau)))))
#define HG_MINROW(b, dir, c) ((dir) == 0 ? HG_ROW(b, 0, (c) * 16) : HG_ROW(b, 1, (c) * 16 + 15))
DI void hgrn_prep(const Params& p) {
    OPAQUE_IDS
    unsigned char* P = p.ws + WS_P; const bf16_t* Qh = (const bf16_t*)(P + P_HQ); float* EB = (float*)(p.ws + WS_EB);
    const int col2 = tx * 2;
    for (int it = bx; it < 2 * NB * 144; it += gridDim.x) {
        const int dir = it & 1, rem = it >> 1, c = rem % 144, b = rem / 144;
        float* F = (float*)(P + (dir ? P_HF1 : P_HF0));
        f32x2 f2[16]; unsigned q2[16];
#pragma unroll
        for (int t = 0; t < 16; ++t) { const size_t row = HG_ROW(b, dir, c * 16 + t); f2[t] = *(const f32x2*)(F + row * D + col2); q2[t] = *(const unsigned*)(Qh + row * D + col2); }
        unsigned qt[16], k0[8], k1[8]; float run0 = 0.f, run1 = 0.f, ka = 0.f, kb = 0.f;
#pragma unroll
        for (int t = 0; t < 16; ++t) {
            run0 += __logf(f2[t][0]); run1 += __logf(f2[t][1]);
            qt[t] = pack2(bflo(q2[t]) * __expf(run0), bfhi(q2[t]) * __expf(run1));
            const float a = (1.f - f2[t][0]) * __expf(fminf(-run0, 80.f)), bq = (1.f - f2[t][1]) * __expf(fminf(-run1, 80.f));
            if (t & 1) { k0[t >> 1] = pack2(ka, a); k1[t >> 1] = pack2(kb, bq); } else { ka = a; kb = bq; }
        }
        __syncthreads();
        unsigned char* base = (unsigned char*)F + HG_MINROW(b, dir, c) * 4096;
#pragma unroll
        for (int t = 0; t < 16; ++t) *(unsigned*)(base + t * 2048 + col2 * 2) = qt[t];
        *(u32x4*)(base + 32768 + col2 * 32) = (u32x4){k0[0], k0[1], k0[2], k0[3]}; *(u32x4*)(base + 32768 + col2 * 32 + 16) = (u32x4){k0[4], k0[5], k0[6], k0[7]};
        *(u32x4*)(base + 32768 + col2 * 32 + 32) = (u32x4){k1[0], k1[1], k1[2], k1[3]}; *(u32x4*)(base + 32768 + col2 * 32 + 48) = (u32x4){k1[4], k1[5], k1[6], k1[7]};
        *(f32x2*)(EB + ((size_t)(dir * NB + b) * 144 + c) * D + col2) = (f32x2){__expf(run0), __expf(run1)};
        __syncthreads();
    }
}
DI void hgrn_scan_mfma(const Params& p, char* shm) {
    OPAQUE_IDS
    constexpr int C = 32, QS = 272;
    const unsigned char* P = p.ws + WS_P;
    const bf16_t* V = (const bf16_t*)(P + P_HV); const float* EB = (const float*)(p.ws + WS_EB); const bf16_t* Qh = (const bf16_t*)(P + P_HQ);
    char* QtL = shm;
    char* VL = QtL + C * QS;
    char* KtL = VL + C * QS;
    float* eBL = (float*)(KtL + C * QS);
    const int tid = tx, w = tid >> 6, lane = tid & 63, l15 = lane & 15, g = lane >> 4;
    for (int u = bx; u < 128; u += gridDim.x) {
        const int dir = u & 1, head = (u >> 1) & 7, b = u >> 4;
        const unsigned char* Fb = P + (dir ? P_HF1 : P_HF0); bf16_t* Oo = dir ? (bf16_t*)(p.ws + WS_P + P_HOB) : (bf16_t*)(p.ws + WS_H);
        f32x4 S[8];
#pragma unroll
        for (int kt = 0; kt < 8; ++kt) S[kt] = (f32x4){0.f, 0.f, 0.f, 0.f};
        const int lt = tid >> 4, lp = tid & 15;
        u32x4 ra0, ra1, ra2, ra3, ra4, rb0, rb1, rb2, rb3, rb4;
#define HG_LOAD(ch, r0, r1, r2, r3, r4) do { const size_t row_ = HG_ROW(b, dir, (ch) * C + lt); const unsigned char* fr_ = Fb + row_ * 4096; \
            r0 = *(const u32x4*)(Qh + row_ * D + head * 128 + lp * 8); r1 = *(const u32x4*)(fr_ + (head * 128 + lp * 8) * 2); r2 = *(const u32x4*)(V + row_ * D + head * 128 + lp * 8); \
            r3 = *(const u32x4*)(fr_ + (1024 + head * 128 + lp * 8) * 2); \
            if (tid < 32) r4 = *(const u32x4*)(EB + ((size_t)(dir * NB + b) * 72 + (ch)) * D + head * 128 + tid * 4); } while (0)
#define HG_QE(qw, ew) pack2(bflo(qw) * bflo(ew), bfhi(qw) * bfhi(ew))
#define HG_STAGE(ch, r0, r1, r2, r3, r4) do { __syncthreads(); \
            *(u32x4*)(QtL + lt * QS + lp * 16) = (u32x4){HG_QE(r0.x, r1.x), HG_QE(r0.y, r1.y), HG_QE(r0.z, r1.z), HG_QE(r0.w, r1.w)}; *(u32x4*)(VL + lt * QS + lp * 16) = r2; \
            *(u32x4*)(KtL + lt * QS + lp * 16) = r3; if (tid < 32) *(u32x4*)((char*)eBL + tid * 16) = r4; \
            __syncthreads(); \
            if ((ch) + 2 < LT / C) HG_LOAD((ch) + 2, r0, r1, r2, r3, r4); } while (0)
        HG_LOAD(0, ra0, ra1, ra2, ra3, ra4); HG_LOAD(1, rb0, rb1, rb2, rb3, rb4);
        for (int ch2 = 0; ch2 < LT / C; ch2 += 2) {
#pragma unroll
          for (int hh = 0; hh < 2; ++hh) {
            const int ch = ch2 + hh;
            if (hh == 0) HG_STAGE(ch, ra0, ra1, ra2, ra3, ra4); else HG_STAGE(ch, rb0, rb1, rb2, rb3, rb4);
            { const bf16_t* kt16 = (const bf16_t*)KtL; const bf16_t* v16 = (const bf16_t*)VL; const int vcol = w * 16 + l15;
#define HG_U2(arr, r_a, r_b, c_) ((unsigned)(arr)[(r_a) * (QS / 2) + (c_)] | ((unsigned)(arr)[(r_b) * (QS / 2) + (c_)] << 16))
              const bf16x8 vf = __builtin_bit_cast(bf16x8, (u32x4){HG_U2(v16, g * 4 + 0, g * 4 + 1, vcol), HG_U2(v16, g * 4 + 2, g * 4 + 3, vcol), HG_U2(v16, 16 + g * 4 + 0, 16 + g * 4 + 1, vcol), HG_U2(v16, 16 + g * 4 + 2, 16 + g * 4 + 3, vcol)});
              f32x4 sc00 = (f32x4){0.f, 0.f, 0.f, 0.f}, sc01 = sc00, sc11 = sc00, o0 = sc00, o1 = sc00;
#pragma unroll
              for (int kc = 0; kc < 4; ++kc) {
                  const bf16x8 aK0 = *(const bf16x8*)(KtL + l15 * QS + kc * 64 + g * 16), aK1 = *(const bf16x8*)(KtL + (16 + l15) * QS + kc * 64 + g * 16);
                  const bf16x8 bQ0 = *(const bf16x8*)(QtL + l15 * QS + kc * 64 + g * 16), bQ1 = *(const bf16x8*)(QtL + (16 + l15) * QS + kc * 64 + g * 16);
                  sc00 = __builtin_amdgcn_mfma_f32_16x16x32_bf16(aK0, bQ0, sc00, 0, 0, 0);
                  sc01 = __builtin_amdgcn_mfma_f32_16x16x32_bf16(aK0, bQ1, sc01, 0, 0, 0);
                  sc11 = __builtin_amdgcn_mfma_f32_16x16x32_bf16(aK1, bQ1, sc11, 0, 0, 0);
                  const int kp = kc;
                  const u32x2 qa0 = *(const u32x2*)(QtL + l15 * QS + ((2 * kp) * 16 + g * 4) * 2), qb0 = *(const u32x2*)(QtL + l15 * QS + ((2 * kp + 1) * 16 + g * 4) * 2);
                  const u32x2 qa1 = *(const u32x2*)(QtL + (16 + l15) * QS + ((2 * kp) * 16 + g * 4) * 2), qb1 = *(const u32x2*)(QtL + (16 + l15) * QS + ((2 * kp + 1) * 16 + g * 4) * 2);
                  const bf16x8 sw = __builtin_bit_cast(bf16x8, (u32x4){pack2(S[2 * kp][0], S[2 * kp][1]), pack2(S[2 * kp][2], S[2 * kp][3]), pack2(S[2 * kp + 1][0], S[2 * kp + 1][1]), pack2(S[2 * kp + 1][2], S[2 * kp + 1][3])});
                  o0 = __builtin_amdgcn_mfma_f32_16x16x32_bf16(__builtin_bit_cast(bf16x8, (u32x4){qa0.x, qa0.y, qb0.x, qb0.y}), sw, o0, 0, 0, 0);
                  o1 = __builtin_amdgcn_mfma_f32_16x16x32_bf16(__builtin_bit_cast(bf16x8, (u32x4){qa1.x, qa1.y, qb1.x, qb1.y}), sw, o1, 0, 0, 0); }
#pragma unroll
              for (int r = 0; r < 4; ++r) if (g * 4 + r > l15) { sc00[r] = 0.f; sc11[r] = 0.f; }
              o0 = __builtin_amdgcn_mfma_f32_16x16x32_bf16(__builtin_bit_cast(bf16x8, (u32x4){pack2(sc00[0], sc00[1]), pack2(sc00[2], sc00[3]), 0u, 0u}), vf, o0, 0, 0, 0);
              o1 = __builtin_amdgcn_mfma_f32_16x16x32_bf16(__builtin_bit_cast(bf16x8, (u32x4){pack2(sc01[0], sc01[1]), pack2(sc01[2], sc01[3]), pack2(sc11[0], sc11[1]), pack2(sc11[2], sc11[3])}), vf, o1, 0, 0, 0);
#pragma unroll
              for (int r = 0; r < 4; ++r) { const size_t rw0 = HG_ROW(b, dir, ch * C + g * 4 + r), rw1 = HG_ROW(b, dir, ch * C + 16 + g * 4 + r);
                  Oo[rw0 * D + head * 128 + vcol] = (bf16_t)(pack2(o0[r], 0.f) & 0xffffu); Oo[rw1 * D + head * 128 + vcol] = (bf16_t)(pack2(o1[r], 0.f) & 0xffffu); }
#pragma unroll
              for (int kt = 0; kt < 8; ++kt) { const f32x4 dcy = *(const f32x4*)(eBL + kt * 16 + g * 4); const int kcol = kt * 16 + l15;
                  const bf16x8 kl = __builtin_bit_cast(bf16x8, (u32x4){HG_U2(kt16, g * 4 + 0, g * 4 + 1, kcol), HG_U2(kt16, g * 4 + 2, g * 4 + 3, kcol), HG_U2(kt16, 16 + g * 4 + 0, 16 + g * 4 + 1, kcol), HG_U2(kt16, 16 + g * 4 + 2, 16 + g * 4 + 3, kcol)});
                  S[kt] = __builtin_amdgcn_mfma_f32_16x16x32_bf16(kl, vf, S[kt], 0, 0, 0) * dcy; }
#undef HG_U2
            }
          }
        }
#undef HG_STAGE
#undef HG_QE
#undef HG_LOAD
    }
    __syncthreads();
}

#define XB_TMO      128
#define XB_XCNT(j)  (256  + 64 * (j))
#define XB_XSUB(j)  (1280 + 64 * (j))
#define XB_XGEN(j)  (2304 + 64 * (j))
#define XB_TOP      3328
#define XB_TOPGEN   3392
#define XCD_BAR_WORDS 3456
#define XB_SPIN_CAP (1u << 22)
DI unsigned xb_ld(unsigned* p)              { return __hip_atomic_load(p, __ATOMIC_RELAXED, __HIP_MEMORY_SCOPE_AGENT); }
DI unsigned xb_add(unsigned* p, unsigned v) { return __hip_atomic_fetch_add(p, v, __ATOMIC_RELAXED, __HIP_MEMORY_SCOPE_AGENT); }
DI unsigned xb_xcc_id() { return (unsigned)__builtin_amdgcn_s_getreg((3 << 11) | 20) & 0xFu; }
#define XB_SPIN(cond, bar) do { unsigned _sp = 0; while (cond) { __builtin_amdgcn_s_sleep(1); \
    if ((++_sp & 255u) == 0u) { if (xb_ld(&(bar)[XB_TMO])) break; if (_sp > XB_SPIN_CAP) { atomicAdd(&(bar)[XB_TMO], 1u); break; } } } } while (0)
struct XcdBarrier { unsigned* bar; unsigned x; volatile LAS unsigned* st; };
DI XcdBarrier xcd_barrier_post(unsigned* bar, volatile LAS unsigned* st) {
    XcdBarrier b; b.bar = bar; b.x = xb_xcc_id(); b.st = st;
    if (threadIdx.x == 0) (void)xb_add(&bar[XB_XCNT(b.x)], 1u);
    return b;
}
DI void xcd_barrier_complete(unsigned* bar, unsigned x, unsigned& nloc, unsigned& nx) {
    const unsigned G = gridDim.x * gridDim.y * gridDim.z;
    unsigned sum, cnt, mine, sp = 0u;
    for (;;) {
        sum = 0u; cnt = 0u; mine = 0u;
#pragma unroll
        for (unsigned j = 0; j < 16; ++j) { const unsigned c = xb_ld(&bar[XB_XCNT(j)]); sum += c; cnt += (c > 0u) ? 1u : 0u; mine = (j == x) ? c : mine; }
        if (sum == G) break;
        __builtin_amdgcn_s_sleep(1);
        if ((++sp & 255u) == 0u) { if (xb_ld(&bar[XB_TMO])) break; if (sp > XB_SPIN_CAP) { atomicAdd(&bar[XB_TMO], 1u); break; } }
    }
    nloc = mine > 0u ? mine : 1u; nx = cnt > 0u ? cnt : 1u;
}
DI void xcd_barrier(const XcdBarrier& b) {
    asm volatile("s_waitcnt vmcnt(0)" ::: "memory");
    __syncthreads();
    if (threadIdx.x == 0) {
        unsigned* bar = b.bar;
        __builtin_amdgcn_s_waitcnt(0);
        unsigned nloc = b.st[0], nx = b.st[1];
        if (nloc == 0u) { xcd_barrier_complete(bar, b.x, nloc, nx); b.st[0] = nloc; b.st[1] = nx; }
        const unsigned old = xb_add(&bar[XB_XSUB(b.x)], 1u);
        const unsigned gen = old / nloc;
        if (old + 1u == (gen + 1u) * nloc) {
            __builtin_amdgcn_fence(__ATOMIC_RELEASE, "agent");
            asm volatile("s_waitcnt vmcnt(0)" ::: "memory");
            const unsigned og = xb_add(&bar[XB_TOP], 1u);
            const unsigned tg = og / nx;
            if (og + 1u == (tg + 1u) * nx) xb_add(&bar[XB_TOPGEN], 1u);
            else XB_SPIN(xb_ld(&bar[XB_TOPGEN]) == tg, bar);
            __builtin_amdgcn_fence(__ATOMIC_ACQUIRE, "agent");
            xb_add(&bar[XB_XGEN(b.x)], 1u);
            asm volatile("s_waitcnt vmcnt(0)" ::: "memory");
        } else {
            XB_SPIN(xb_ld(&bar[XB_XGEN(b.x)]) == gen, bar);
            __builtin_amdgcn_fence(__ATOMIC_ACQUIRE, "agent");
            asm volatile("s_waitcnt vmcnt(0)" ::: "memory");
        }
    }
    __syncthreads();
}

template <int layer>
DI void layer_body(const Params& p, const XcdBarrier& xb, char* shm) {
    unsigned char* P = p.ws + WS_P;
    bf16_t* H = (bf16_t*)(p.ws + WS_H);
    bf16_t* wfi = (bf16_t*)(p.ws + WS_WFI); bf16_t* wfo = (bf16_t*)(p.ws + WS_WFO); bf16_t* wmi = (bf16_t*)(p.ws + WS_WMI); bf16_t* wmo = (bf16_t*)(p.ws + WS_WMO);
    const float* modall = (const float*)(p.ws + WS_MOD);
    float* ctxres = (float*)(p.ws + WS_CTXRES);
    (void)wmi; (void)H;
        const float* mod = modall + (size_t)layer * 9 * 6144;
        const bool last = layer == 3;
        PH(0) if (layer > 0) convert_layer(p, layer, shm);
        PH(1) norm_phase(p, layer, 0, false, layer > 0 ? (const float*)(P + P_PARTF) : nullptr, 8, layer == 0 ? 1 : 0);
        xcd_barrier(xb);
        if constexpr (layer == 0) {
            { const bf16_t* cdt = (const bf16_t*)(P + P_CDT); bf16_t* gtl = (bf16_t*)(P + P_GTL); bf16_t* gtc = (bf16_t*)(P + P_GTC);
              gemm_loop(NB * 72, 1024, shm,
                  [&](int L) { const int b = L / 72, r2 = L % 72, pm = r2 / 9, pn = r2 % 9, k0 = (pm & 3) * 256; return Tile{cdt + k0, H + (size_t)b * LT * D + k0, 1024, D, 256, pm * 256, pn * 256}; },
                  [&](int L, const AccT& acc, int brow, int bcol, int wr, int wc, int fr, int fq) { EpiFnet1 e{gtl, gtc, L / 72}; e(acc, brow, bcol, wr, wc, fr, fq); }); }
            xcd_barrier(xb);
            { const bf16_t* wl = (const bf16_t*)(P + P_WL); const bf16_t* wc = (const bf16_t*)(P + P_WC); bf16_t* Yb = (bf16_t*)(P + P_YB);
              const bf16_t* gtl = (const bf16_t*)(P + P_GTL); const bf16_t* gtc = (const bf16_t*)(P + P_GTC);
              gemm_loop(NB * 32, 4096, shm,
                  [&](int L) { const int b = L >> 5, pm = (L >> 2) & 7, pn = L & 3; return Tile{wl, gtl + (size_t)b * 1024 * 4096, 4096, 4096, 4096, pm * 256, pn * 256}; },
                  [&](int L, const AccT& acc, int brow, int bcol, int wr, int wc_, int fr, int fq) { EpiBf16 e{Yb + ((size_t)(L >> 5) * LT + LC) * D, (size_t)D}; e(acc, brow, bcol, wr, wc_, fr, fq); });
              gemm_loop(NB * 4, 512, shm,
                  [&](int L) { const int b = L >> 2, pn = L & 3; return Tile{wc, gtc + (size_t)b * 1024 * 512, 512, 512, 512, 0, pn * 256}; },
                  [&](int L, const AccT& acc, int brow, int bcol, int wr, int wc_, int fr, int fq) { EpiBf16 e{Yb + ((size_t)(L >> 2) * LT) * D, (size_t)D}; e(acc, brow, bcol, wr, wc_, fr, fq); }); }
            xcd_barrier(xb);
            gemm_resid<4>((const bf16_t*)(P + P_YB), wmo, D, true, p.out, p.in[0], mod + 2 * 1024, p.in[10], (float*)(P + P_PARTO), shm);
        } else if constexpr (layer == 1) {
            { bf16_t* QK = (bf16_t*)(P + P_DQK); bf16_t* Vt = (bf16_t*)(P + P_DVT); const int n1 = 72 * 8, n2 = NB * 4 * 9;
              gemm_loop(n1 + n2, D, shm,
                  [&](int L) { if (L < n1) { int pm, pn; tile_map(L, 72, 8, pm, pn); return Tile{H, wmi, D, D, D, pm * 256, pn * 256}; }
                               const int v = L - n1, b = v / 36, r2 = v % 36, pm = r2 / 9, pn = r2 % 9; return Tile{wmi + (size_t)2048 * D, H + (size_t)b * LT * D, D, D, D, pm * 256, pn * 256}; },
                  [&](int L, const AccT& acc, int brow, int bcol, int wr, int wc, int fr, int fq) {
                      if (L < n1) { EpiBf16 e{QK, (size_t)2048}; e(acc, brow, bcol, wr, wc, fr, fq); }
                      else { EpiBf16 e{Vt + (size_t)((L - n1) / 36) * 1024 * LT, (size_t)LT}; e(acc, brow, bcol, wr, wc, fr, fq); } }); }
            xcd_barrier(xb);
            PH(2) qknorm_phase<32>((bf16_t*)(P + P_DQK), 2048, p.in[13], 2, (const f32x2*)(p.ws + WS_ROPED));
            xcd_barrier(xb);
            PH(4) attn_phase<64, 0>((const bf16_t*)(P + P_DQK), 2048, (const bf16_t*)(P + P_DVT), 1024, (bf16_t*)(P + P_DO2), 2048, 16, false, p.in[12], (const f32x2*)(p.ws + WS_ROPED), 0.125f * 1.4426950408889634f, shm);
            xcd_barrier(xb);
            { const float* lp = p.in[14]; float s01 = 0.f, s23 = 0.f;
              for (int e = 0; e < 64; ++e) { s01 += lp[e] * lp[64 + e]; s23 += lp[128 + e] * lp[192 + e]; }
              const float lam_init = 0.8f - 0.6f * expf(-0.3f * 1.f); const float lam = expf(s01) - expf(s23) + lam_init;
              PH(1) headnorm_phase<0>(p, (const bf16_t*)(P + P_DO2), nullptr, nullptr, p.in[15], lam, 1.f - lam_init); }
            xcd_barrier(xb);
            gemm_resid<4>(H, wmo, D, true, p.out, p.out, mod + 2 * 1024, nullptr, (float*)(P + P_PARTO), shm);
        } else if constexpr (layer == 2) {
            { EpiHgrn e{P, (const float*)(p.ws + WS_LBV), p.ws + WS_EB}; gemm_phase(H, D, wmi, D, 5 * D, D, false, shm, e); }
            xcd_barrier(xb);
            PH(6) hgrn_scan_mfma(p, shm);
            xcd_barrier(xb);
            PH(1) headnorm_phase<1>(p, H, (const bf16_t*)(P + P_HOB), (const bf16_t*)(P + P_HG), p.in[19], 0.f, 1.f);
            xcd_barrier(xb);
            gemm_resid<4>(H, wmo, D, true, p.out, p.out, mod + 2 * 1024, nullptr, (float*)(P + P_PARTO), shm);
        } else {
            { bf16_t* QK = (bf16_t*)(P + P_GQK); bf16_t* Vt = (bf16_t*)(P + P_GVT); const int n1 = 72 * 5, n2 = NB * 9;
              gemm_loop(n1 + n2, D, shm,
                  [&](int L) { if (L < n1) { int pm, pn; tile_map(L, 72, 5, pm, pn); return Tile{H, wmi, D, D, D, pm * 256, pn * 256}; }
                               const int v = L - n1, b = v / 9, pn = v % 9; return Tile{wmi + (size_t)1280 * D, H + (size_t)b * LT * D, D, D, D, 0, pn * 256}; },
                  [&](int L, const AccT& acc, int brow, int bcol, int wr, int wc, int fr, int fq) {
                      if (L < n1) { EpiBf16 e{QK, (size_t)1280}; e(acc, brow, bcol, wr, wc, fr, fq); }
                      else { EpiBf16 e{Vt + (size_t)((L - n1) / 9) * 256 * LT, (size_t)LT}; e(acc, brow, bcol, wr, wc, fr, fq); } }); }
            xcd_barrier(xb);
            PH(3) qknorm_phase<64>((bf16_t*)(P + P_GQK), 1280, p.in[23], 0, (const f32x2*)(p.ws + WS_ROPEG));
            xcd_barrier(xb);
            PH(5) attn_phase<128, 1>((const bf16_t*)(P + P_GQK), 1280, (const bf16_t*)(P + P_GVT), 256, H, D, 8, true, p.in[22], (const f32x2*)(p.ws + WS_ROPEG), 0.08838834764831845f * 1.4426950408889634f, shm);
            xcd_barrier(xb);
            gemm_resid<4>(H, wmo, D, false, p.out, p.out, mod + 2 * 1024, nullptr, (float*)(P + P_PARTO), shm);
        }
        xcd_barrier(xb);
        PH(1) norm_phase(p, layer, 1, last, last ? nullptr : (const float*)(P + P_PARTO), 4, layer == 0 ? 2 : 0);
        xcd_barrier(xb);
        { EpiSwiglu e{(bf16_t*)(P + P_ACT)}; gemm_phase(H, D, wfi, D, 2 * DFF, D, last, shm, e); }
        xcd_barrier(xb);
        gemm_resid<8>((const bf16_t*)(P + P_ACT), wfo, DFF, !last, p.out, p.out, mod + 5 * 1024, nullptr, (float*)(P + P_PARTF), shm);
        if constexpr (layer < 3) xcd_barrier(xb);
    }

__global__ void __launch_bounds__(NTHR) fwd_megakernel(Params p) {
    extern __shared__ __attribute__((aligned(16))) char shm[];
    cg::grid_group grid = cg::this_grid();
    if (threadIdx.x < 4) ((unsigned*)(shm + 131072))[threadIdx.x] = 0u;
    __syncthreads();
    const XcdBarrier xb = xcd_barrier_post((unsigned*)(p.ws + WS_BAR), (volatile LAS unsigned*)(shm + 131072));
    PH(0) prologue(p, shm);
    if (p.ws == nullptr) grid.sync();
    xcd_barrier(xb);
    PH(0) mod_reduce(p);
    xcd_barrier(xb);
    layer_body<0>(p, xb, shm);
    layer_body<1>(p, xb, shm);
    layer_body<2>(p, xb, shm);
    layer_body<3>(p, xb, shm);
}

extern "C" void kernel_launch(void* const* d_in, const int* in_sizes, int n_in, void* d_out, int out_size, void* d_ws, size_t ws_size, hipStream_t stream) {
    static int grid_blocks = 0;
    if (grid_blocks == 0) {
        if (n_in != 25 || ws_size < WS_END) { fprintf(stderr, "kernel_launch: need 25 inputs and %zu bytes of workspace (got %d, %zu)\n", (size_t)WS_END, n_in, ws_size); grid_blocks = -1; return; }
        int dev = 0, cus = 0, per_cu = 0;
        hipGetDevice(&dev);
        hipDeviceGetAttribute(&cus, hipDeviceAttributeMultiprocessorCount, dev);
        if (hipFuncSetAttribute((const void*)fwd_megakernel, hipFuncAttributeMaxDynamicSharedMemorySize, LDS_BYTES) != hipSuccess) { fprintf(stderr, "kernel_launch: hipFuncSetAttribute failed\n"); grid_blocks = -1; return; }
        if (hipOccupancyMaxActiveBlocksPerMultiprocessor(&per_cu, (const void*)fwd_megakernel, NTHR, LDS_BYTES) != hipSuccess || per_cu < 1) { fprintf(stderr, "kernel_launch: occupancy query says %d blocks/CU\n", per_cu); grid_blocks = -1; return; }
        grid_blocks = cus;
    }
    if (grid_blocks < 0) return;
    if (hipMemsetAsync((char*)d_ws + WS_BAR, 0, 16384, stream) != hipSuccess) { fprintf(stderr, "kernel_launch: memset of barrier words failed\n"); return; }
    Params p{};
    for (int i = 0; i < 25; ++i) p.in[i] = (const float*)d_in[i];
    p.out = (float*)d_out; p.ws = (unsigned char*)d_ws;
    void* args[] = {&p};
    hipError_t e = hipLaunchCooperativeKernel((const void*)fwd_megakernel, dim3(grid_blocks), dim3(NTHR), args, LDS_BYTES, stream);
    if (e != hipSuccess) fprintf(stderr, "cooperative launch failed: %s (grid %d)\n", hipGetErrorString(e), grid_blocks);
}
```

```cpp
#include <hip/hip_runtime.h>
#include <hip/hip_cooperative_groups.h>
#include <cstdint>
#include <cstdio>
namespace cg = cooperative_groups;

#define DI __device__ __forceinline__
#ifndef PHMASK
#define PHMASK 0xFFFF
#endif
#define PH(bit) if ((PHMASK >> (bit)) & 1)
#define OPAQUE_IDS int tx = threadIdx.x; int bx = blockIdx.x; asm volatile("" : "+v"(tx), "+s"(bx));
typedef unsigned short bf16_t;
typedef short bf16x8 __attribute__((ext_vector_type(8)));
typedef short s16x4 __attribute__((ext_vector_type(4)));
typedef float f32x2 __attribute__((ext_vector_type(2)));
typedef float f32x4 __attribute__((ext_vector_type(4)));
typedef float f32x16 __attribute__((ext_vector_type(16)));
typedef unsigned u32x2 __attribute__((ext_vector_type(2)));
typedef unsigned u32x4 __attribute__((ext_vector_type(4)));

constexpr int NB = 8, LC = 256, LL = 2048, LT = 2304, T = NB * LT, D = 1024, DFF = 2816;
constexpr int NTHR = 512;
constexpr int LDS_BYTES = 131072 + 16;
constexpr float EPS = 1e-6f;

constexpr size_t al256(size_t x) { return (x + 255) & ~(size_t)255; }
constexpr size_t WS_CTXRES = 0;
constexpr size_t WS_MOD    = WS_CTXRES + (size_t)NB * LC * D * 4;
constexpr size_t WS_ROPED  = WS_MOD + (size_t)4 * 9 * 6144 * 4;
constexpr size_t WS_ROPEG  = WS_ROPED + (size_t)2048 * 32 * 8;
constexpr size_t WS_LBV    = WS_ROPEG + (size_t)2048 * 64 * 8;
constexpr size_t WS_WFI    = WS_LBV + 2 * 1024 * 4;
constexpr size_t WS_WFO    = WS_WFI + (size_t)5632 * 1024 * 2;
constexpr size_t WS_WMI    = WS_WFO + (size_t)1024 * 2816 * 2;
constexpr size_t WS_WMO    = WS_WMI + (size_t)5120 * 1024 * 2;
constexpr size_t WS_H      = WS_WMO + (size_t)1024 * 1024 * 2;
constexpr size_t WS_P      = WS_H + (size_t)T * D * 2;
constexpr size_t P_PART = 0;
constexpr size_t P_CDT  = P_PART + (size_t)16 * 4 * 9 * 6144 * 4;
constexpr size_t P_WL   = P_CDT + (size_t)2048 * 1024 * 2;
constexpr size_t P_WC   = P_WL + (size_t)2048 * 4096 * 2;
constexpr size_t P_GTL  = P_WC + (size_t)256 * 512 * 2;
constexpr size_t P_GTC  = P_GTL + (size_t)NB * 1024 * 4096 * 2;
constexpr size_t P_YB   = P_GTC + (size_t)NB * 1024 * 512 * 2;
constexpr size_t P_DQK = 0;
constexpr size_t P_DVT = P_DQK + (size_t)T * 2048 * 2;
constexpr size_t P_DO2 = P_DVT + (size_t)NB * 1024 * LT * 2;
constexpr size_t P_HQ  = 0;
constexpr size_t P_HF0 = P_HQ + (size_t)T * D * 2;
constexpr size_t P_HF1 = P_HF0 + (size_t)T * D * 4;
constexpr size_t P_HV  = P_HF1 + (size_t)T * D * 4;
constexpr size_t P_HG  = P_HV + (size_t)T * D * 2;
constexpr size_t P_HOB = P_HG + (size_t)T * D * 2;
constexpr size_t P_HEND = P_HOB + (size_t)T * D * 2;
constexpr size_t P_GQK = 0;
constexpr size_t P_GVT = P_GQK + (size_t)T * 1280 * 2;
constexpr size_t P_ACT = 0;
constexpr size_t P_PARTF = P_ACT + (size_t)T * DFF * 2;
constexpr size_t P_PARTO = 0;
constexpr size_t WS_BAR = WS_P + P_HEND;
constexpr size_t WS_EB  = WS_BAR + 16384;
constexpr size_t WS_END = WS_EB + (size_t)2 * NB * 144 * D * 4;

struct Params {
    const float* in[25];
    float* out;
    unsigned char* ws;
};

DI bf16_t f2bf(float x) { unsigned u = __float_as_uint(x); u += 0x7fffu + ((u >> 16) & 1u); return (bf16_t)(u >> 16); }
DI float bf2f(bf16_t v) { return __uint_as_float(((unsigned)v) << 16); }
typedef __bf16 bf16x2_t __attribute__((ext_vector_type(2)));
DI unsigned pack2(float lo, float hi) { const f32x2 v = (f32x2){lo, hi}; return __builtin_bit_cast(unsigned, __builtin_convertvector(v, bf16x2_t)); }
DI float bflo(unsigned w) { return __uint_as_float(w << 16); }
DI float bfhi(unsigned w) { return __uint_as_float(w & 0xffff0000u); }
DI float silu_f(float x) { return x / (1.f + __expf(-x)); }
DI float sigmoid_f(float x) { return 1.f / (1.f + __expf(-x)); }
DI float wave_sum(float v) {
    v += __shfl_xor(v, 32); v += __shfl_xor(v, 16); v += __shfl_xor(v, 8); v += __shfl_xor(v, 4); v += __shfl_xor(v, 2); v += __shfl_xor(v, 1);
    return v;
}
DI float* resid_row(const Params& p, int row) {
    const int b = row / LT, pos = row - b * LT;
    return pos < LC ? (float*)(p.ws + WS_CTXRES) + ((size_t)(b * LC + pos)) * D : p.out + ((size_t)(b * LL + pos - LC)) * D;
}
DI int cond_idx(int row) { const int b = row / LT, pos = row - b * LT; return pos < LC ? 8 : b; }

constexpr int BM = 256, BK = 64, HALF = 128, HTB = HALF * BK * 2;
DI int lds_byte(int r, int c) { int st = (r >> 4) * 2 + (c >> 5), rr = r & 15, cc = c & 31, ob = rr * 64 + cc * 2; return st * 1024 + (ob ^ (((ob >> 9) & 1) << 5)); }
DI void stage_rc(int b, int& R, int& C) { int st = b / 1024, sb = b % 1024, swz = sb ^ (((sb >> 9) & 1) << 5); R = (st >> 1) * 16 + swz / 64; C = (st & 1) * 32 + (swz % 64) / 2; }

typedef f32x4 AccT[2][2][4][2];

struct Tile { const bf16_t* A; const bf16_t* Bt; int lda, ldb, K, brow, bcol; };
#define LAS __attribute__((address_space(3)))
template <class Get, class Epi>
DI void gemm_loop(int ntiles, int ld, char* shm, const Get& get, const Epi& epi) {
    int tx = threadIdx.x, bx = blockIdx.x; asm volatile("" : "+v"(tx), "+s"(bx));
    if (!((PHMASK >> 7) & 1)) return;
    LAS unsigned char* lds = (LAS unsigned char*)shm;
    const int tid = tx, wid = __builtin_amdgcn_readfirstlane(tid >> 6), lane = tid & 63, wr = wid >> 2, wc = wid & 3, fr = lane & 15, fq = lane >> 4;
    unsigned voffA[2], voffB[2];
#pragma unroll
    for (int i = 0; i < 2; ++i) { int R, C; stage_rc(tid * 16 + i * 8192, R, C); const int rho = R & 31, Rb = (R & ~31) + 8 * ((rho & 15) >> 2) + 4 * (rho >> 4) + (rho & 3);
        voffA[i] = (unsigned)(R * ld + C) * 2u; voffB[i] = (unsigned)(Rb * ld + C) * 2u; }
    const size_t kstep = (size_t)(BK * 2), hstep = (size_t)HALF * ld * 2;
    const unsigned ldsw = (unsigned)wid * 1024u;
    const int aoff = lds_byte(wr * 64 + fr, fq * 8), boff = lds_byte(wc * 32 + fr, fq * 8);
#define G_SA(b, h) (((b) * 2 + (h)) * HTB)
#define G_SB(b, h) ((4 + (b) * 2 + (h)) * HTB)
#define G_STAGE(bufoff, gbase, voff) do { _Pragma("unroll") for (int _i = 0; _i < 2; ++_i) \
        __builtin_amdgcn_global_load_lds((const unsigned*)((const char*)(gbase) + voff[_i]), (LAS unsigned*)(lds + (bufoff) + ldsw + _i * 8192), 16, 0, 0); } while (0)
#define G_LDA(dst, b, h) do { _Pragma("unroll") for (int m = 0; m < 4; ++m) _Pragma("unroll") for (int k = 0; k < 2; ++k) dst[m][k] = *(const LAS bf16x8*)(lds + G_SA(b, h) + aoff + m * 2048 + k * 1024); } while (0)
#define G_LDB(dst, b, h) do { _Pragma("unroll") for (int n = 0; n < 2; ++n) _Pragma("unroll") for (int k = 0; k < 2; ++k) dst[n][k] = *(const LAS bf16x8*)(lds + G_SB(b, h) + boff + n * 2048 + k * 1024); } while (0)
#define G_MMA(ai, bj, At_, Bt_) do { __builtin_amdgcn_s_setprio(1); _Pragma("unroll") for (int m = 0; m < 4; ++m) _Pragma("unroll") for (int n = 0; n < 2; ++n) _Pragma("unroll") for (int k = 0; k < 2; ++k) \
        acc[ai][bj][m][n] = __builtin_amdgcn_mfma_f32_16x16x32_bf16(Bt_[n][k], At_[m][k], acc[ai][bj][m][n], 0, 0, 0); __builtin_amdgcn_s_setprio(0); } while (0)
#define WAIT_V(n) asm volatile("s_waitcnt vmcnt(" #n ")" ::: "memory")
#define WAIT_L(n) asm volatile("s_waitcnt lgkmcnt(" #n ")" ::: "memory")
#define BAR __builtin_amdgcn_s_barrier()
#define SCHED __builtin_amdgcn_sched_barrier(0)
    int L = bx; if (L >= ntiles) return;
    Tile cur = get(L), nxt = cur;
    AccT acc;
#define G_ZERO _Pragma("unroll") for (int a = 0; a < 2; ++a) _Pragma("unroll") for (int b = 0; b < 2; ++b) _Pragma("unroll") for (int m = 0; m < 4; ++m) _Pragma("unroll") for (int n = 0; n < 2; ++n) acc[a][b][m][n] = (f32x4){0.f, 0.f, 0.f, 0.f}
    G_ZERO;
    bf16x8 At[4][2], B0[2][2], B1[2][2];
    const char* cA = (const char*)cur.A + (size_t)cur.brow * ld * 2; const char* cB = (const char*)cur.Bt + (size_t)cur.bcol * ld * 2;
    G_STAGE(G_SB(0, 0), cB, voffB); G_STAGE(G_SB(0, 1), cB + hstep, voffB); G_STAGE(G_SA(0, 0), cA, voffA); G_STAGE(G_SA(0, 1), cA + hstep, voffA);
    if (wr == 1) BAR;
    WAIT_V(2); BAR;
    G_STAGE(G_SB(1, 0), cB + kstep, voffB); G_STAGE(G_SA(1, 0), cA + kstep, voffA); G_STAGE(G_SB(1, 1), cB + hstep + kstep, voffB);
    WAIT_V(6); BAR;
    for (;;) {
        const int Ln = L + gridDim.x; const bool has_next = Ln < ntiles; if (has_next) nxt = get(Ln);
        const char* nA = has_next ? (const char*)nxt.A + (size_t)nxt.brow * ld * 2 : cA; const char* nB = has_next ? (const char*)nxt.Bt + (size_t)nxt.bcol * ld * 2 : cB;
        const int nt = cur.K / BK;
        for (int t = 0; t < nt; t += 2) {
            const bool last = (t == nt - 2);
            const char* a1 = cA + (size_t)(t + 1) * kstep;
            const char* a2 = last ? nA : cA + (size_t)(t + 2) * kstep; const char* b2 = last ? nB : cB + (size_t)(t + 2) * kstep;
            const char* a3 = a2 + kstep; const char* b3 = b2 + kstep;
            G_LDB(B0, 0, 0); G_LDB(B1, 0, 1); SCHED; G_LDA(At, 0, 0); G_STAGE(G_SA(1, 1), a1 + hstep, voffA);
            WAIT_V(8); WAIT_L(0); BAR; G_MMA(0, 0, At, B0); G_MMA(0, 1, At, B1); BAR; SCHED;
            G_LDA(At, 0, 1); G_STAGE(G_SB(0, 0), b2, voffB); G_STAGE(G_SB(0, 1), b2 + hstep, voffB); G_STAGE(G_SA(0, 0), a2, voffA);
            WAIT_V(8); WAIT_L(0); BAR; G_MMA(1, 0, At, B0); G_MMA(1, 1, At, B1); BAR; SCHED;
            G_LDB(B0, 1, 0); G_LDB(B1, 1, 1); SCHED; G_LDA(At, 1, 0); G_STAGE(G_SA(0, 1), a2 + hstep, voffA);
            WAIT_V(8); WAIT_L(0); BAR; G_MMA(0, 0, At, B0); G_MMA(0, 1, At, B1); BAR; SCHED;
            G_LDA(At, 1, 1); G_STAGE(G_SB(1, 0), b3, voffB); G_STAGE(G_SB(1, 1), b3 + hstep, voffB); G_STAGE(G_SA(1, 0), a3, voffA);
            WAIT_V(8); WAIT_L(0); BAR; G_MMA(1, 0, At, B0); G_MMA(1, 1, At, B1); BAR; SCHED;
        }
        if (wr == 0) BAR;
        { int tx2 = threadIdx.x, brow2 = cur.brow, bcol2 = cur.bcol, Lo = L; asm volatile("" : "+v"(tx2), "+s"(brow2), "+s"(bcol2), "+s"(Lo));
          const int wid2 = tx2 >> 6, lane2 = tx2 & 63; epi(Lo, acc, brow2, bcol2, wid2 >> 2, wid2 & 3, lane2 & 15, lane2 >> 4); }
        if (!has_next) break;
        G_ZERO;
        cur = nxt; cA = nA; cB = nB; L = Ln;
        if (wr == 1) BAR;
    }
    WAIT_V(0);
    BAR;
#undef G_SA
#undef G_SB
#undef G_STAGE
#undef G_LDA
#undef G_LDB
#undef G_MMA
#undef G_ZERO
}
DI void tile_map(int L, int nM, int nN, int& pm, int& pn) {
    const int nwg = nM * nN; int wgid = L;
    { const int q = nwg / 8, r = nwg % 8, xcd = wgid % 8, off = wgid / 8; wgid = (xcd < r ? xcd * (q + 1) : r * (q + 1) + (xcd - r) * q) + off; }
    const int nig = 8 * nN, gid = wgid / nig, fm = gid * 8, gsz = (nM - fm) < 8 ? (nM - fm) : 8;
    pm = fm + ((wgid % nig) % gsz); pn = (wgid % nig) / gsz;
}

#define EPI_LOOP_ROWS _Pragma("unroll") for (int ai = 0; ai < 2; ++ai) _Pragma("unroll") for (int m = 0; m < 4; ++m)
#define EPI_LOOP_BJ _Pragma("unroll") for (int bj = 0; bj < 2; ++bj)
DI u32x4 pack8(const f32x4 a, const f32x4 b) { return (u32x4){pack2(a[0], a[1]), pack2(a[2], a[3]), pack2(b[0], b[1]), pack2(b[2], b[3])}; }

struct EpiBf16 {
    bf16_t* C; size_t ldc;
    DI void operator()(const AccT& acc, int brow, int bcol, int wr, int wc, int fr, int fq) const {
        EPI_LOOP_ROWS { const size_t row = brow + ai * 128 + wr * 64 + m * 16 + fr;
            EPI_LOOP_BJ { const int col = bcol + bj * 128 + wc * 32 + fq * 8; *(u32x4*)(C + row * ldc + col) = pack8(acc[ai][bj][m][0], acc[ai][bj][m][1]); } }
    }
};
struct EpiFnet1 {
    bf16_t* GtL; bf16_t* GtC; int b;
    DI void operator()(const AccT& acc, int brow, int bcol, int wr, int wc, int fr, int fq) const {
        const int cs = brow >= 1024; const bool isctx = bcol < LC;
        EPI_LOOP_ROWS { const int ch = brow + ai * 128 + wr * 64 + m * 16 + fr - cs * 1024;
            bf16_t* dst = isctx ? GtC + ((size_t)(b * 1024 + ch)) * 512 + cs * 256 : GtL + ((size_t)(b * 1024 + ch)) * 4096 + cs * 2048 - LC;
            EPI_LOOP_BJ { const int col = bcol + bj * 128 + wc * 32 + fq * 8; *(u32x4*)(dst + col) = pack8(acc[ai][bj][m][0], acc[ai][bj][m][1]); } }
    }
};
struct EpiResid {
    float* base; const float* src; const float* gate; const float* bias; bool rmw;
    DI void operator()(const AccT& acc, int brow, int bcol, int wr, int wc, int fr, int fq) const {
        EPI_LOOP_BJ { const int col = bcol + bj * 128 + wc * 32 + fq * 8;
            const f32x4 g0 = *(const f32x4*)(gate + col), g1 = *(const f32x4*)(gate + col + 4); f32x4 b0 = (f32x4){0.f, 0.f, 0.f, 0.f}, b1 = b0; if (bias) { b0 = *(const f32x4*)(bias + col); b1 = *(const f32x4*)(bias + col + 4); }
            EPI_LOOP_ROWS { const size_t eo = (size_t)(ai * 128 + wr * 64 + m * 16 + fr) * D + col; float* q = base + eo;
                f32x4 x0 = (f32x4){0.f, 0.f, 0.f, 0.f}, x1 = x0; if (rmw) { x0 = *(const f32x4*)(src + eo); x1 = *(const f32x4*)(src + eo + 4); }
                x0 += g0 * (acc[ai][bj][m][0] + b0); x1 += g1 * (acc[ai][bj][m][1] + b1); *(f32x4*)q = x0; *(f32x4*)(q + 4) = x1; } }
    }
};
struct EpiSwiglu {
    bf16_t* ACT;
    DI void operator()(const AccT& acc, int brow, int bcol, int wr, int wc, int fr, int fq) const {
        const int col = (bcol >> 1) + wc * 32 + fq * 8;
        EPI_LOOP_ROWS { const size_t row = brow + ai * 128 + wr * 64 + m * 16 + fr; f32x4 o[2];
#pragma unroll
            for (int n = 0; n < 2; ++n) { const f32x4 g = acc[ai][0][m][n], u = acc[ai][1][m][n];
#pragma unroll
                for (int j = 0; j < 4; ++j) o[n][j] = silu_f(g[j]) * u[j]; }
            *(u32x4*)(ACT + row * DFF + col) = pack8(o[0], o[1]); }
    }
};
template <int CTRL> DI float dpp_f(float x) { return __int_as_float(__builtin_amdgcn_update_dpp(0, __float_as_int(x), CTRL, 0xF, 0xF, true)); }
struct EpiHgrn {
    unsigned char* P; const float* lbv; unsigned char* ebase;
    DI void operator()(const AccT& acc, int brow, int bcol, int wr, int wc, int fr, int fq) const {
        const int seg = bcol >> 10, cb = bcol & 1023;
        EPI_LOOP_BJ { const int col = cb + bj * 128 + wc * 32 + fq * 8;
            if (seg == 1 || seg == 2) {
                const int dir = seg - 1;
                const f32x4 lb0 = *(const f32x4*)(lbv + dir * 1024 + col), lb1 = *(const f32x4*)(lbv + dir * 1024 + col + 4);
                bf16_t* EK = (bf16_t*)(P + (dir ? P_HF1 : P_HF0)); float* EBp = (float*)(ebase);
                const int lane_ = fq * 16 + fr;
#pragma unroll
                for (int ai = 0; ai < 2; ++ai)
#pragma unroll
                for (int mp = 0; mp < 2; ++mp) {
                    const size_t row0 = brow + ai * 128 + wr * 64 + mp * 32 + fr, row1 = row0 + 16;
                    float fa[8], fb[8], xa[8], xb[8];
#pragma unroll
                    for (int j = 0; j < 4; ++j) { fa[j] = lb0[j] + (1.f - lb0[j]) * sigmoid_f(acc[ai][bj][2 * mp][0][j]); fa[4 + j] = lb1[j] + (1.f - lb1[j]) * sigmoid_f(acc[ai][bj][2 * mp][1][j]);
                                                  fb[j] = lb0[j] + (1.f - lb0[j]) * sigmoid_f(acc[ai][bj][2 * mp + 1][0][j]); fb[4 + j] = lb1[j] + (1.f - lb1[j]) * sigmoid_f(acc[ai][bj][2 * mp + 1][1][j]); }
#pragma unroll
                    for (int j = 0; j < 8; ++j) { float x = __logf(fa[j]), y = __logf(fb[j]);
                        if (dir == 0) { x += dpp_f<0x111>(x); x += dpp_f<0x112>(x); x += dpp_f<0x114>(x); x += dpp_f<0x118>(x);
                                        y += dpp_f<0x111>(y); y += dpp_f<0x112>(y); y += dpp_f<0x114>(y); y += dpp_f<0x118>(y);
                                        y += __shfl(x, (lane_ & 48) | 15); }
                        else { x += dpp_f<0x101>(x); x += dpp_f<0x102>(x); x += dpp_f<0x104>(x); x += dpp_f<0x108>(x);
                               y += dpp_f<0x101>(y); y += dpp_f<0x102>(y); y += dpp_f<0x104>(y); y += dpp_f<0x108>(y);
                               x += __shfl(y, lane_ & 48); }
                        xa[j] = x; xb[j] = y; }
                    f32x4 e0, e1, k0, k1;
#pragma unroll
                    for (int j = 0; j < 4; ++j) { e0[j] = __expf(xa[j]); e1[j] = __expf(xa[4 + j]); k0[j] = (1.f - fa[j]) * __expf(fminf(-xa[j], 80.f)); k1[j] = (1.f - fa[4 + j]) * __expf(fminf(-xa[4 + j], 80.f)); }
                    *(u32x4*)(EK + row0 * 2048 + col) = pack8(e0, e1); *(u32x4*)(EK + row0 * 2048 + 1024 + col) = pack8(k0, k1);
                    if (dir == 1 && fr == 0) { const int b_ = (int)(row0 / LT), pos = (int)(row0 - (size_t)b_ * LT); const int tau = pos < LC ? LC - 1 - pos : LT + LC - 1 - pos;
                        float* ep = EBp + ((size_t)(NB + b_) * 72 + (tau >> 5)) * D + col; *(f32x4*)ep = e0; *(f32x4*)(ep + 4) = e1; }
#pragma unroll
                    for (int j = 0; j < 4; ++j) { e0[j] = __expf(xb[j]); e1[j] = __expf(xb[4 + j]); k0[j] = (1.f - fb[j]) * __expf(fminf(-xb[j], 80.f)); k1[j] = (1.f - fb[4 + j]) * __expf(fminf(-xb[4 + j], 80.f)); }
                    *(u32x4*)(EK + row1 * 2048 + col) = pack8(e0, e1); *(u32x4*)(EK + row1 * 2048 + 1024 + col) = pack8(k0, k1);
                    if (dir == 0 && fr == 15) { const int b_ = (int)(row1 / LT), pos = (int)(row1 - (size_t)b_ * LT);
                        float* ep = EBp + ((size_t)b_ * 72 + (pos >> 5)) * D + col; *(f32x4*)ep = e0; *(f32x4*)(ep + 4) = e1; }
                }
            } else {
                bf16_t* C = (bf16_t*)(P + (seg == 0 ? P_HQ : (seg == 3 ? P_HV : P_HG)));
                EPI_LOOP_ROWS { const size_t row = brow + ai * 128 + wr * 64 + m * 16 + fr; f32x4 v0 = acc[ai][bj][m][0], v1 = acc[ai][bj][m][1];
                    if (seg == 0) {
#pragma unroll
                        for (int j = 0; j < 4; ++j) { v0[j] = silu_f(v0[j]); v1[j] = silu_f(v1[j]); } }
                    *(u32x4*)(C + row * D + col) = pack8(v0, v1); }
            } }
    }
};

template <class Epi>
DI void gemm_phase(const bf16_t* A, int lda, const bf16_t* Bt, int ldb, int N, int K, bool lat_only, char* shm, const Epi& epi) {
    const int nM = lat_only ? 64 : 72, nN = N / BM;
    gemm_loop(nM * nN, lda, shm, [&](int L) { int pm, pn; tile_map(L, nM, nN, pm, pn); if (lat_only) pm = (pm >> 3) * 9 + 1 + (pm & 7); return Tile{A, Bt, lda, ldb, K, pm * BM, pn * BM}; },
              [&](int, const AccT& acc, int brow, int bcol, int wr, int wc, int fr, int fq) { epi(acc, brow, bcol, wr, wc, fr, fq); });
}
template <int S>
DI void gemm_resid(const bf16_t* A, const bf16_t* Bt, int K, bool with_ctx, float* out, const float* xin, const float* gate, const float* bias, float* part, char* shm) {
    const int U = K / 128, ub = U / S, ur = U % S;
    gemm_loop(256 + (with_ctx ? 32 * S : 0), K, shm,
              [&](int L) { if (L < 256) { int pm, pn; tile_map(L, 64, 4, pm, pn); pm = (pm >> 3) * 9 + 1 + (pm & 7); return Tile{A, Bt, K, K, K, pm * BM, pn * BM}; }
                           const int v = L - 256, s = v % S, tt = v / S, b = tt >> 2, pn = tt & 3; const int u0 = s * ub + (s < ur ? s : ur), nu = ub + (s < ur ? 1 : 0);
                           return Tile{A + u0 * 128, Bt + u0 * 128, K, K, nu * 128, b * LT, pn * BM}; },
              [&](int L, const AccT& acc, int brow, int bcol, int wr, int wc, int fr, int fq) {
                  const int b = brow / LT; EpiResid e;
                  if (L < 256) { const size_t ro = ((size_t)(b * LL + (brow - b * LT) - LC)) * D; e.base = out + ro; e.src = xin + ro; e.gate = gate + (size_t)b * 6144; e.bias = bias; e.rmw = true; }
                  else { const int s = (L - 256) % S; e.base = part + ((size_t)s * NB * LC + b * LC) * D; e.src = e.base; e.gate = gate + (size_t)8 * 6144; e.bias = s == 0 ? bias : nullptr; e.rmw = false; }
                  e(acc, brow, bcol, wr, wc, fr, fq); });
}

struct ConvJob { const float* src; bf16_t* dst; int ldsrc, K, N, mode; };
DI void conv_jobs(const ConvJob j0, const ConvJob j1, const ConvJob j2, const ConvJob j3, char* shm) {
    OPAQUE_IDS
    float* tile = (float*)shm;
    const int tid = tx;
    const int c1 = (j0.K / 64) * (j0.N / 256), c2 = c1 + (j1.K / 64) * (j1.N / 256), c3 = c2 + (j2.K / 64) * (j2.N / 256), c4 = c3 + (j3.K / 64) * (j3.N / 256);
    for (int L = bx; L < c4; L += gridDim.x) {
        const float* __restrict__ src = j0.src; bf16_t* __restrict__ dst = j0.dst; int ldsrc = j0.ldsrc, K = j0.K, mode = j0.mode, base = 0;
        if (L >= c1) { src = j1.src; dst = j1.dst; ldsrc = j1.ldsrc; K = j1.K; mode = j1.mode; base = c1; }
        if (L >= c2) { src = j2.src; dst = j2.dst; ldsrc = j2.ldsrc; K = j2.K; mode = j2.mode; base = c2; }
        if (L >= c3) { src = j3.src; dst = j3.dst; ldsrc = j3.ldsrc; K = j3.K; mode = j3.mode; base = c3; }
        const int nk = K / 64, Ll = L - base, tk = Ll % nk, ts = Ll / nk, n0 = ts * 256;
        __syncthreads();
        f32x4 v[8];
#pragma unroll
        for (int i = 0; i < 8; ++i) { const int e = tid + i * NTHR, kk = e >> 6, n4 = (e & 63) * 4;
            const int scol = mode == 1 ? ((n4 >> 7) ? 2816 + ts * 128 + (n4 & 127) : ts * 128 + n4) : n0 + n4;
            v[i] = *(const f32x4*)(src + (size_t)(tk * 64 + kk) * ldsrc + scol); }
#pragma unroll
        for (int i = 0; i < 8; ++i) { const int e = tid + i * NTHR, kk = e >> 6, n4 = (e & 63) * 4; *(f32x4*)(tile + kk * 260 + (n4 ^ (((kk >> 3) & 7) << 3))) = v[i]; }
        __syncthreads();
#pragma unroll
        for (int i = 0; i < 4; ++i) { const int n = (tid >> 3) + 64 * i, m = tid & 7, kc = m * 8; const float* tp = tile + kc * 260 + (n ^ (m << 3)); u32x4 w;
            w.x = pack2(tp[0], tp[260]); w.y = pack2(tp[2 * 260], tp[3 * 260]); w.z = pack2(tp[4 * 260], tp[5 * 260]); w.w = pack2(tp[6 * 260], tp[7 * 260]);
            *(u32x4*)(dst + (size_t)(n0 + n) * K + tk * 64 + kc) = w; }
    }
    __syncthreads();
}
DI void convert_layer(const Params& p, int i, char* shm) {
    bf16_t* wfi = (bf16_t*)(p.ws + WS_WFI); bf16_t* wfo = (bf16_t*)(p.ws + WS_WFO); bf16_t* wmi = (bf16_t*)(p.ws + WS_WMI); bf16_t* wmo = (bf16_t*)(p.ws + WS_WMO);
    const ConvJob jf1{p.in[7] + (size_t)i * D * 2 * DFF, wfi, 2 * DFF, D, 2 * DFF, 1}, jf2{p.in[8] + (size_t)i * DFF * D, wfo, D, DFF, D, 0};
    const float* msrc = i == 1 ? p.in[11] : (i == 2 ? p.in[17] : p.in[21]); const int mN = i == 0 ? 0 : (i == 1 ? 3 * D : (i == 2 ? 5 * D : 1536));
    const float* osrc = i == 0 ? p.in[9] : (i == 1 ? p.in[16] : (i == 2 ? p.in[20] : p.in[24]));
    const ConvJob jm{msrc, wmi, mN, D, mN, 0}, jo{osrc, wmo, D, D, D, 0};
    conv_jobs(jf1, jf2, jm, jo, shm);
}

DI void prologue(const Params& p, char* shm) {
    OPAQUE_IDS
    const size_t gtid = (size_t)bx * NTHR + tx, gn = (size_t)gridDim.x * NTHR;
    { float* cond = (float*)shm;
      float* part = (float*)(p.ws + WS_P + P_PART);
      for (int it = bx; it < 4 * 16 * 12; it += gridDim.x) {
          const int cb = it % 12, ks = (it / 12) % 16, Ly = it / (12 * 16);
          __syncthreads();
          for (int e = tx; e < 9 * 64; e += NTHR) { const int ci = e >> 6, k = ks * 64 + (e & 63); const float v = ci < 8 ? p.in[1][ci * D + k] : p.in[3][k]; cond[e] = silu_f(v); }
          __syncthreads();
          const int col = cb * 512 + tx; const float* w = p.in[4] + ((size_t)Ly * D + ks * 64) * 6144 + col;
          float a[9];
#pragma unroll
          for (int c = 0; c < 9; ++c) a[c] = 0.f;
          for (int k = 0; k < 64; ++k) { const float wv = w[(size_t)k * 6144];
#pragma unroll
              for (int c = 0; c < 9; ++c) a[c] += cond[c * 64 + k] * wv; }
#pragma unroll
          for (int c = 0; c < 9; ++c) part[(((size_t)ks * 4 + Ly) * 9 + c) * 6144 + col] = a[c];
      }
      __syncthreads(); }
    { f32x2* rd = (f32x2*)(p.ws + WS_ROPED); f32x2* rg = (f32x2*)(p.ws + WS_ROPEG);
      for (size_t i = gtid; i < (size_t)2048 * 32; i += gn) { const int pos = (int)(i >> 5), pp = (int)(i & 31); const int j = pp & 15; const float inv = exp2f(-(float)j * (13.287712379549449f / 16.f));
          const float ang = (float)(pp < 16 ? (pos >> 6) : (pos & 63)) * inv; float s, c; sincosf(ang, &s, &c); rd[i] = (f32x2){c, s}; }
      for (size_t i = gtid; i < (size_t)2048 * 64; i += gn) { const int pos = (int)(i >> 6), pp = (int)(i & 63); const int j = pp & 31; const float inv = exp2f(-(float)j * (13.287712379549449f / 32.f));
          const float ang = (float)(pp < 32 ? (pos >> 6) : (pos & 63)) * inv; float s, c; sincosf(ang, &s, &c); rg[i] = (f32x2){c, s}; } }
    { float* lbv = (float*)(p.ws + WS_LBV); const float* lbp = p.in[18];
      for (size_t i = gtid; i < 2048; i += gn) { const int d = (int)(i >> 10), c = (int)(i & 1023); const float* q = lbp + (size_t)d * 4 * 1024 + c;
          const float v0 = q[0], v1 = q[1024], v2 = q[2048], v3 = q[3072]; const float mx = fmaxf(fmaxf(v0, v1), fmaxf(v2, v3));
          const float e0 = expf(v0 - mx), e1 = expf(v1 - mx), e2 = expf(v2 - mx), e3 = expf(v3 - mx); lbv[i] = (e1 + e2) / (e0 + e1 + e2 + e3); } }
    { bf16_t* cdt = (bf16_t*)(p.ws + WS_P + P_CDT); bf16_t* wl = (bf16_t*)(p.ws + WS_P + P_WL); bf16_t* wc = (bf16_t*)(p.ws + WS_P + P_WC);
      const float sc128 = 0.08838834764831845f, sc2048 = 0.022097086912079608f, sc256 = 0.0625f;
      for (size_t i = gtid; i < (size_t)2048 * 1024; i += gn) { const int m = (int)(i >> 10), k = (int)(i & 1023); const int cs = m >> 10, ch = m & 1023; float v = 0.f;
          if ((ch >> 7) == (k >> 7)) { const int e = ((ch & 127) * (k & 127)) & 127; const float a = (float)e * (2.f / 128.f); v = (cs ? sinpif(a) : cospif(a)) * sc128; }
          cdt[i] = f2bf(v); }
      for (size_t i = gtid; i < (size_t)2048 * 4096; i += gn) { const int kf = (int)(i >> 12), kk = (int)(i & 4095); const int cs = kk >> 11, t = kk & 2047; const int e = (kf * t) & 2047;
          const float a = (float)e * (2.f / 2048.f); wl[i] = f2bf((cs ? -sinpif(a) : cospif(a)) * sc2048); }
      for (size_t i = gtid; i < (size_t)256 * 512; i += gn) { const int kf = (int)(i >> 9), kk = (int)(i & 511); const int cs = kk >> 8, t = kk & 255; const int e = (kf * t) & 255;
          const float a = (float)e * (2.f / 256.f); wc[i] = f2bf((cs ? -sinpif(a) : cospif(a)) * sc256); } }
    convert_layer(p, 0, shm);
}
DI void mod_reduce(const Params& p) {
    OPAQUE_IDS
    const size_t gtid = (size_t)bx * NTHR + tx, gn = (size_t)gridDim.x * NTHR;
    const float* part = (const float*)(p.ws + WS_P + P_PART); float* mod = (float*)(p.ws + WS_MOD);
    for (size_t i = gtid; i < (size_t)4 * 9 * 6144; i += gn) { const int col = (int)(i % 6144), Ly = (int)(i / (9 * 6144));
        float a = p.in[5][(size_t)Ly * 6144 + col];
        for (int ks = 0; ks < 16; ++ks) a += part[(size_t)ks * 4 * 9 * 6144 + i];
        mod[i] = a; }
}

DI void norm_phase(const Params& p, int layer, int which, bool lat_only, const float* __restrict__ part, int npart, int srcmode) {
    OPAQUE_IDS
    const int lane = tx & 63, gw = bx * 8 + (tx >> 6);
    const float* gain = p.in[6] + ((size_t)layer * 2 + which) * D; const float* mod = (const float*)(p.ws + WS_MOD) + (size_t)layer * 9 * 6144;
    bf16_t* H = (bf16_t*)(p.ws + WS_H);
    f32x4 gm[4], sh[4]; int cur_ci = -1;
    const int nw = gridDim.x * 8;
    for (int vw = gw; vw < NB * 256; vw += nw)
    for (int i0 = 0; i0 < 9; i0 += 3) {
        const int r0 = (vw >> 8) * LT + (vw & 255) + 256 * i0;
        f32x4 v[3][4]; float ss[3]; bool ok[3];
#pragma unroll
        for (int q = 0; q < 3; ++q) {
            const int row = r0 + 256 * q; const int b = row / LT, pos = row - b * LT;
            ok[q] = !(lat_only && pos < LC); ss[q] = 0.f;
            if (ok[q]) {
                float* x = resid_row(p, row);
                const float* xs = (srcmode == 1 || (srcmode == 2 && pos < LC)) ? (pos < LC ? p.in[2] + ((size_t)(b * LC + pos)) * D : p.in[0] + ((size_t)(b * LL + pos - LC)) * D) : x;
#pragma unroll
                for (int j = 0; j < 4; ++j) v[q][j] = *(const f32x4*)(xs + j * 256 + lane * 4);
                if (part != nullptr && pos < LC) {
                    f32x4 a[4];
#pragma unroll
                    for (int j = 0; j < 4; ++j) a[j] = (f32x4){0.f, 0.f, 0.f, 0.f};
                    const float* pp = part + (size_t)(b * LC + pos) * D + lane * 4;
                    for (int s = 0; s < npart; ++s) {
#pragma unroll
                        for (int j = 0; j < 4; ++j) a[j] += *(const f32x4*)(pp + (size_t)s * NB * LC * D + j * 256); }
#pragma unroll
                    for (int j = 0; j < 4; ++j) { v[q][j] += a[j]; *(f32x4*)(x + j * 256 + lane * 4) = v[q][j]; }
                }
#pragma unroll
                for (int j = 0; j < 4; ++j) ss[q] += v[q][j][0] * v[q][j][0] + v[q][j][1] * v[q][j][1] + v[q][j][2] * v[q][j][2] + v[q][j][3] * v[q][j][3];
            }
        }
        ss[0] = wave_sum(ss[0]); ss[1] = wave_sum(ss[1]); ss[2] = wave_sum(ss[2]);
#pragma unroll
        for (int q = 0; q < 3; ++q) {
            if (!ok[q]) continue;
            const int row = r0 + 256 * q; const int ci = cond_idx(row);
            if (ci != cur_ci) { cur_ci = ci; const float* mo = mod + (size_t)ci * 6144 + which * 3072;
#pragma unroll
                for (int j = 0; j < 4; ++j) { const int col = j * 256 + lane * 4; gm[j] = *(const f32x4*)(gain + col) * (1.f + *(const f32x4*)(mo + 1024 + col)); sh[j] = *(const f32x4*)(mo + col); } }
            const float r = rsqrtf(ss[q] * (1.f / 1024.f) + EPS);
#pragma unroll
            for (int j = 0; j < 4; ++j) { const int col = j * 256 + lane * 4; const f32x4 y = v[q][j] * r * gm[j] + sh[j];
                *(u32x2*)(H + (size_t)row * D + col) = (u32x2){pack2(y[0], y[1]), pack2(y[2], y[3])}; }
        }
    }
}

template <int HS>
DI void qknorm_phase(bf16_t* QK, int RL, const float* kgain, int gain_mod, const f32x2* rope) {
    OPAQUE_IDS
    const int lane = tx & 63, gw = bx * 8 + (tx >> 6), nw = gridDim.x * 8;
    const int lpr = (RL - 1024) / HS, rpw = 64 / lpr, rsub = lane / lpr, kl = lane - rsub * lpr, seg = kl >> 1, half = kl & 1;
    const float* gn = kgain + (gain_mod ? (seg % gain_mod) * 2 * HS : 0) + half * HS;
    for (int row0 = gw * rpw; row0 < T; row0 += nw * rpw) {
        const int row = row0 + rsub; const bool act = row < T; const int rowc = act ? row : T - 1;
        const int b = rowc / LT, pos = rowc - b * LT;
        float x[HS]; float ss = 0.f;
        bf16_t* ptr = QK + (size_t)rowc * RL + 1024 + kl * HS;
#pragma unroll
        for (int c = 0; c < HS / 8; ++c) { const u32x4 w = *(const u32x4*)(ptr + c * 8);
            x[c * 8 + 0] = bflo(w.x); x[c * 8 + 1] = bfhi(w.x); x[c * 8 + 2] = bflo(w.y); x[c * 8 + 3] = bfhi(w.y);
            x[c * 8 + 4] = bflo(w.z); x[c * 8 + 5] = bfhi(w.z); x[c * 8 + 6] = bflo(w.w); x[c * 8 + 7] = bfhi(w.w); }
#pragma unroll
        for (int e = 0; e < HS; ++e) ss += x[e] * x[e];
        ss += dpp_f<0xB1>(ss);
        const float r = rsqrtf(ss * (1.f / (2 * HS)) + EPS);
        const bool lat = pos >= LC; const f32x2* rp = rope + (size_t)(lat ? pos - LC : 0) * HS;
#pragma unroll
        for (int e = 0; e < HS; ++e) {
            float v = x[e] * r * gn[e];
            const float o = dpp_f<0xB1>(v);
            if (lat) { const f32x2 cs = rp[e]; v = half ? (o * cs[1] + v * cs[0]) : (v * cs[0] - o * cs[1]); }
            x[e] = v;
        }
        if (act) {
#pragma unroll
            for (int c = 0; c < HS / 8; ++c) { u32x4 w; w.x = pack2(x[c * 8], x[c * 8 + 1]); w.y = pack2(x[c * 8 + 2], x[c * 8 + 3]); w.z = pack2(x[c * 8 + 4], x[c * 8 + 5]); w.w = pack2(x[c * 8 + 6], x[c * 8 + 7]);
                *(u32x4*)(ptr + c * 8) = w; }
        }
    }
}
DI float half_swap_max(float x) { const unsigned u = __float_as_uint(x); const auto r = __builtin_amdgcn_permlane32_swap(u, u, false, false); return fmaxf(__uint_as_float(r[0]), __uint_as_float(r[1])); }
DI float half_swap_sum(float x) { const unsigned u = __float_as_uint(x); const auto r = __builtin_amdgcn_permlane32_swap(u, u, false, false); return __uint_as_float(r[0]) + __uint_as_float(r[1]); }
#define MFMA32(a, b, c) __builtin_amdgcn_mfma_f32_32x32x16_bf16((a), (b), (c), 0, 0, 0)
template <int DQK, int MODE>
DI void attn_phase(const bf16_t* __restrict__ QK, int ldq, const bf16_t* __restrict__ Vt, int VC, bf16_t* __restrict__ O, int ldo, int nhu, bool skip_ctx, const float* __restrict__ qgain, const f32x2* __restrict__ rope, float qscale, char* shm) {
    OPAQUE_IDS
    constexpr int KS = DQK * 2 + 16, VS = 144, KCH = DQK / 8, NKC = 64 * KCH / NTHR;
    constexpr int BUFB = 64 * KS + 128 * VS;
    char* Kl = shm; char* Vl = shm + 64 * KS;
    const int tid = tx, w = tid >> 6, lane = tid & 63, r = lane & 31, h = lane >> 5;
    const int nlat = NB * nhu * 8, nunits = nlat + (skip_ctx ? 0 : NB * nhu);
    for (int u = bx; u < nunits; u += gridDim.x) {
        int qt, hu, b;
        if (u < nlat) { qt = 1 + (u & 7); hu = (u >> 3) % nhu; b = (u >> 3) / nhu; } else { const int v = u - nlat; qt = 0; hu = v % nhu; b = v / nhu; }
        const int qoff = hu * DQK, koff = 1024 + (MODE == 0 ? hu * 64 : (hu >> 2) * 128), voff = (MODE == 0 ? (hu >> 1) : (hu >> 2)) * 128, ooff = hu * 128;
        const int nkt = qt == 0 ? 4 : 36;
        const size_t qrow = (size_t)b * LT + qt * 256 + w * 32 + r;
        bf16x8 qf[DQK / 16];
#pragma unroll
        for (int ks = 0; ks < DQK / 16; ++ks) qf[ks] = *(const bf16x8*)(QK + qrow * ldq + qoff + ks * 16 + h * 8);
        {
            float ss = 0.f;
#pragma unroll
            for (int ks = 0; ks < DQK / 16; ++ks) { const u32x4 wq = __builtin_bit_cast(u32x4, qf[ks]);
                const float a0 = bflo(wq.x), a1 = bfhi(wq.x), a2 = bflo(wq.y), a3 = bfhi(wq.y), a4 = bflo(wq.z), a5 = bfhi(wq.z), a6 = bflo(wq.w), a7 = bfhi(wq.w);
                ss += a0 * a0 + a1 * a1 + a2 * a2 + a3 * a3 + a4 * a4 + a5 * a5 + a6 * a6 + a7 * a7; }
            ss += __shfl_xor(ss, 32);
            const float rr = rsqrtf(ss * (1.f / DQK) + EPS) * qscale; int go = (MODE == 0 ? (hu & 1) * 64 : 0) + h * 8; asm volatile("" : "+v"(go));
            const float* gq = qgain + go; const f32x2* rp = rope + (size_t)((qt > 0 ? qt - 1 : 0) * 256 + w * 32 + r) * (DQK / 2) + h * 8;
#pragma unroll
            for (int ks = 0; ks < DQK / 32; ++ks) {
                const u32x4 wa = __builtin_bit_cast(u32x4, qf[ks]), wb = __builtin_bit_cast(u32x4, qf[ks + DQK / 32]);
                float xa[8] = {bflo(wa.x), bfhi(wa.x), bflo(wa.y), bfhi(wa.y), bflo(wa.z), bfhi(wa.z), bflo(wa.w), bfhi(wa.w)};
                float xb[8] = {bflo(wb.x), bfhi(wb.x), bflo(wb.y), bfhi(wb.y), bflo(wb.z), bfhi(wb.z), bflo(wb.w), bfhi(wb.w)};
#pragma unroll
                for (int j = 0; j < 8; ++j) { float x1 = xa[j] * rr * gq[ks * 16 + j], x2 = xb[j] * rr * gq[(ks + DQK / 32) * 16 + j];
                    if (qt > 0) { const f32x2 cs = rp[ks * 16 + j]; const float y1 = x1 * cs[0] - x2 * cs[1], y2 = x1 * cs[1] + x2 * cs[0]; x1 = y1; x2 = y2; }
                    xa[j] = x1; xb[j] = x2; }
                qf[ks] = __builtin_bit_cast(bf16x8, (u32x4){pack2(xa[0], xa[1]), pack2(xa[2], xa[3]), pack2(xa[4], xa[5]), pack2(xa[6], xa[7])});
                qf[ks + DQK / 32] = __builtin_bit_cast(bf16x8, (u32x4){pack2(xb[0], xb[1]), pack2(xb[2], xb[3]), pack2(xb[4], xb[5]), pack2(xb[6], xb[7])});
            }
        }
        f32x16 oacc[4];
#pragma unroll
        for (int t = 0; t < 4; ++t)
#pragma unroll
            for (int i = 0; i < 16; ++i) oacc[t][i] = 0.f;
        float mrun = -1e30f, lsum = 0.f;
        const bf16_t* kbase = QK + (size_t)b * LT * ldq + koff; const bf16_t* vbase = Vt + ((size_t)b * VC + voff) * LT;
        u32x4 kreg[NKC], vreg[2];
#define ATT_LOAD(kt) do { _Pragma("unroll") for (int i = 0; i < NKC; ++i) { const int c = tid + i * NTHR, key = c / KCH, part = c % KCH; \
                kreg[i] = *(const u32x4*)(kbase + (size_t)((kt) * 64 + key) * ldq + part * 8); } \
            _Pragma("unroll") for (int i = 0; i < 2; ++i) { const int c = tid + i * NTHR, dv = c >> 3, part = c & 7; \
                vreg[i] = *(const u32x4*)(vbase + (size_t)dv * LT + (kt) * 64 + part * 8); } } while (0)
        ATT_LOAD(0);
#define ATT_STORE(buf) do { char* Kw = Kl + (buf) * BUFB; char* Vw = Vl + (buf) * BUFB; \
            _Pragma("unroll") for (int i = 0; i < NKC; ++i) { const int c = tid + i * NTHR, key = c / KCH, part = c % KCH; *(u32x4*)(Kw + key * KS + part * 16) = kreg[i]; } \
            _Pragma("unroll") for (int i = 0; i < 2; ++i) { const int c = tid + i * NTHR, dv = c >> 3, part = c & 7; char* vp_ = Vw + dv * VS + (part >> 1) * 32 + (part & 1) * 8; \
                *(u32x2*)(vp_) = (u32x2){vreg[i].x, vreg[i].y}; *(u32x2*)(vp_ + 16) = (u32x2){vreg[i].z, vreg[i].w}; } } while (0)
        __syncthreads();
        ATT_STORE(0);
        __syncthreads();
        for (int kt = 0; kt < nkt; ++kt) {
            const char* Kc = Kl + (kt & 1) * BUFB; const char* Vc = Vl + (kt & 1) * BUFB;
            if (kt + 1 < nkt) ATT_LOAD(kt + 1);
            f32x16 st0, st1;
#pragma unroll
            for (int i = 0; i < 16; ++i) { st0[i] = 0.f; st1[i] = 0.f; }
#pragma unroll
            for (int ks = 0; ks < DQK / 16; ++ks) {
                const bf16x8 a0 = *(const bf16x8*)(Kc + r * KS + ks * 32 + h * 16), a1 = *(const bf16x8*)(Kc + (32 + r) * KS + ks * 32 + h * 16);
                st0 = MFMA32(a0, qf[ks], st0); st1 = MFMA32(a1, qf[ks], st1);
            }
            float mx = st0[0];
#pragma unroll
            for (int i = 0; i < 16; ++i) mx = __builtin_fmaxf(__builtin_fmaxf(mx, st0[i]), st1[i]);
            mx = half_swap_max(mx);
            if (__any(mx > mrun + 8.f)) {
                const float mnew = fmaxf(mrun, mx), alpha = __builtin_amdgcn_exp2f(mrun - mnew); mrun = mnew; lsum *= alpha;
#pragma unroll
                for (int t = 0; t < 4; ++t)
#pragma unroll
                    for (int i = 0; i < 16; ++i) oacc[t][i] *= alpha;
            }
            { const f32x2 m2 = (f32x2){mrun, mrun}; f32x2 ps2 = (f32x2){0.f, 0.f};
#pragma unroll
              for (int i = 0; i < 16; i += 2) {
                  f32x2 a = (f32x2){st0[i], st0[i + 1]} - m2, c = (f32x2){st1[i], st1[i + 1]} - m2;
                  a[0] = __builtin_amdgcn_exp2f(a[0]); a[1] = __builtin_amdgcn_exp2f(a[1]); c[0] = __builtin_amdgcn_exp2f(c[0]); c[1] = __builtin_amdgcn_exp2f(c[1]);
                  ps2 += a; ps2 += c; st0[i] = a[0]; st0[i + 1] = a[1]; st1[i] = c[0]; st1[i + 1] = c[1]; }
              lsum += ps2[0] + ps2[1]; }
#pragma unroll
            for (int kb = 0; kb < 2; ++kb)
#pragma unroll
                for (int s = 0; s < 2; ++s) {
                    u32x4 pw;
                    if (kb == 0) { pw.x = pack2(st0[8 * s], st0[8 * s + 1]); pw.y = pack2(st0[8 * s + 2], st0[8 * s + 3]); pw.z = pack2(st0[8 * s + 4], st0[8 * s + 5]); pw.w = pack2(st0[8 * s + 6], st0[8 * s + 7]); }
                    else { pw.x = pack2(st1[8 * s], st1[8 * s + 1]); pw.y = pack2(st1[8 * s + 2], st1[8 * s + 3]); pw.z = pack2(st1[8 * s + 4], st1[8 * s + 5]); pw.w = pack2(st1[8 * s + 6], st1[8 * s + 7]); }
                    const bf16x8 pb = __builtin_bit_cast(bf16x8, pw);
#pragma unroll
                    for (int t = 0; t < 4; ++t) {
                        const bf16x8 a = *(const bf16x8*)(Vc + (32 * t + r) * VS + (kb * 2 + s) * 32 + h * 16);
                        oacc[t] = MFMA32(a, pb, oacc[t]);
                    }
                }
            if (kt + 1 < nkt) ATT_STORE((kt + 1) & 1);
            __syncthreads();
        }
#undef ATT_STORE
#undef ATT_LOAD
        const float l = half_swap_sum(lsum), inv = 1.f / l;
        bf16_t* op = O + qrow * ldo + ooff;
#pragma unroll
        for (int t = 0; t < 4; ++t)
#pragma unroll
            for (int g = 0; g < 4; g += 2) {
                const unsigned ax = pack2(oacc[t][4 * g] * inv, oacc[t][4 * g + 1] * inv), ay = pack2(oacc[t][4 * g + 2] * inv, oacc[t][4 * g + 3] * inv);
                const unsigned bx_ = pack2(oacc[t][4 * g + 4] * inv, oacc[t][4 * g + 5] * inv), by_ = pack2(oacc[t][4 * g + 6] * inv, oacc[t][4 * g + 7] * inv);
                const auto sx = __builtin_amdgcn_permlane32_swap(ax, bx_, false, false); const auto sy = __builtin_amdgcn_permlane32_swap(ay, by_, false, false);
                *(u32x4*)(op + 32 * t + 8 * (g + h)) = (u32x4){sx[0], sy[0], sx[1], sy[1]}; }
    }
    __syncthreads();
}

template <int MODE>
DI void headnorm_phase(const Params& p, const bf16_t* __restrict__ A0, const bf16_t* __restrict__ A1, const bf16_t* __restrict__ G, const float* gain, float lam, float outscale) {
    OPAQUE_IDS
    const int lane = tx & 63, gw = bx * 8 + (tx >> 6), nw = gridDim.x * 8;
    bf16_t* H = (bf16_t*)(p.ws + WS_H); const int hh = lane >> 3, d0 = (lane & 7) * 16;
    for (int row = gw; row < T; row += nw) {
        float x[16];
#pragma unroll
        for (int c = 0; c < 2; ++c) {
            u32x4 a, b2;
            if (MODE == 0) { a = *(const u32x4*)(A0 + (size_t)row * 2048 + hh * 256 + d0 + c * 8); b2 = *(const u32x4*)(A0 + (size_t)row * 2048 + hh * 256 + 128 + d0 + c * 8); }
            else { a = *(const u32x4*)(A0 + (size_t)row * D + hh * 128 + d0 + c * 8); b2 = *(const u32x4*)(A1 + (size_t)row * D + hh * 128 + d0 + c * 8); }
            const float s = MODE == 0 ? -lam : 1.f;
            x[c * 8 + 0] = bflo(a.x) + s * bflo(b2.x); x[c * 8 + 1] = bfhi(a.x) + s * bfhi(b2.x); x[c * 8 + 2] = bflo(a.y) + s * bflo(b2.y); x[c * 8 + 3] = bfhi(a.y) + s * bfhi(b2.y);
            x[c * 8 + 4] = bflo(a.z) + s * bflo(b2.z); x[c * 8 + 5] = bfhi(a.z) + s * bfhi(b2.z); x[c * 8 + 6] = bflo(a.w) + s * bflo(b2.w); x[c * 8 + 7] = bfhi(a.w) + s * bfhi(b2.w);
        }
        float ss = 0.f;
#pragma unroll
        for (int e = 0; e < 16; ++e) ss += x[e] * x[e];
        ss += __shfl_xor(ss, 1); ss += __shfl_xor(ss, 2); ss += __shfl_xor(ss, 4);
        const float r = rsqrtf(ss * (1.f / 128.f) + EPS) * outscale;
#pragma unroll
        for (int c = 0; c < 2; ++c) {
            float y[8];
#pragma unroll
            for (int e = 0; e < 8; ++e) y[e] = x[c * 8 + e] * r * gain[d0 + c * 8 + e];
            if (MODE == 1) { const u32x4 g = *(const u32x4*)(G + (size_t)row * D + hh * 128 + d0 + c * 8);
                y[0] *= silu_f(bflo(g.x)); y[1] *= silu_f(bfhi(g.x)); y[2] *= silu_f(bflo(g.y)); y[3] *= silu_f(bfhi(g.y));
                y[4] *= silu_f(bflo(g.z)); y[5] *= silu_f(bfhi(g.z)); y[6] *= silu_f(bflo(g.w)); y[7] *= silu_f(bfhi(g.w)); }
            u32x4 wv; wv.x = pack2(y[0], y[1]); wv.y = pack2(y[2], y[3]); wv.z = pack2(y[4], y[5]); wv.w = pack2(y[6], y[7]);
            *(u32x4*)(H + (size_t)row * D + hh * 128 + d0 + c * 8) = wv;
        }
    }
}

DI float dpp_x1(float x) { return __int_as_float(__builtin_amdgcn_update_dpp(0, __float_as_int(x), 0xB1, 0xF, 0xF, true)); }
DI float dpp_x2(float x) { return __int_as_float(__builtin_amdgcn_update_dpp(0, __float_as_int(x), 0x4E, 0xF, 0xF, true)); }
DI void hgrn_scan(const Params& p, char* shm) {
    OPAQUE_IDS
    constexpr int TCH = 32;
    const unsigned char* P = p.ws + WS_P;
    const bf16_t* Qh = (const bf16_t*)(P + P_HQ); const bf16_t* V = (const bf16_t*)(P + P_HV);
    float* fL = (float*)shm; float* qL = fL + TCH * 128; float* vL = qL + TCH * 128; float* pL = vL + TCH * 64;
    const int tid = tx, w = tid >> 6, lane = tid & 63, kg = lane & 3, vg = lane >> 2;
    for (int u = bx; u < 256; u += gridDim.x) {
        const int slice = u & 1, dir = (u >> 1) & 1, head = (u >> 2) & 7, b = u >> 5;
        const float* F = (const float*)(P + (dir ? P_HF1 : P_HF0)); bf16_t* Oo = dir ? (bf16_t*)(p.ws + WS_P + P_HOB) : (bf16_t*)(p.ws + WS_H);
        f32x2 s[4][2];
#pragma unroll
        for (int i = 0; i < 4; ++i) { s[i][0] = (f32x2){0.f, 0.f}; s[i][1] = (f32x2){0.f, 0.f}; }
        const int ltok = tid >> 5, lk4 = (tid & 31) * 4, vtok = tid >> 4, lv4 = (tid & 15) * 4;
        f32x4 fr[2]; u32x2 qr[2]; u32x2 vr;
#define HG_ROW(tau) ((size_t)b * LT + (dir == 0 ? (tau) : ((tau) < LC ? (LC - 1 - (tau)) : (LT + LC - 1 - (tau)))))
#define HG_LOAD(ch) do { _Pragma("unroll") for (int i_ = 0; i_ < 2; ++i_) { const size_t row = HG_ROW((ch) * TCH + ltok + 16 * i_); fr[i_] = *(const f32x4*)(F + row * D + head * 128 + lk4); \
            qr[i_] = *(const u32x2*)(Qh + row * D + head * 128 + lk4); } \
            { const size_t row = HG_ROW((ch) * TCH + vtok); vr = *(const u32x2*)(V + row * D + head * 128 + slice * 64 + lv4); } } while (0)
        HG_LOAD(0);
        for (int ch = 0; ch < LT / TCH; ++ch) {
            __syncthreads();
#pragma unroll
            for (int i_ = 0; i_ < 2; ++i_) { *(f32x4*)(fL + (ltok + 16 * i_) * 128 + lk4) = fr[i_];
                *(f32x4*)(qL + (ltok + 16 * i_) * 128 + lk4) = (f32x4){bflo(qr[i_].x), bfhi(qr[i_].x), bflo(qr[i_].y), bfhi(qr[i_].y)}; }
            *(f32x4*)(vL + vtok * 64 + lv4) = (f32x4){bflo(vr.x), bfhi(vr.x), bflo(vr.y), bfhi(vr.y)};
            __syncthreads();
            if (ch + 1 < LT / TCH) HG_LOAD(ch + 1);
#pragma unroll 4
            for (int tok = 0; tok < TCH; ++tok) {
                const f32x4 f4 = *(const f32x4*)(fL + tok * 128 + w * 16 + kg * 4), q4 = *(const f32x4*)(qL + tok * 128 + w * 16 + kg * 4), v4 = *(const f32x4*)(vL + tok * 64 + vg * 4);
                const f32x2 va = (f32x2){v4[0], v4[1]}, vb = (f32x2){v4[2], v4[3]}; f32x2 oa = (f32x2){0.f, 0.f}, ob = (f32x2){0.f, 0.f};
#pragma unroll
                for (int ki = 0; ki < 4; ++ki) { const f32x2 f2 = (f32x2){f4[ki], f4[ki]}, q2 = (f32x2){q4[ki], q4[ki]};
                    f32x2 d = s[ki][0] - va; s[ki][0] = f2 * d + va; oa += s[ki][0] * q2;
                    d = s[ki][1] - vb; s[ki][1] = f2 * d + vb; ob += s[ki][1] * q2; }
                f32x4 o4 = (f32x4){oa[0], oa[1], ob[0], ob[1]};
#pragma unroll
                for (int e = 0; e < 4; ++e) { o4[e] += dpp_x1(o4[e]); o4[e] += dpp_x2(o4[e]); }
                if (kg == 0) *(f32x4*)(pL + (w * TCH + tok) * 64 + vg * 4) = o4;
            }
            __syncthreads();
            { f32x4 a = (f32x4){0.f, 0.f, 0.f, 0.f};
#pragma unroll
              for (int ww = 0; ww < 8; ++ww) a += *(const f32x4*)(pL + (ww * TCH + vtok) * 64 + lv4);
              const size_t row = HG_ROW(ch * TCH + vtok); *(u32x2*)(Oo + row * D + head * 128 + slice * 64 + lv4) = (u32x2){pack2(a[0], a[1]), pack2(a[2], a[3])}; }
        }
#undef HG_LOAD
#undef HG_ROW
    }
    __syncthreads();
}

#define HG_ROW(b, dir, tau) ((size_t)(b) * LT + ((dir) == 0 ? (tau) : ((tau) < LC ? (LC - 1 - (tau)) : (LT + LC - 1 - (tau)))))
#define HG_MINROW(b, dir, c) ((dir) == 0 ? HG_ROW(b, 0, (c) * 16) : HG_ROW(b, 1, (c) * 16 + 15))
DI void hgrn_prep(const Params& p) {
    OPAQUE_IDS
    unsigned char* P = p.ws + WS_P; const bf16_t* Qh = (const bf16_t*)(P + P_HQ); float* EB = (float*)(p.ws + WS_EB);
    const int col2 = tx * 2;
    for (int it = bx; it < 2 * NB * 144; it += gridDim.x) {
        const int dir = it & 1, rem = it >> 1, c = rem % 144, b = rem / 144;
        float* F = (float*)(P + (dir ? P_HF1 : P_HF0));
        f32x2 f2[16]; unsigned q2[16];
#pragma unroll
        for (int t = 0; t < 16; ++t) { const size_t row = HG_ROW(b, dir, c * 16 + t); f2[t] = *(const f32x2*)(F + row * D + col2); q2[t] = *(const unsigned*)(Qh + row * D + col2); }
        unsigned qt[16], k0[8], k1[8]; float run0 = 0.f, run1 = 0.f, ka = 0.f, kb = 0.f;
#pragma unroll
        for (int t = 0; t < 16; ++t) {
            run0 += __logf(f2[t][0]); run1 += __logf(f2[t][1]);
            qt[t] = pack2(bflo(q2[t]) * __expf(run0), bfhi(q2[t]) * __expf(run1));
            const float a = (1.f - f2[t][0]) * __expf(fminf(-run0, 80.f)), bq = (1.f - f2[t][1]) * __expf(fminf(-run1, 80.f));
            if (t & 1) { k0[t >> 1] = pack2(ka, a); k1[t >> 1] = pack2(kb, bq); } else { ka = a; kb = bq; }
        }
        __syncthreads();
        unsigned char* base = (unsigned char*)F + HG_MINROW(b, dir, c) * 4096;
#pragma unroll
        for (int t = 0; t < 16; ++t) *(unsigned*)(base + t * 2048 + col2 * 2) = qt[t];
        *(u32x4*)(base + 32768 + col2 * 32) = (u32x4){k0[0], k0[1], k0[2], k0[3]}; *(u32x4*)(base + 32768 + col2 * 32 + 16) = (u32x4){k0[4], k0[5], k0[6], k0[7]};
        *(u32x4*)(base + 32768 + col2 * 32 + 32) = (u32x4){k1[0], k1[1], k1[2], k1[3]}; *(u32x4*)(base + 32768 + col2 * 32 + 48) = (u32x4){k1[4], k1[5], k1[6], k1[7]};
        *(f32x2*)(EB + ((size_t)(dir * NB + b) * 144 + c) * D + col2) = (f32x2){__expf(run0), __expf(run1)};
        __syncthreads();
    }
}
DI void hgrn_scan_mfma(const Params& p, char* shm) {
    OPAQUE_IDS
    constexpr int C = 32, QS = 272;
    const unsigned char* P = p.ws + WS_P;
    const bf16_t* V = (const bf16_t*)(P + P_HV); const float* EB = (const float*)(p.ws + WS_EB); const bf16_t* Qh = (const bf16_t*)(P + P_HQ);
    char* QtL = shm;
    char* VL = QtL + C * QS;
    char* KtL = VL + C * QS;
    float* eBL = (float*)(KtL + C * QS);
    const int tid = tx, w = tid >> 6, lane = tid & 63, l15 = lane & 15, g = lane >> 4;
    for (int u = bx; u < 128; u += gridDim.x) {
        const int dir = u & 1, head = (u >> 1) & 7, b = u >> 4;
        const unsigned char* Fb = P + (dir ? P_HF1 : P_HF0); bf16_t* Oo = dir ? (bf16_t*)(p.ws + WS_P + P_HOB) : (bf16_t*)(p.ws + WS_H);
        f32x4 S[8];
#pragma unroll
        for (int kt = 0; kt < 8; ++kt) S[kt] = (f32x4){0.f, 0.f, 0.f, 0.f};
        const int lt = tid >> 4, lp = tid & 15;
        u32x4 ra0, ra1, ra2, ra3, ra4, rb0, rb1, rb2, rb3, rb4;
#define HG_LOAD(ch, r0, r1, r2, r3, r4) do { const size_t row_ = HG_ROW(b, dir, (ch) * C + lt); const unsigned char* fr_ = Fb + row_ * 4096; \
            r0 = *(const u32x4*)(Qh + row_ * D + head * 128 + lp * 8); r1 = *(const u32x4*)(fr_ + (head * 128 + lp * 8) * 2); r2 = *(const u32x4*)(V + row_ * D + head * 128 + lp * 8); \
            r3 = *(const u32x4*)(fr_ + (1024 + head * 128 + lp * 8) * 2); \
            if (tid < 32) r4 = *(const u32x4*)(EB + ((size_t)(dir * NB + b) * 72 + (ch)) * D + head * 128 + tid * 4); } while (0)
#define HG_QE(qw, ew) pack2(bflo(qw) * bflo(ew), bfhi(qw) * bfhi(ew))
#define HG_STAGE(ch, r0, r1, r2, r3, r4) do { __syncthreads(); \
            *(u32x4*)(QtL + lt * QS + lp * 16) = (u32x4){HG_QE(r0.x, r1.x), HG_QE(r0.y, r1.y), HG_QE(r0.z, r1.z), HG_QE(r0.w, r1.w)}; *(u32x4*)(VL + lt * QS + lp * 16) = r2; \
            *(u32x4*)(KtL + lt * QS + lp * 16) = r3; if (tid < 32) *(u32x4*)((char*)eBL + tid * 16) = r4; \
            __syncthreads(); \
            if ((ch) + 2 < LT / C) HG_LOAD((ch) + 2, r0, r1, r2, r3, r4); } while (0)
        HG_LOAD(0, ra0, ra1, ra2, ra3, ra4); HG_LOAD(1, rb0, rb1, rb2, rb3, rb4);
        for (int ch2 = 0; ch2 < LT / C; ch2 += 2) {
#pragma unroll
          for (int hh = 0; hh < 2; ++hh) {
            const int ch = ch2 + hh;
            if (hh == 0) HG_STAGE(ch, ra0, ra1, ra2, ra3, ra4); else HG_STAGE(ch, rb0, rb1, rb2, rb3, rb4);
            { const bf16_t* kt16 = (const bf16_t*)KtL; const bf16_t* v16 = (const bf16_t*)VL; const int vcol = w * 16 + l15;
#define HG_U2(arr, r_a, r_b, c_) ((unsigned)(arr)[(r_a) * (QS / 2) + (c_)] | ((unsigned)(arr)[(r_b) * (QS / 2) + (c_)] << 16))
              const bf16x8 vf = __builtin_bit_cast(bf16x8, (u32x4){HG_U2(v16, g * 4 + 0, g * 4 + 1, vcol), HG_U2(v16, g * 4 + 2, g * 4 + 3, vcol), HG_U2(v16, 16 + g * 4 + 0, 16 + g * 4 + 1, vcol), HG_U2(v16, 16 + g * 4 + 2, 16 + g * 4 + 3, vcol)});
              f32x4 sc00 = (f32x4){0.f, 0.f, 0.f, 0.f}, sc01 = sc00, sc11 = sc00, o0 = sc00, o1 = sc00;
#pragma unroll
              for (int kc = 0; kc < 4; ++kc) {
                  const bf16x8 aK0 = *(const bf16x8*)(KtL + l15 * QS + kc * 64 + g * 16), aK1 = *(const bf16x8*)(KtL + (16 + l15) * QS + kc * 64 + g * 16);
                  const bf16x8 bQ0 = *(const bf16x8*)(QtL + l15 * QS + kc * 64 + g * 16), bQ1 = *(const bf16x8*)(QtL + (16 + l15) * QS + kc * 64 + g * 16);
                  sc00 = __builtin_amdgcn_mfma_f32_16x16x32_bf16(aK0, bQ0, sc00, 0, 0, 0);
                  sc01 = __builtin_amdgcn_mfma_f32_16x16x32_bf16(aK0, bQ1, sc01, 0, 0, 0);
                  sc11 = __builtin_amdgcn_mfma_f32_16x16x32_bf16(aK1, bQ1, sc11, 0, 0, 0);
                  const int kp = kc;
                  const u32x2 qa0 = *(const u32x2*)(QtL + l15 * QS + ((2 * kp) * 16 + g * 4) * 2), qb0 = *(const u32x2*)(QtL + l15 * QS + ((2 * kp + 1) * 16 + g * 4) * 2);
                  const u32x2 qa1 = *(const u32x2*)(QtL + (16 + l15) * QS + ((2 * kp) * 16 + g * 4) * 2), qb1 = *(const u32x2*)(QtL + (16 + l15) * QS + ((2 * kp + 1) * 16 + g * 4) * 2);
                  const bf16x8 sw = __builtin_bit_cast(bf16x8, (u32x4){pack2(S[2 * kp][0], S[2 * kp][1]), pack2(S[2 * kp][2], S[2 * kp][3]), pack2(S[2 * kp + 1][0], S[2 * kp + 1][1]), pack2(S[2 * kp + 1][2], S[2 * kp + 1][3])});
                  o0 = __builtin_amdgcn_mfma_f32_16x16x32_bf16(__builtin_bit_cast(bf16x8, (u32x4){qa0.x, qa0.y, qb0.x, qb0.y}), sw, o0, 0, 0, 0);
                  o1 = __builtin_amdgcn_mfma_f32_16x16x32_bf16(__builtin_bit_cast(bf16x8, (u32x4){qa1.x, qa1.y, qb1.x, qb1.y}), sw, o1, 0, 0, 0); }
#pragma unroll
              for (int r = 0; r < 4; ++r) if (g * 4 + r > l15) { sc00[r] = 0.f; sc11[r] = 0.f; }
              o0 = __builtin_amdgcn_mfma_f32_16x16x32_bf16(__builtin_bit_cast(bf16x8, (u32x4){pack2(sc00[0], sc00[1]), pack2(sc00[2], sc00[3]), 0u, 0u}), vf, o0, 0, 0, 0);
              o1 = __builtin_amdgcn_mfma_f32_16x16x32_bf16(__builtin_bit_cast(bf16x8, (u32x4){pack2(sc01[0], sc01[1]), pack2(sc01[2], sc01[3]), pack2(sc11[0], sc11[1]), pack2(sc11[2], sc11[3])}), vf, o1, 0, 0, 0);
#pragma unroll
              for (int r = 0; r < 4; ++r) { const size_t rw0 = HG_ROW(b, dir, ch * C + g * 4 + r), rw1 = HG_ROW(b, dir, ch * C + 16 + g * 4 + r);
                  Oo[rw0 * D + head * 128 + vcol] = (bf16_t)(pack2(o0[r], 0.f) & 0xffffu); Oo[rw1 * D + head * 128 + vcol] = (bf16_t)(pack2(o1[r], 0.f) & 0xffffu); }
#pragma unroll
              for (int kt = 0; kt < 8; ++kt) { const f32x4 dcy = *(const f32x4*)(eBL + kt * 16 + g * 4); const int kcol = kt * 16 + l15;
                  const bf16x8 kl = __builtin_bit_cast(bf16x8, (u32x4){HG_U2(kt16, g * 4 + 0, g * 4 + 1, kcol), HG_U2(kt16, g * 4 + 2, g * 4 + 3, kcol), HG_U2(kt16, 16 + g * 4 + 0, 16 + g * 4 + 1, kcol), HG_U2(kt16, 16 + g * 4 + 2, 16 + g * 4 + 3, kcol)});
                  S[kt] = __builtin_amdgcn_mfma_f32_16x16x32_bf16(kl, vf, S[kt], 0, 0, 0) * dcy; }
#undef HG_U2
            }
          }
        }
#undef HG_STAGE
#undef HG_QE
#undef HG_LOAD
    }
    __syncthreads();
}

#define XB_TMO      128
#define XB_XCNT(j)  (256  + 64 * (j))
#define XB_XSUB(j)  (1280 + 64 * (j))
#define XB_XGEN(j)  (2304 + 64 * (j))
#define XB_TOP      3328
#define XB_TOPGEN   3392
#define XCD_BAR_WORDS 3456
#define XB_SPIN_CAP (1u << 22)
DI unsigned xb_ld(unsigned* p)              { return __hip_atomic_load(p, __ATOMIC_RELAXED, __HIP_MEMORY_SCOPE_AGENT); }
DI unsigned xb_add(unsigned* p, unsigned v) { return __hip_atomic_fetch_add(p, v, __ATOMIC_RELAXED, __HIP_MEMORY_SCOPE_AGENT); }
DI unsigned xb_xcc_id() { return (unsigned)__builtin_amdgcn_s_getreg((3 << 11) | 20) & 0xFu; }
#define XB_SPIN(cond, bar) do { unsigned _sp = 0; while (cond) { __builtin_amdgcn_s_sleep(1); \
    if ((++_sp & 255u) == 0u) { if (xb_ld(&(bar)[XB_TMO])) break; if (_sp > XB_SPIN_CAP) { atomicAdd(&(bar)[XB_TMO], 1u); break; } } } } while (0)
struct XcdBarrier { unsigned* bar; unsigned x; volatile LAS unsigned* st; };
DI XcdBarrier xcd_barrier_post(unsigned* bar, volatile LAS unsigned* st) {
    XcdBarrier b; b.bar = bar; b.x = xb_xcc_id(); b.st = st;
    if (threadIdx.x == 0) (void)xb_add(&bar[XB_XCNT(b.x)], 1u);
    return b;
}
DI void xcd_barrier_complete(unsigned* bar, unsigned x, unsigned& nloc, unsigned& nx) {
    const unsigned G = gridDim.x * gridDim.y * gridDim.z;
    unsigned sum, cnt, mine, sp = 0u;
    for (;;) {
        sum = 0u; cnt = 0u; mine = 0u;
#pragma unroll
        for (unsigned j = 0; j < 16; ++j) { const unsigned c = xb_ld(&bar[XB_XCNT(j)]); sum += c; cnt += (c > 0u) ? 1u : 0u; mine = (j == x) ? c : mine; }
        if (sum == G) break;
        __builtin_amdgcn_s_sleep(1);
        if ((++sp & 255u) == 0u) { if (xb_ld(&bar[XB_TMO])) break; if (sp > XB_SPIN_CAP) { atomicAdd(&bar[XB_TMO], 1u); break; } }
    }
    nloc = mine > 0u ? mine : 1u; nx = cnt > 0u ? cnt : 1u;
}
DI void xcd_barrier(const XcdBarrier& b) {
    asm volatile("s_waitcnt vmcnt(0)" ::: "memory");
    __syncthreads();
    if (threadIdx.x == 0) {
        unsigned* bar = b.bar;
        __builtin_amdgcn_s_waitcnt(0);
        unsigned nloc = b.st[0], nx = b.st[1];
        if (nloc == 0u) { xcd_barrier_complete(bar, b.x, nloc, nx); b.st[0] = nloc; b.st[1] = nx; }
        const unsigned old = xb_add(&bar[XB_XSUB(b.x)], 1u);
        const unsigned gen = old / nloc;
        if (old + 1u == (gen + 1u) * nloc) {
            __builtin_amdgcn_fence(__ATOMIC_RELEASE, "agent");
            asm volatile("s_waitcnt vmcnt(0)" ::: "memory");
            const unsigned og = xb_add(&bar[XB_TOP], 1u);
            const unsigned tg = og / nx;
            if (og + 1u == (tg + 1u) * nx) xb_add(&bar[XB_TOPGEN], 1u);
            else XB_SPIN(xb_ld(&bar[XB_TOPGEN]) == tg, bar);
            __builtin_amdgcn_fence(__ATOMIC_ACQUIRE, "agent");
            xb_add(&bar[XB_XGEN(b.x)], 1u);
            asm volatile("s_waitcnt vmcnt(0)" ::: "memory");
        } else {
            XB_SPIN(xb_ld(&bar[XB_XGEN(b.x)]) == gen, bar);
            __builtin_amdgcn_fence(__ATOMIC_ACQUIRE, "agent");
            asm volatile("s_waitcnt vmcnt(0)" ::: "memory");
        }
    }
    __syncthreads();
}

template <int layer>
DI void layer_body(const Params& p, const XcdBarrier& xb, char* shm) {
    unsigned char* P = p.ws + WS_P;
    bf16_t* H = (bf16_t*)(p.ws + WS_H);
    bf16_t* wfi = (bf16_t*)(p.ws + WS_WFI); bf16_t* wfo = (bf16_t*)(p.ws + WS_WFO); bf16_t* wmi = (bf16_t*)(p.ws + WS_WMI); bf16_t* wmo = (bf16_t*)(p.ws + WS_WMO);
    const float* modall = (const float*)(p.ws + WS_MOD);
    float* ctxres = (float*)(p.ws + WS_CTXRES);
    (void)wmi; (void)H;
        const float* mod = modall + (size_t)layer * 9 * 6144;
        const bool last = layer == 3;
        PH(0) if (layer > 0) convert_layer(p, layer, shm);
        PH(1) norm_phase(p, layer, 0, false, layer > 0 ? (const float*)(P + P_PARTF) : nullptr, 8, layer == 0 ? 1 : 0);
        xcd_barrier(xb);
        if constexpr (layer == 0) {
            { const bf16_t* cdt = (const bf16_t*)(P + P_CDT); bf16_t* gtl = (bf16_t*)(P + P_GTL); bf16_t* gtc = (bf16_t*)(P + P_GTC);
              gemm_loop(NB * 72, 1024, shm,
                  [&](int L) { const int b = L / 72, r2 = L % 72, pm = r2 / 9, pn = r2 % 9, k0 = (pm & 3) * 256; return Tile{cdt + k0, H + (size_t)b * LT * D + k0, 1024, D, 256, pm * 256, pn * 256}; },
                  [&](int L, const AccT& acc, int brow, int bcol, int wr, int wc, int fr, int fq) { EpiFnet1 e{gtl, gtc, L / 72}; e(acc, brow, bcol, wr, wc, fr, fq); }); }
            xcd_barrier(xb);
            { const bf16_t* wl = (const bf16_t*)(P + P_WL); const bf16_t* wc = (const bf16_t*)(P + P_WC); bf16_t* Yb = (bf16_t*)(P + P_YB);
              const bf16_t* gtl = (const bf16_t*)(P + P_GTL); const bf16_t* gtc = (const bf16_t*)(P + P_GTC);
              gemm_loop(NB * 32, 4096, shm,
                  [&](int L) { const int b = L >> 5, pm = (L >> 2) & 7, pn = L & 3; return Tile{wl, gtl + (size_t)b * 1024 * 4096, 4096, 4096, 4096, pm * 256, pn * 256}; },
                  [&](int L, const AccT& acc, int brow, int bcol, int wr, int wc_, int fr, int fq) { EpiBf16 e{Yb + ((size_t)(L >> 5) * LT + LC) * D, (size_t)D}; e(acc, brow, bcol, wr, wc_, fr, fq); });
              gemm_loop(NB * 4, 512, shm,
                  [&](int L) { const int b = L >> 2, pn = L & 3; return Tile{wc, gtc + (size_t)b * 1024 * 512, 512, 512, 512, 0, pn * 256}; },
                  [&](int L, const AccT& acc, int brow, int bcol, int wr, int wc_, int fr, int fq) { EpiBf16 e{Yb + ((size_t)(L >> 2) * LT) * D, (size_t)D}; e(acc, brow, bcol, wr, wc_, fr, fq); }); }
            xcd_barrier(xb);
            gemm_resid<4>((const bf16_t*)(P + P_YB), wmo, D, true, p.out, p.in[0], mod + 2 * 1024, p.in[10], (float*)(P + P_PARTO), shm);
        } else if constexpr (layer == 1) {
            { bf16_t* QK = (bf16_t*)(P + P_DQK); bf16_t* Vt = (bf16_t*)(P + P_DVT); const int n1 = 72 * 8, n2 = NB * 4 * 9;
              gemm_loop(n1 + n2, D, shm,
                  [&](int L) { if (L < n1) { int pm, pn; tile_map(L, 72, 8, pm, pn); return Tile{H, wmi, D, D, D, pm * 256, pn * 256}; }
                               const int v = L - n1, b = v / 36, r2 = v % 36, pm = r2 / 9, pn = r2 % 9; return Tile{wmi + (size_t)2048 * D, H + (size_t)b * LT * D, D, D, D, pm * 256, pn * 256}; },
                  [&](int L, const AccT& acc, int brow, int bcol, int wr, int wc, int fr, int fq) {
                      if (L < n1) { EpiBf16 e{QK, (size_t)2048}; e(acc, brow, bcol, wr, wc, fr, fq); }
                      else { EpiBf16 e{Vt + (size_t)((L - n1) / 36) * 1024 * LT, (size_t)LT}; e(acc, brow, bcol, wr, wc, fr, fq); } }); }
            xcd_barrier(xb);
            PH(2) qknorm_phase<32>((bf16_t*)(P + P_DQK), 2048, p.in[13], 2, (const f32x2*)(p.ws + WS_ROPED));
            xcd_barrier(xb);
            PH(4) attn_phase<64, 0>((const bf16_t*)(P + P_DQK), 2048, (const bf16_t*)(P + P_DVT), 1024, (bf16_t*)(P + P_DO2), 2048, 16, false, p.in[12], (const f32x2*)(p.ws + WS_ROPED), 0.125f * 1.4426950408889634f, shm);
            xcd_barrier(xb);
            { const float* lp = p.in[14]; float s01 = 0.f, s23 = 0.f;
              for (int e = 0; e < 64; ++e) { s01 += lp[e] * lp[64 + e]; s23 += lp[128 + e] * lp[192 + e]; }
              const float lam_init = 0.8f - 0.6f * expf(-0.3f * 1.f); const float lam = expf(s01) - expf(s23) + lam_init;
              PH(1) headnorm_phase<0>(p, (const bf16_t*)(P + P_DO2), nullptr, nullptr, p.in[15], lam, 1.f - lam_init); }
            xcd_barrier(xb);
            gemm_resid<4>(H, wmo, D, true, p.out, p.out, mod + 2 * 1024, nullptr, (float*)(P + P_PARTO), shm);
        } else if constexpr (layer == 2) {
            { EpiHgrn e{P, (const float*)(p.ws + WS_LBV), p.ws + WS_EB}; gemm_phase(H, D, wmi, D, 5 * D, D, false, shm, e); }
            xcd_barrier(xb);
            PH(6) hgrn_scan_mfma(p, shm);
            xcd_barrier(xb);
            PH(1) headnorm_phase<1>(p, H, (const bf16_t*)(P + P_HOB), (const bf16_t*)(P + P_HG), p.in[19], 0.f, 1.f);
            xcd_barrier(xb);
            gemm_resid<4>(H, wmo, D, true, p.out, p.out, mod + 2 * 1024, nullptr, (float*)(P + P_PARTO), shm);
        } else {
            { bf16_t* QK = (bf16_t*)(P + P_GQK); bf16_t* Vt = (bf16_t*)(P + P_GVT); const int n1 = 72 * 5, n2 = NB * 9;
              gemm_loop(n1 + n2, D, shm,
                  [&](int L) { if (L < n1) { int pm, pn; tile_map(L, 72, 5, pm, pn); return Tile{H, wmi, D, D, D, pm * 256, pn * 256}; }
                               const int v = L - n1, b = v / 9, pn = v % 9; return Tile{wmi + (size_t)1280 * D, H + (size_t)b * LT * D, D, D, D, 0, pn * 256}; },
                  [&](int L, const AccT& acc, int brow, int bcol, int wr, int wc, int fr, int fq) {
                      if (L < n1) { EpiBf16 e{QK, (size_t)1280}; e(acc, brow, bcol, wr, wc, fr, fq); }
                      else { EpiBf16 e{Vt + (size_t)((L - n1) / 9) * 256 * LT, (size_t)LT}; e(acc, brow, bcol, wr, wc, fr, fq); } }); }
            xcd_barrier(xb);
            PH(3) qknorm_phase<64>((bf16_t*)(P + P_GQK), 1280, p.in[23], 0, (const f32x2*)(p.ws + WS_ROPEG));
            xcd_barrier(xb);
            PH(5) attn_phase<128, 1>((const bf16_t*)(P + P_GQK), 1280, (const bf16_t*)(P + P_GVT), 256, H, D, 8, true, p.in[22], (const f32x2*)(p.ws + WS_ROPEG), 0.08838834764831845f * 1.4426950408889634f, shm);
            xcd_barrier(xb);
            gemm_resid<4>(H, wmo, D, false, p.out, p.out, mod + 2 * 1024, nullptr, (float*)(P + P_PARTO), shm);
        }
        xcd_barrier(xb);
        PH(1) norm_phase(p, layer, 1, last, last ? nullptr : (const float*)(P + P_PARTO), 4, layer == 0 ? 2 : 0);
        xcd_barrier(xb);
        { EpiSwiglu e{(bf16_t*)(P + P_ACT)}; gemm_phase(H, D, wfi, D, 2 * DFF, D, last, shm, e); }
        xcd_barrier(xb);
        gemm_resid<8>((const bf16_t*)(P + P_ACT), wfo, DFF, !last, p.out, p.out, mod + 5 * 1024, nullptr, (float*)(P + P_PARTF), shm);
        if constexpr (layer < 3) xcd_barrier(xb);
    }

__global__ void __launch_bounds__(NTHR) fwd_megakernel(Params p) {
    extern __shared__ __attribute__((aligned(16))) char shm[];
    cg::grid_group grid = cg::this_grid();
    if (threadIdx.x < 4) ((unsigned*)(shm + 131072))[threadIdx.x] = 0u;
    __syncthreads();
    const XcdBarrier xb = xcd_barrier_post((unsigned*)(p.ws + WS_BAR), (volatile LAS unsigned*)(shm + 131072));
    PH(0) prologue(p, shm);
    if (p.ws == nullptr) grid.sync();
    xcd_barrier(xb);
    PH(0) mod_reduce(p);
    xcd_barrier(xb);
    layer_body<0>(p, xb, shm);
    layer_body<1>(p, xb, shm);
    layer_body<2>(p, xb, shm);
    layer_body<3>(p, xb, shm);
}

extern "C" void kernel_launch(void* const* d_in, const int* in_sizes, int n_in, void* d_out, int out_size, void* d_ws, size_t ws_size, hipStream_t stream) {
    static int grid_blocks = 0;
    if (grid_blocks == 0) {
        if (n_in != 25 || ws_size < WS_END) { fprintf(stderr, "kernel_launch: need 25 inputs and %zu bytes of workspace (got %d, %zu)\n", (size_t)WS_END, n_in, ws_size); grid_blocks = -1; return; }
        int dev = 0, cus = 0, per_cu = 0;
        hipGetDevice(&dev);
        hipDeviceGetAttribute(&cus, hipDeviceAttributeMultiprocessorCount, dev);
        if (hipFuncSetAttribute((const void*)fwd_megakernel, hipFuncAttributeMaxDynamicSharedMemorySize, LDS_BYTES) != hipSuccess) { fprintf(stderr, "kernel_launch: hipFuncSetAttribute failed\n"); grid_blocks = -1; return; }
        if (hipOccupancyMaxActiveBlocksPerMultiprocessor(&per_cu, (const void*)fwd_megakernel, NTHR, LDS_BYTES) != hipSuccess || per_cu < 1) { fprintf(stderr, "kernel_launch: occupancy query says %d blocks/CU\n", per_cu); grid_blocks = -1; return; }
        grid_blocks = cus;
    }
    if (grid_blocks < 0) return;
    if (hipMemsetAsync((char*)d_ws + WS_BAR, 0, 16384, stream) != hipSuccess) { fprintf(stderr, "kernel_launch: memset of barrier words failed\n"); return; }
    Params p{};
    for (int i = 0; i < 25; ++i) p.in[i] = (const float*)d_in[i];
    p.out = (float*)d_out; p.ws = (unsigned char*)d_ws;
    void* args[] = {&p};
    hipError_t e = hipLaunchCooperativeKernel((const void*)fwd_megakernel, dim3(grid_blocks), dim3(NTHR), args, LDS_BYTES, stream);
    if (e != hipSuccess) fprintf(stderr, "cooperative launch failed: %s (grid %d)\n", hipGetErrorString(e), grid_blocks);
}
```

```cpp
#include <hip/hip_runtime.h>
#include <hip/hip_cooperative_groups.h>
#include <cstdint>
#include <cstdio>
namespace cg = cooperative_groups;

#define DI __device__ __forceinline__
#ifndef PHMASK
#define PHMASK 0xFFFF
#endif
#define PH(bit) if ((PHMASK >> (bit)) & 1)
#define OPAQUE_IDS int tx = threadIdx.x; int bx = blockIdx.x; asm volatile("" : "+v"(tx), "+s"(bx));
typedef unsigned short bf16_t;
typedef short bf16x8 __attribute__((ext_vector_type(8)));
typedef short s16x4 __attribute__((ext_vector_type(4)));
typedef float f32x2 __attribute__((ext_vector_type(2)));
typedef float f32x4 __attribute__((ext_vector_type(4)));
typedef float f32x16 __attribute__((ext_vector_type(16)));
typedef unsigned u32x2 __attribute__((ext_vector_type(2)));
typedef unsigned u32x4 __attribute__((ext_vector_type(4)));

constexpr int NB = 8, LC = 256, LL = 2048, LT = 2304, T = NB * LT, D = 1024, DFF = 2816;
constexpr int NTHR = 512;
constexpr int LDS_BYTES = 131072 + 16;
constexpr float EPS = 1e-6f;

constexpr size_t al256(size_t x) { return (x + 255) & ~(size_t)255; }
constexpr size_t WS_CTXRES = 0;
constexpr size_t WS_MOD    = WS_CTXRES + (size_t)NB * LC * D * 4;
constexpr size_t WS_ROPED  = WS_MOD + (size_t)4 * 9 * 6144 * 4;
constexpr size_t WS_ROPEG  = WS_ROPED + (size_t)2048 * 32 * 8;
constexpr size_t WS_LBV    = WS_ROPEG + (size_t)2048 * 64 * 8;
constexpr size_t WS_WFI    = WS_LBV + 2 * 1024 * 4;
constexpr size_t WS_WFO    = WS_WFI + (size_t)5632 * 1024 * 2;
constexpr size_t WS_WMI    = WS_WFO + (size_t)1024 * 2816 * 2;
constexpr size_t WS_WMO    = WS_WMI + (size_t)5120 * 1024 * 2;
constexpr size_t WS_H      = WS_WMO + (size_t)1024 * 1024 * 2;
constexpr size_t WS_P      = WS_H + (size_t)T * D * 2;
constexpr size_t P_PART = 0;
constexpr size_t P_CDT  = P_PART + (size_t)16 * 4 * 9 * 6144 * 4;
constexpr size_t P_WL   = P_CDT + (size_t)2048 * 1024 * 2;
constexpr size_t P_WC   = P_WL + (size_t)2048 * 4096 * 2;
constexpr size_t P_GTL  = P_WC + (size_t)256 * 512 * 2;
constexpr size_t P_GTC  = P_GTL + (size_t)NB * 1024 * 4096 * 2;
constexpr size_t P_YB   = P_GTC + (size_t)NB * 1024 * 512 * 2;
constexpr size_t P_DQK = 0;
constexpr size_t P_DVT = P_DQK + (size_t)T * 2048 * 2;
constexpr size_t P_DO2 = P_DVT + (size_t)NB * 1024 * LT * 2;
constexpr size_t P_HQ  = 0;
constexpr size_t P_HF0 = P_HQ + (size_t)T * D * 2;
constexpr size_t P_HF1 = P_HF0 + (size_t)T * D * 4;
constexpr size_t P_HV  = P_HF1 + (size_t)T * D * 4;
constexpr size_t P_HG  = P_HV + (size_t)T * D * 2;
constexpr size_t P_HOB = P_HG + (size_t)T * D * 2;
constexpr size_t P_HEND = P_HOB + (size_t)T * D * 2;
constexpr size_t P_GQK = 0;
constexpr size_t P_GVT = P_GQK + (size_t)T * 1280 * 2;
constexpr size_t P_ACT = 0;
constexpr size_t P_PARTF = P_ACT + (size_t)T * DFF * 2;
constexpr size_t P_PARTO = 0;
constexpr size_t WS_BAR = WS_P + P_HEND;
constexpr size_t WS_EB  = WS_BAR + 16384;
constexpr size_t WS_END = WS_EB + (size_t)2 * NB * 144 * D * 4;

struct Params {
    const float* in[25];
    float* out;
    unsigned char* ws;
};

DI bf16_t f2bf(float x) { unsigned u = __float_as_uint(x); u += 0x7fffu + ((u >> 16) & 1u); return (bf16_t)(u >> 16); }
DI float bf2f(bf16_t v) { return __uint_as_float(((unsigned)v) << 16); }
typedef __bf16 bf16x2_t __attribute__((ext_vector_type(2)));
DI unsigned pack2(float lo, float hi) { const f32x2 v = (f32x2){lo, hi}; return __builtin_bit_cast(unsigned, __builtin_convertvector(v, bf16x2_t)); }
DI float bflo(unsigned w) { return __uint_as_float(w << 16); }
DI float bfhi(unsigned w) { return __uint_as_float(w & 0xffff0000u); }
DI float silu_f(float x) { return x * __builtin_amdgcn_rcpf(1.f + __expf(-x)); }
DI float sigmoid_f(float x) { return __builtin_amdgcn_rcpf(1.f + __expf(-x)); }
DI float wave_sum(float v) {
    v += __shfl_xor(v, 32); v += __shfl_xor(v, 16); v += __shfl_xor(v, 8); v += __shfl_xor(v, 4); v += __shfl_xor(v, 2); v += __shfl_xor(v, 1);
    return v;
}
DI float* resid_row(const Params& p, int row) {
    const int b = row / LT, pos = row - b * LT;
    return pos < LC ? (float*)(p.ws + WS_CTXRES) + ((size_t)(b * LC + pos)) * D : p.out + ((size_t)(b * LL + pos - LC)) * D;
}
DI int cond_idx(int row) { const int b = row / LT, pos = row - b * LT; return pos < LC ? 8 : b; }

constexpr int BM = 256, BK = 64, HALF = 128, HTB = HALF * BK * 2;
DI int lds_byte(int r, int c) { int st = (r >> 4) * 2 + (c >> 5), rr = r & 15, cc = c & 31, ob = rr * 64 + cc * 2; return st * 1024 + (ob ^ (((ob >> 9) & 1) << 5)); }
DI void stage_rc(int b, int& R, int& C) { int st = b / 1024, sb = b % 1024, swz = sb ^ (((sb >> 9) & 1) << 5); R = (st >> 1) * 16 + swz / 64; C = (st & 1) * 32 + (swz % 64) / 2; }

typedef f32x4 AccT[2][2][4][2];

struct Tile { const bf16_t* A; const bf16_t* Bt; int lda, ldb, K, brow, bcol; };
#define LAS __attribute__((address_space(3)))
template <class Get, class Epi>
DI void gemm_loop(int ntiles, int ld, char* shm, const Get& get, const Epi& epi) {
    int tx = threadIdx.x, bx = blockIdx.x; asm volatile("" : "+v"(tx), "+s"(bx));
    if (!((PHMASK >> 7) & 1)) return;
    LAS unsigned char* lds = (LAS unsigned char*)shm;
    const int tid = tx, wid = __builtin_amdgcn_readfirstlane(tid >> 6), lane = tid & 63, wr = wid >> 2, wc = wid & 3, fr = lane & 15, fq = lane >> 4;
    unsigned voffA[2], voffB[2];
#pragma unroll
    for (int i = 0; i < 2; ++i) { int R, C; stage_rc(tid * 16 + i * 8192, R, C); const int rho = R & 31, Rb = (R & ~31) + 8 * ((rho & 15) >> 2) + 4 * (rho >> 4) + (rho & 3);
        voffA[i] = (unsigned)(R * ld + C) * 2u; voffB[i] = (unsigned)(Rb * ld + C) * 2u; }
    const size_t kstep = (size_t)(BK * 2), hstep = (size_t)HALF * ld * 2;
    const unsigned ldsw = (unsigned)wid * 1024u;
    const int aoff = lds_byte(wr * 64 + fr, fq * 8), boff = lds_byte(wc * 32 + fr, fq * 8);
#define G_SA(b, h) (((b) * 2 + (h)) * HTB)
#define G_SB(b, h) ((4 + (b) * 2 + (h)) * HTB)
#define G_STAGE(bufoff, gbase, voff) do { _Pragma("unroll") for (int _i = 0; _i < 2; ++_i) \
        __builtin_amdgcn_global_load_lds((const unsigned*)((const char*)(gbase) + voff[_i]), (LAS unsigned*)(lds + (bufoff) + ldsw + _i * 8192), 16, 0, 0); } while (0)
#define G_LDA(dst, b, h) do { _Pragma("unroll") for (int m = 0; m < 4; ++m) _Pragma("unroll") for (int k = 0; k < 2; ++k) dst[m][k] = *(const LAS bf16x8*)(lds + G_SA(b, h) + aoff + m * 2048 + k * 1024); } while (0)
#define G_LDB(dst, b, h) do { _Pragma("unroll") for (int n = 0; n < 2; ++n) _Pragma("unroll") for (int k = 0; k < 2; ++k) dst[n][k] = *(const LAS bf16x8*)(lds + G_SB(b, h) + boff + n * 2048 + k * 1024); } while (0)
#define G_MMA(ai, bj, At_, Bt_) do { __builtin_amdgcn_s_setprio(1); _Pragma("unroll") for (int m = 0; m < 4; ++m) _Pragma("unroll") for (int n = 0; n < 2; ++n) _Pragma("unroll") for (int k = 0; k < 2; ++k) \
        acc[ai][bj][m][n] = __builtin_amdgcn_mfma_f32_16x16x32_bf16(Bt_[n][k], At_[m][k], acc[ai][bj][m][n], 0, 0, 0); __builtin_amdgcn_s_setprio(0); } while (0)
#define WAIT_V(n) asm volatile("s_waitcnt vmcnt(" #n ")" ::: "memory")
#define WAIT_L(n) asm volatile("s_waitcnt lgkmcnt(" #n ")" ::: "memory")
#define BAR __builtin_amdgcn_s_barrier()
#define SCHED __builtin_amdgcn_sched_barrier(0)
    int L = bx; if (L >= ntiles) return;
    Tile cur = get(L), nxt = cur;
    AccT acc;
#define G_ZERO _Pragma("unroll") for (int a = 0; a < 2; ++a) _Pragma("unroll") for (int b = 0; b < 2; ++b) _Pragma("unroll") for (int m = 0; m < 4; ++m) _Pragma("unroll") for (int n = 0; n < 2; ++n) acc[a][b][m][n] = (f32x4){0.f, 0.f, 0.f, 0.f}
    G_ZERO;
    bf16x8 At[4][2], B0[2][2], B1[2][2];
    const char* cA = (const char*)cur.A + (size_t)cur.brow * ld * 2; const char* cB = (const char*)cur.Bt + (size_t)cur.bcol * ld * 2;
    G_STAGE(G_SB(0, 0), cB, voffB); G_STAGE(G_SB(0, 1), cB + hstep, voffB); G_STAGE(G_SA(0, 0), cA, voffA); G_STAGE(G_SA(0, 1), cA + hstep, voffA);
    if (wr == 1) BAR;
    WAIT_V(2); BAR;
    G_STAGE(G_SB(1, 0), cB + kstep, voffB); G_STAGE(G_SA(1, 0), cA + kstep, voffA); G_STAGE(G_SB(1, 1), cB + hstep + kstep, voffB);
    WAIT_V(6); BAR;
    for (;;) {
        const int Ln = L + gridDim.x; const bool has_next = Ln < ntiles; if (has_next) nxt = get(Ln);
        const char* nA = has_next ? (const char*)nxt.A + (size_t)nxt.brow * ld * 2 : cA; const char* nB = has_next ? (const char*)nxt.Bt + (size_t)nxt.bcol * ld * 2 : cB;
        const int nt = cur.K / BK;
        for (int t = 0; t < nt; t += 2) {
            const bool last = (t == nt - 2);
            const char* a1 = cA + (size_t)(t + 1) * kstep;
            const char* a2 = last ? nA : cA + (size_t)(t + 2) * kstep; const char* b2 = last ? nB : cB + (size_t)(t + 2) * kstep;
            const char* a3 = a2 + kstep; const char* b3 = b2 + kstep;
            G_LDB(B0, 0, 0); G_LDB(B1, 0, 1); SCHED; G_LDA(At, 0, 0); G_STAGE(G_SA(1, 1), a1 + hstep, voffA);
            WAIT_V(8); WAIT_L(0); BAR; G_MMA(0, 0, At, B0); G_MMA(0, 1, At, B1); BAR; SCHED;
            G_LDA(At, 0, 1); G_STAGE(G_SB(0, 0), b2, voffB); G_STAGE(G_SB(0, 1), b2 + hstep, voffB); G_STAGE(G_SA(0, 0), a2, voffA);
            WAIT_V(8); WAIT_L(0); BAR; G_MMA(1, 0, At, B0); G_MMA(1, 1, At, B1); BAR; SCHED;
            G_LDB(B0, 1, 0); G_LDB(B1, 1, 1); SCHED; G_LDA(At, 1, 0); G_STAGE(G_SA(0, 1), a2 + hstep, voffA);
            WAIT_V(8); WAIT_L(0); BAR; G_MMA(0, 0, At, B0); G_MMA(0, 1, At, B1); BAR; SCHED;
            G_LDA(At, 1, 1); G_STAGE(G_SB(1, 0), b3, voffB); G_STAGE(G_SB(1, 1), b3 + hstep, voffB); G_STAGE(G_SA(1, 0), a3, voffA);
            WAIT_V(8); WAIT_L(0); BAR; G_MMA(1, 0, At, B0); G_MMA(1, 1, At, B1); BAR; SCHED;
        }
        if (wr == 0) BAR;
        { int tx2 = threadIdx.x, brow2 = cur.brow, bcol2 = cur.bcol, Lo = L; asm volatile("" : "+v"(tx2), "+s"(brow2), "+s"(bcol2), "+s"(Lo));
          const int wid2 = tx2 >> 6, lane2 = tx2 & 63; epi(Lo, acc, brow2, bcol2, wid2 >> 2, wid2 & 3, lane2 & 15, lane2 >> 4); }
        if (!has_next) break;
        G_ZERO;
        cur = nxt; cA = nA; cB = nB; L = Ln;
        if (wr == 1) BAR;
    }
    WAIT_V(0);
    BAR;
#undef G_SA
#undef G_SB
#undef G_STAGE
#undef G_LDA
#undef G_LDB
#undef G_MMA
#undef G_ZERO
}
DI void tile_map(int L, int nM, int nN, int& pm, int& pn) {
    const int nwg = nM * nN; int wgid = L;
    { const int q = nwg / 8, r = nwg % 8, xcd = wgid % 8, off = wgid / 8; wgid = (xcd < r ? xcd * (q + 1) : r * (q + 1) + (xcd - r) * q) + off; }
    const int nig = 8 * nN, gid = wgid / nig, fm = gid * 8, gsz = (nM - fm) < 8 ? (nM - fm) : 8;
    pm = fm + ((wgid % nig) % gsz); pn = (wgid % nig) / gsz;
}

#define EPI_LOOP_ROWS _Pragma("unroll") for (int ai = 0; ai < 2; ++ai) _Pragma("unroll") for (int m = 0; m < 4; ++m)
#define EPI_LOOP_BJ _Pragma("unroll") for (int bj = 0; bj < 2; ++bj)
DI u32x4 pack8(const f32x4 a, const f32x4 b) { return (u32x4){pack2(a[0], a[1]), pack2(a[2], a[3]), pack2(b[0], b[1]), pack2(b[2], b[3])}; }

struct EpiBf16 {
    bf16_t* C; size_t ldc;
    DI void operator()(const AccT& acc, int brow, int bcol, int wr, int wc, int fr, int fq) const {
        EPI_LOOP_ROWS { const size_t row = brow + ai * 128 + wr * 64 + m * 16 + fr;
            EPI_LOOP_BJ { const int col = bcol + bj * 128 + wc * 32 + fq * 8; *(u32x4*)(C + row * ldc + col) = pack8(acc[ai][bj][m][0], acc[ai][bj][m][1]); } }
    }
};
struct EpiFnet1 {
    bf16_t* GtL; bf16_t* GtC; int b;
    DI void operator()(const AccT& acc, int brow, int bcol, int wr, int wc, int fr, int fq) const {
        const int cs = brow >= 1024; const bool isctx = bcol < LC;
        EPI_LOOP_ROWS { const int ch = brow + ai * 128 + wr * 64 + m * 16 + fr - cs * 1024;
            bf16_t* dst = isctx ? GtC + ((size_t)(b * 1024 + ch)) * 512 + cs * 256 : GtL + ((size_t)(b * 1024 + ch)) * 4096 + cs * 2048 - LC;
            EPI_LOOP_BJ { const int col = bcol + bj * 128 + wc * 32 + fq * 8; *(u32x4*)(dst + col) = pack8(acc[ai][bj][m][0], acc[ai][bj][m][1]); } }
    }
};
struct EpiResid {
    float* base; const float* src; const float* gate; const float* bias; bool rmw;
    DI void operator()(const AccT& acc, int brow, int bcol, int wr, int wc, int fr, int fq) const {
        EPI_LOOP_BJ { const int col = bcol + bj * 128 + wc * 32 + fq * 8;
            const f32x4 g0 = *(const f32x4*)(gate + col), g1 = *(const f32x4*)(gate + col + 4); f32x4 b0 = (f32x4){0.f, 0.f, 0.f, 0.f}, b1 = b0; if (bias) { b0 = *(const f32x4*)(bias + col); b1 = *(const f32x4*)(bias + col + 4); }
            EPI_LOOP_ROWS { const size_t eo = (size_t)(ai * 128 + wr * 64 + m * 16 + fr) * D + col; float* q = base + eo;
                f32x4 x0 = (f32x4){0.f, 0.f, 0.f, 0.f}, x1 = x0; if (rmw) { x0 = *(const f32x4*)(src + eo); x1 = *(const f32x4*)(src + eo + 4); }
                x0 += g0 * (acc[ai][bj][m][0] + b0); x1 += g1 * (acc[ai][bj][m][1] + b1); *(f32x4*)q = x0; *(f32x4*)(q + 4) = x1; } }
    }
};
struct EpiSwiglu {
    bf16_t* ACT;
    DI void operator()(const AccT& acc, int brow, int bcol, int wr, int wc, int fr, int fq) const {
        const int col = (bcol >> 1) + wc * 32 + fq * 8;
        EPI_LOOP_ROWS { const size_t row = brow + ai * 128 + wr * 64 + m * 16 + fr; f32x4 o[2];
#pragma unroll
            for (int n = 0; n < 2; ++n) { const f32x4 g = acc[ai][0][m][n], u = acc[ai][1][m][n];
#pragma unroll
                for (int j = 0; j < 4; ++j) o[n][j] = silu_f(g[j]) * u[j]; }
            *(u32x4*)(ACT + row * DFF + col) = pack8(o[0], o[1]); }
    }
};
template <int CTRL> DI float dpp_f(float x) { return __int_as_float(__builtin_amdgcn_update_dpp(0, __float_as_int(x), CTRL, 0xF, 0xF, true)); }
struct EpiHgrn {
    unsigned char* P; const float* lbv; unsigned char* ebase;
    DI void operator()(const AccT& acc, int brow, int bcol, int wr, int wc, int fr, int fq) const {
        const int seg = bcol >> 10, cb = bcol & 1023;
        EPI_LOOP_BJ { const int col = cb + bj * 128 + wc * 32 + fq * 8;
            if (seg == 1 || seg == 2) {
                const int dir = seg - 1;
                const f32x4 lb0 = *(const f32x4*)(lbv + dir * 1024 + col), lb1 = *(const f32x4*)(lbv + dir * 1024 + col + 4);
                bf16_t* EK = (bf16_t*)(P + (dir ? P_HF1 : P_HF0)); float* EBp = (float*)(ebase);
                const int lane_ = fq * 16 + fr;
#pragma unroll
                for (int ai = 0; ai < 2; ++ai)
#pragma unroll
                for (int mp = 0; mp < 2; ++mp) {
                    const size_t row0 = brow + ai * 128 + wr * 64 + mp * 32 + fr, row1 = row0 + 16;
                    float fa[8], fb[8], xa[8], xb[8];
#pragma unroll
                    for (int j = 0; j < 4; ++j) { fa[j] = lb0[j] + (1.f - lb0[j]) * sigmoid_f(acc[ai][bj][2 * mp][0][j]); fa[4 + j] = lb1[j] + (1.f - lb1[j]) * sigmoid_f(acc[ai][bj][2 * mp][1][j]);
                                                  fb[j] = lb0[j] + (1.f - lb0[j]) * sigmoid_f(acc[ai][bj][2 * mp + 1][0][j]); fb[4 + j] = lb1[j] + (1.f - lb1[j]) * sigmoid_f(acc[ai][bj][2 * mp + 1][1][j]); }
#pragma unroll
                    for (int j = 0; j < 8; ++j) { float x = __logf(fa[j]), y = __logf(fb[j]);
                        if (dir == 0) { x += dpp_f<0x111>(x); x += dpp_f<0x112>(x); x += dpp_f<0x114>(x); x += dpp_f<0x118>(x);
                                        y += dpp_f<0x111>(y); y += dpp_f<0x112>(y); y += dpp_f<0x114>(y); y += dpp_f<0x118>(y);
                                        y += __shfl(x, (lane_ & 48) | 15); }
                        else { x += dpp_f<0x101>(x); x += dpp_f<0x102>(x); x += dpp_f<0x104>(x); x += dpp_f<0x108>(x);
                               y += dpp_f<0x101>(y); y += dpp_f<0x102>(y); y += dpp_f<0x104>(y); y += dpp_f<0x108>(y);
                               x += __shfl(y, lane_ & 48); }
                        xa[j] = x; xb[j] = y; }
                    f32x4 e0, e1, k0, k1;
#pragma unroll
                    for (int j = 0; j < 4; ++j) { e0[j] = __expf(xa[j]); e1[j] = __expf(xa[4 + j]); k0[j] = (1.f - fa[j]) * __expf(fminf(-xa[j], 80.f)); k1[j] = (1.f - fa[4 + j]) * __expf(fminf(-xa[4 + j], 80.f)); }
                    *(u32x4*)(EK + row0 * 2048 + col) = pack8(e0, e1); *(u32x4*)(EK + row0 * 2048 + 1024 + col) = pack8(k0, k1);
                    if (dir == 1 && fr == 0) { const int b_ = (int)(row0 / LT), pos = (int)(row0 - (size_t)b_ * LT); const int tau = pos < LC ? LC - 1 - pos : LT + LC - 1 - pos;
                        float* ep = EBp + ((size_t)(NB + b_) * 72 + (tau >> 5)) * D + col; *(f32x4*)ep = e0; *(f32x4*)(ep + 4) = e1; }
#pragma unroll
                    for (int j = 0; j < 4; ++j) { e0[j] = __expf(xb[j]); e1[j] = __expf(xb[4 + j]); k0[j] = (1.f - fb[j]) * __expf(fminf(-xb[j], 80.f)); k1[j] = (1.f - fb[4 + j]) * __expf(fminf(-xb[4 + j], 80.f)); }
                    *(u32x4*)(EK + row1 * 2048 + col) = pack8(e0, e1); *(u32x4*)(EK + row1 * 2048 + 1024 + col) = pack8(k0, k1);
                    if (dir == 0 && fr == 15) { const int b_ = (int)(row1 / LT), pos = (int)(row1 - (size_t)b_ * LT);
                        float* ep = EBp + ((size_t)b_ * 72 + (pos >> 5)) * D + col; *(f32x4*)ep = e0; *(f32x4*)(ep + 4) = e1; }
                }
            } else {
                bf16_t* C = (bf16_t*)(P + (seg == 0 ? P_HQ : (seg == 3 ? P_HV : P_HG)));
                EPI_LOOP_ROWS { const size_t row = brow + ai * 128 + wr * 64 + m * 16 + fr; f32x4 v0 = acc[ai][bj][m][0], v1 = acc[ai][bj][m][1];
                    if (seg == 0) {
#pragma unroll
                        for (int j = 0; j < 4; ++j) { v0[j] = silu_f(v0[j]); v1[j] = silu_f(v1[j]); } }
                    *(u32x4*)(C + row * D + col) = pack8(v0, v1); }
            } }
    }
};

template <class Epi>
DI void gemm_phase(const bf16_t* A, int lda, const bf16_t* Bt, int ldb, int N, int K, bool lat_only, char* shm, const Epi& epi) {
    const int nM = lat_only ? 64 : 72, nN = N / BM;
    gemm_loop(nM * nN, lda, shm, [&](int L) { int pm, pn; tile_map(L, nM, nN, pm, pn); if (lat_only) pm = (pm >> 3) * 9 + 1 + (pm & 7); return Tile{A, Bt, lda, ldb, K, pm * BM, pn * BM}; },
              [&](int, const AccT& acc, int brow, int bcol, int wr, int wc, int fr, int fq) { epi(acc, brow, bcol, wr, wc, fr, fq); });
}
template <int S>
DI void gemm_resid(const bf16_t* A, const bf16_t* Bt, int K, bool with_ctx, float* out, const float* xin, const float* gate, const float* bias, float* part, char* shm) {
    const int U = K / 128, ub = U / S, ur = U % S;
    gemm_loop(256 + (with_ctx ? 32 * S : 0), K, shm,
              [&](int L) { if (L < 256) { int pm, pn; tile_map(L, 64, 4, pm, pn); pm = (pm >> 3) * 9 + 1 + (pm & 7); return Tile{A, Bt, K, K, K, pm * BM, pn * BM}; }
                           const int v = L - 256, s = v % S, tt = v / S, b = tt >> 2, pn = tt & 3; const int u0 = s * ub + (s < ur ? s : ur), nu = ub + (s < ur ? 1 : 0);
                           return Tile{A + u0 * 128, Bt + u0 * 128, K, K, nu * 128, b * LT, pn * BM}; },
              [&](int L, const AccT& acc, int brow, int bcol, int wr, int wc, int fr, int fq) {
                  const int b = brow / LT; EpiResid e;
                  if (L < 256) { const size_t ro = ((size_t)(b * LL + (brow - b * LT) - LC)) * D; e.base = out + ro; e.src = xin + ro; e.gate = gate + (size_t)b * 6144; e.bias = bias; e.rmw = true; }
                  else { const int s = (L - 256) % S; e.base = part + ((size_t)s * NB * LC + b * LC) * D; e.src = e.base; e.gate = gate + (size_t)8 * 6144; e.bias = s == 0 ? bias : nullptr; e.rmw = false; }
                  e(acc, brow, bcol, wr, wc, fr, fq); });
}

struct ConvJob { const float* src; bf16_t* dst; int ldsrc, K, N, mode; };
DI void conv_jobs(const ConvJob j0, const ConvJob j1, const ConvJob j2, const ConvJob j3, char* shm) {
    OPAQUE_IDS
    float* tile = (float*)shm;
    const int tid = tx;
    const int c1 = (j0.K / 64) * (j0.N / 256), c2 = c1 + (j1.K / 64) * (j1.N / 256), c3 = c2 + (j2.K / 64) * (j2.N / 256), c4 = c3 + (j3.K / 64) * (j3.N / 256);
    for (int L = bx; L < c4; L += gridDim.x) {
        const float* __restrict__ src = j0.src; bf16_t* __restrict__ dst = j0.dst; int ldsrc = j0.ldsrc, K = j0.K, mode = j0.mode, base = 0;
        if (L >= c1) { src = j1.src; dst = j1.dst; ldsrc = j1.ldsrc; K = j1.K; mode = j1.mode; base = c1; }
        if (L >= c2) { src = j2.src; dst = j2.dst; ldsrc = j2.ldsrc; K = j2.K; mode = j2.mode; base = c2; }
        if (L >= c3) { src = j3.src; dst = j3.dst; ldsrc = j3.ldsrc; K = j3.K; mode = j3.mode; base = c3; }
        const int nk = K / 64, Ll = L - base, tk = Ll % nk, ts = Ll / nk, n0 = ts * 256;
        __syncthreads();
        f32x4 v[8];
#pragma unroll
        for (int i = 0; i < 8; ++i) { const int e = tid + i * NTHR, kk = e >> 6, n4 = (e & 63) * 4;
            const int scol = mode == 1 ? ((n4 >> 7) ? 2816 + ts * 128 + (n4 & 127) : ts * 128 + n4) : n0 + n4;
            v[i] = *(const f32x4*)(src + (size_t)(tk * 64 + kk) * ldsrc + scol); }
#pragma unroll
        for (int i = 0; i < 8; ++i) { const int e = tid + i * NTHR, kk = e >> 6, n4 = (e & 63) * 4; *(f32x4*)(tile + kk * 260 + (n4 ^ (((kk >> 3) & 7) << 3))) = v[i]; }
        __syncthreads();
#pragma unroll
        for (int i = 0; i < 4; ++i) { const int n = (tid >> 3) + 64 * i, m = tid & 7, kc = m * 8; const float* tp = tile + kc * 260 + (n ^ (m << 3)); u32x4 w;
            w.x = pack2(tp[0], tp[260]); w.y = pack2(tp[2 * 260], tp[3 * 260]); w.z = pack2(tp[4 * 260], tp[5 * 260]); w.w = pack2(tp[6 * 260], tp[7 * 260]);
            *(u32x4*)(dst + (size_t)(n0 + n) * K + tk * 64 + kc) = w; }
    }
    __syncthreads();
}
DI void convert_layer(const Params& p, int i, char* shm) {
    bf16_t* wfi = (bf16_t*)(p.ws + WS_WFI); bf16_t* wfo = (bf16_t*)(p.ws + WS_WFO); bf16_t* wmi = (bf16_t*)(p.ws + WS_WMI); bf16_t* wmo = (bf16_t*)(p.ws + WS_WMO);
    const ConvJob jf1{p.in[7] + (size_t)i * D * 2 * DFF, wfi, 2 * DFF, D, 2 * DFF, 1}, jf2{p.in[8] + (size_t)i * DFF * D, wfo, D, DFF, D, 0};
    const float* msrc = i == 1 ? p.in[11] : (i == 2 ? p.in[17] : p.in[21]); const int mN = i == 0 ? 0 : (i == 1 ? 3 * D : (i == 2 ? 5 * D : 1536));
    const float* osrc = i == 0 ? p.in[9] : (i == 1 ? p.in[16] : (i == 2 ? p.in[20] : p.in[24]));
    const ConvJob jm{msrc, wmi, mN, D, mN, 0}, jo{osrc, wmo, D, D, D, 0};
    conv_jobs(jf1, jf2, jm, jo, shm);
}

DI void prologue(const Params& p, char* shm) {
    OPAQUE_IDS
    const size_t gtid = (size_t)bx * NTHR + tx, gn = (size_t)gridDim.x * NTHR;
    { float* cond = (float*)shm;
      float* part = (float*)(p.ws + WS_P + P_PART);
      for (int it = bx; it < 4 * 16 * 12; it += gridDim.x) {
          const int cb = it % 12, ks = (it / 12) % 16, Ly = it / (12 * 16);
          __syncthreads();
          for (int e = tx; e < 9 * 64; e += NTHR) { const int ci = e >> 6, k = ks * 64 + (e & 63); const float v = ci < 8 ? p.in[1][ci * D + k] : p.in[3][k]; cond[e] = silu_f(v); }
          __syncthreads();
          const int col = cb * 512 + tx; const float* w = p.in[4] + ((size_t)Ly * D + ks * 64) * 6144 + col;
          float a[9];
#pragma unroll
          for (int c = 0; c < 9; ++c) a[c] = 0.f;
          for (int k = 0; k < 64; ++k) { const float wv = w[(size_t)k * 6144];
#pragma unroll
              for (int c = 0; c < 9; ++c) a[c] += cond[c * 64 + k] * wv; }
#pragma unroll
          for (int c = 0; c < 9; ++c) part[(((size_t)ks * 4 + Ly) * 9 + c) * 6144 + col] = a[c];
      }
      __syncthreads(); }
    { f32x2* rd = (f32x2*)(p.ws + WS_ROPED); f32x2* rg = (f32x2*)(p.ws + WS_ROPEG);
      for (size_t i = gtid; i < (size_t)2048 * 32; i += gn) { const int pos = (int)(i >> 5), pp = (int)(i & 31); const int j = pp & 15; const float inv = exp2f(-(float)j * (13.287712379549449f / 16.f));
          const float ang = (float)(pp < 16 ? (pos >> 6) : (pos & 63)) * inv; float s, c; sincosf(ang, &s, &c); rd[i] = (f32x2){c, s}; }
      for (size_t i = gtid; i < (size_t)2048 * 64; i += gn) { const int pos = (int)(i >> 6), pp = (int)(i & 63); const int j = pp & 31; const float inv = exp2f(-(float)j * (13.287712379549449f / 32.f));
          const float ang = (float)(pp < 32 ? (pos >> 6) : (pos & 63)) * inv; float s, c; sincosf(ang, &s, &c); rg[i] = (f32x2){c, s}; } }
    { float* lbv = (float*)(p.ws + WS_LBV); const float* lbp = p.in[18];
      for (size_t i = gtid; i < 2048; i += gn) { const int d = (int)(i >> 10), c = (int)(i & 1023); const float* q = lbp + (size_t)d * 4 * 1024 + c;
          const float v0 = q[0], v1 = q[1024], v2 = q[2048], v3 = q[3072]; const float mx = fmaxf(fmaxf(v0, v1), fmaxf(v2, v3));
          const float e0 = expf(v0 - mx), e1 = expf(v1 - mx), e2 = expf(v2 - mx), e3 = expf(v3 - mx); lbv[i] = (e1 + e2) / (e0 + e1 + e2 + e3); } }
    { bf16_t* cdt = (bf16_t*)(p.ws + WS_P + P_CDT); bf16_t* wl = (bf16_t*)(p.ws + WS_P + P_WL); bf16_t* wc = (bf16_t*)(p.ws + WS_P + P_WC);
      const float sc128 = 0.08838834764831845f, sc2048 = 0.022097086912079608f, sc256 = 0.0625f;
      for (size_t i = gtid; i < (size_t)2048 * 1024; i += gn) { const int m = (int)(i >> 10), k = (int)(i & 1023); const int cs = m >> 10, ch = m & 1023; float v = 0.f;
          if ((ch >> 7) == (k >> 7)) { const int e = ((ch & 127) * (k & 127)) & 127; const float a = (float)e * (2.f / 128.f); v = (cs ? sinpif(a) : cospif(a)) * sc128; }
          cdt[i] = f2bf(v); }
      for (size_t i = gtid; i < (size_t)2048 * 4096; i += gn) { const int kf = (int)(i >> 12), kk = (int)(i & 4095); const int cs = kk >> 11, t = kk & 2047; const int e = (kf * t) & 2047;
          const float a = (float)e * (2.f / 2048.f); wl[i] = f2bf((cs ? -sinpif(a) : cospif(a)) * sc2048); }
      for (size_t i = gtid; i < (size_t)256 * 512; i += gn) { const int kf = (int)(i >> 9), kk = (int)(i & 511); const int cs = kk >> 8, t = kk & 255; const int e = (kf * t) & 255;
          const float a = (float)e * (2.f / 256.f); wc[i] = f2bf((cs ? -sinpif(a) : cospif(a)) * sc256); } }
    convert_layer(p, 0, shm);
}
DI void mod_reduce(const Params& p) {
    OPAQUE_IDS
    const size_t gtid = (size_t)bx * NTHR + tx, gn = (size_t)gridDim.x * NTHR;
    const float* part = (const float*)(p.ws + WS_P + P_PART); float* mod = (float*)(p.ws + WS_MOD);
    for (size_t i = gtid; i < (size_t)4 * 9 * 6144; i += gn) { const int col = (int)(i % 6144), Ly = (int)(i / (9 * 6144));
        float a = p.in[5][(size_t)Ly * 6144 + col];
        for (int ks = 0; ks < 16; ++ks) a += part[(size_t)ks * 4 * 9 * 6144 + i];
        mod[i] = a; }
}

DI void norm_phase(const Params& p, int layer, int which, bool lat_only, const float* __restrict__ part, int npart, int srcmode) {
    OPAQUE_IDS
    const int lane = tx & 63, gw = bx * 8 + (tx >> 6);
    const float* gain = p.in[6] + ((size_t)layer * 2 + which) * D; const float* mod = (const float*)(p.ws + WS_MOD) + (size_t)layer * 9 * 6144;
    bf16_t* H = (bf16_t*)(p.ws + WS_H);
    f32x4 gm[4], sh[4]; int cur_ci = -1;
    const int nw = gridDim.x * 8;
    for (int vw = gw; vw < NB * 256; vw += nw)
    for (int i0 = 0; i0 < 9; i0 += 3) {
        const int r0 = (vw >> 8) * LT + (vw & 255) + 256 * i0;
        f32x4 v[3][4]; float ss[3]; bool ok[3];
#pragma unroll
        for (int q = 0; q < 3; ++q) {
            const int row = r0 + 256 * q; const int b = row / LT, pos = row - b * LT;
            ok[q] = !(lat_only && pos < LC); ss[q] = 0.f;
            if (ok[q]) {
                float* x = resid_row(p, row);
                const float* xs = (srcmode == 1 || (srcmode == 2 && pos < LC)) ? (pos < LC ? p.in[2] + ((size_t)(b * LC + pos)) * D : p.in[0] + ((size_t)(b * LL + pos - LC)) * D) : x;
#pragma unroll
                for (int j = 0; j < 4; ++j) v[q][j] = *(const f32x4*)(xs + j * 256 + lane * 4);
                if (part != nullptr && pos < LC) {
                    f32x4 a[4];
#pragma unroll
                    for (int j = 0; j < 4; ++j) a[j] = (f32x4){0.f, 0.f, 0.f, 0.f};
                    const float* pp = part + (size_t)(b * LC + pos) * D + lane * 4;
                    for (int s = 0; s < npart; ++s) {
#pragma unroll
                        for (int j = 0; j < 4; ++j) a[j] += *(const f32x4*)(pp + (size_t)s * NB * LC * D + j * 256); }
#pragma unroll
                    for (int j = 0; j < 4; ++j) { v[q][j] += a[j]; *(f32x4*)(x + j * 256 + lane * 4) = v[q][j]; }
                }
#pragma unroll
                for (int j = 0; j < 4; ++j) ss[q] += v[q][j][0] * v[q][j][0] + v[q][j][1] * v[q][j][1] + v[q][j][2] * v[q][j][2] + v[q][j][3] * v[q][j][3];
            }
        }
        ss[0] = wave_sum(ss[0]); ss[1] = wave_sum(ss[1]); ss[2] = wave_sum(ss[2]);
#pragma unroll
        for (int q = 0; q < 3; ++q) {
            if (!ok[q]) continue;
            const int row = r0 + 256 * q; const int ci = cond_idx(row);
            if (ci != cur_ci) { cur_ci = ci; const float* mo = mod + (size_t)ci * 6144 + which * 3072;
#pragma unroll
                for (int j = 0; j < 4; ++j) { const int col = j * 256 + lane * 4; gm[j] = *(const f32x4*)(gain + col) * (1.f + *(const f32x4*)(mo + 1024 + col)); sh[j] = *(const f32x4*)(mo + col); } }
            const float r = rsqrtf(ss[q] * (1.f / 1024.f) + EPS);
#pragma unroll
            for (int j = 0; j < 4; ++j) { const int col = j * 256 + lane * 4; const f32x4 y = v[q][j] * r * gm[j] + sh[j];
                *(u32x2*)(H + (size_t)row * D + col) = (u32x2){pack2(y[0], y[1]), pack2(y[2], y[3])}; }
        }
    }
}

template <int HS>
DI void qknorm_phase(bf16_t* QK, int RL, const float* kgain, int gain_mod, const f32x2* rope) {
    OPAQUE_IDS
    const int lane = tx & 63, gw = bx * 8 + (tx >> 6), nw = gridDim.x * 8;
    const int lpr = (RL - 1024) / HS, rpw = 64 / lpr, rsub = lane / lpr, kl = lane - rsub * lpr, seg = kl >> 1, half = kl & 1;
    const float* gn = kgain + (gain_mod ? (seg % gain_mod) * 2 * HS : 0) + half * HS;
    for (int row0 = gw * rpw; row0 < T; row0 += nw * rpw) {
        const int row = row0 + rsub; const bool act = row < T; const int rowc = act ? row : T - 1;
        const int b = rowc / LT, pos = rowc - b * LT;
        float x[HS]; float ss = 0.f;
        bf16_t* ptr = QK + (size_t)rowc * RL + 1024 + kl * HS;
#pragma unroll
        for (int c = 0; c < HS / 8; ++c) { const u32x4 w = *(const u32x4*)(ptr + c * 8);
            x[c * 8 + 0] = bflo(w.x); x[c * 8 + 1] = bfhi(w.x); x[c * 8 + 2] = bflo(w.y); x[c * 8 + 3] = bfhi(w.y);
            x[c * 8 + 4] = bflo(w.z); x[c * 8 + 5] = bfhi(w.z); x[c * 8 + 6] = bflo(w.w); x[c * 8 + 7] = bfhi(w.w); }
#pragma unroll
        for (int e = 0; e < HS; ++e) ss += x[e] * x[e];
        ss += dpp_f<0xB1>(ss);
        const float r = rsqrtf(ss * (1.f / (2 * HS)) + EPS);
        const bool lat = pos >= LC; const f32x2* rp = rope + (size_t)(lat ? pos - LC : 0) * HS;
#pragma unroll
        for (int e = 0; e < HS; ++e) {
            float v = x[e] * r * gn[e];
            const float o = dpp_f<0xB1>(v);
            if (lat) { const f32x2 cs = rp[e]; v = half ? (o * cs[1] + v * cs[0]) : (v * cs[0] - o * cs[1]); }
            x[e] = v;
        }
        if (act) {
#pragma unroll
            for (int c = 0; c < HS / 8; ++c) { u32x4 w; w.x = pack2(x[c * 8], x[c * 8 + 1]); w.y = pack2(x[c * 8 + 2], x[c * 8 + 3]); w.z = pack2(x[c * 8 + 4], x[c * 8 + 5]); w.w = pack2(x[c * 8 + 6], x[c * 8 + 7]);
                *(u32x4*)(ptr + c * 8) = w; }
        }
    }
}
DI float half_swap_max(float x) { const unsigned u = __float_as_uint(x); const auto r = __builtin_amdgcn_permlane32_swap(u, u, false, false); return fmaxf(__uint_as_float(r[0]), __uint_as_float(r[1])); }
DI float half_swap_sum(float x) { const unsigned u = __float_as_uint(x); const auto r = __builtin_amdgcn_permlane32_swap(u, u, false, false); return __uint_as_float(r[0]) + __uint_as_float(r[1]); }
#define MFMA32(a, b, c) __builtin_amdgcn_mfma_f32_32x32x16_bf16((a), (b), (c), 0, 0, 0)
template <int DQK, int MODE>
DI void attn_phase(const bf16_t* __restrict__ QK, int ldq, const bf16_t* __restrict__ Vt, int VC, bf16_t* __restrict__ O, int ldo, int nhu, bool skip_ctx, const float* __restrict__ qgain, const f32x2* __restrict__ rope, float qscale, char* shm) {
    OPAQUE_IDS
    constexpr int KS = DQK * 2 + 16, VS = 144, KCH = DQK / 8, NKC = 64 * KCH / NTHR;
    constexpr int BUFB = 64 * KS + 128 * VS;
    char* Kl = shm; char* Vl = shm + 64 * KS;
    const int tid = tx, w = tid >> 6, lane = tid & 63, r = lane & 31, h = lane >> 5;
    const int nlat = NB * nhu * 8, nunits = nlat + (skip_ctx ? 0 : NB * nhu);
    for (int u = bx; u < nunits; u += gridDim.x) {
        int qt, hu, b;
        if (u < nlat) { qt = 1 + (u & 7); hu = (u >> 3) % nhu; b = (u >> 3) / nhu; } else { const int v = u - nlat; qt = 0; hu = v % nhu; b = v / nhu; }
        const int qoff = hu * DQK, koff = 1024 + (MODE == 0 ? hu * 64 : (hu >> 2) * 128), voff = (MODE == 0 ? (hu >> 1) : (hu >> 2)) * 128, ooff = hu * 128;
        const int nkt = qt == 0 ? 4 : 36;
        const size_t qrow = (size_t)b * LT + qt * 256 + w * 32 + r;
        bf16x8 qf[DQK / 16];
#pragma unroll
        for (int ks = 0; ks < DQK / 16; ++ks) qf[ks] = *(const bf16x8*)(QK + qrow * ldq + qoff + ks * 16 + h * 8);
        {
            float ss = 0.f;
#pragma unroll
            for (int ks = 0; ks < DQK / 16; ++ks) { const u32x4 wq = __builtin_bit_cast(u32x4, qf[ks]);
                const float a0 = bflo(wq.x), a1 = bfhi(wq.x), a2 = bflo(wq.y), a3 = bfhi(wq.y), a4 = bflo(wq.z), a5 = bfhi(wq.z), a6 = bflo(wq.w), a7 = bfhi(wq.w);
                ss += a0 * a0 + a1 * a1 + a2 * a2 + a3 * a3 + a4 * a4 + a5 * a5 + a6 * a6 + a7 * a7; }
            ss += __shfl_xor(ss, 32);
            const float rr = rsqrtf(ss * (1.f / DQK) + EPS) * qscale; int go = (MODE == 0 ? (hu & 1) * 64 : 0) + h * 8; asm volatile("" : "+v"(go));
            const float* gq = qgain + go; const f32x2* rp = rope + (size_t)((qt > 0 ? qt - 1 : 0) * 256 + w * 32 + r) * (DQK / 2) + h * 8;
#pragma unroll
            for (int ks = 0; ks < DQK / 32; ++ks) {
                const u32x4 wa = __builtin_bit_cast(u32x4, qf[ks]), wb = __builtin_bit_cast(u32x4, qf[ks + DQK / 32]);
                float xa[8] = {bflo(wa.x), bfhi(wa.x), bflo(wa.y), bfhi(wa.y), bflo(wa.z), bfhi(wa.z), bflo(wa.w), bfhi(wa.w)};
                float xb[8] = {bflo(wb.x), bfhi(wb.x), bflo(wb.y), bfhi(wb.y), bflo(wb.z), bfhi(wb.z), bflo(wb.w), bfhi(wb.w)};
#pragma unroll
                for (int j = 0; j < 8; ++j) { float x1 = xa[j] * rr * gq[ks * 16 + j], x2 = xb[j] * rr * gq[(ks + DQK / 32) * 16 + j];
                    if (qt > 0) { const f32x2 cs = rp[ks * 16 + j]; const float y1 = x1 * cs[0] - x2 * cs[1], y2 = x1 * cs[1] + x2 * cs[0]; x1 = y1; x2 = y2; }
                    xa[j] = x1; xb[j] = x2; }
                qf[ks] = __builtin_bit_cast(bf16x8, (u32x4){pack2(xa[0], xa[1]), pack2(xa[2], xa[3]), pack2(xa[4], xa[5]), pack2(xa[6], xa[7])});
                qf[ks + DQK / 32] = __builtin_bit_cast(bf16x8, (u32x4){pack2(xb[0], xb[1]), pack2(xb[2], xb[3]), pack2(xb[4], xb[5]), pack2(xb[6], xb[7])});
            }
        }
        f32x16 oacc[4];
#pragma unroll
        for (int t = 0; t < 4; ++t)
#pragma unroll
            for (int i = 0; i < 16; ++i) oacc[t][i] = 0.f;
        float mrun = -1e30f, lsum = 0.f;
        const bf16_t* kbase = QK + (size_t)b * LT * ldq + koff; const bf16_t* vbase = Vt + ((size_t)b * VC + voff) * LT;
        u32x4 kreg[NKC], vreg[2];
#define ATT_LOAD(kt) do { _Pragma("unroll") for (int i = 0; i < NKC; ++i) { const int c = tid + i * NTHR, key = c / KCH, part = c % KCH; \
                kreg[i] = *(const u32x4*)(kbase + (size_t)((kt) * 64 + key) * ldq + part * 8); } \
            _Pragma("unroll") for (int i = 0; i < 2; ++i) { const int c = tid + i * NTHR, dv = c >> 3, part = c & 7; \
                vreg[i] = *(const u32x4*)(vbase + (size_t)dv * LT + (kt) * 64 + part * 8); } } while (0)
        ATT_LOAD(0);
#define ATT_STORE(buf) do { char* Kw = Kl + (buf) * BUFB; char* Vw = Vl + (buf) * BUFB; \
            _Pragma("unroll") for (int i = 0; i < NKC; ++i) { const int c = tid + i * NTHR, key = c / KCH, part = c % KCH; *(u32x4*)(Kw + key * KS + part * 16) = kreg[i]; } \
            _Pragma("unroll") for (int i = 0; i < 2; ++i) { const int c = tid + i * NTHR, dv = c >> 3, part = c & 7; char* vp_ = Vw + dv * VS + (part >> 1) * 32 + (part & 1) * 8; \
                *(u32x2*)(vp_) = (u32x2){vreg[i].x, vreg[i].y}; *(u32x2*)(vp_ + 16) = (u32x2){vreg[i].z, vreg[i].w}; } } while (0)
        __syncthreads();
        ATT_STORE(0);
        __syncthreads();
        for (int kt = 0; kt < nkt; ++kt) {
            const char* Kc = Kl + (kt & 1) * BUFB; const char* Vc = Vl + (kt & 1) * BUFB;
            if (kt + 1 < nkt) ATT_LOAD(kt + 1);
            f32x16 st0, st1;
#pragma unroll
            for (int i = 0; i < 16; ++i) { st0[i] = 0.f; st1[i] = 0.f; }
#pragma unroll
            for (int ks = 0; ks < DQK / 16; ++ks) {
                const bf16x8 a0 = *(const bf16x8*)(Kc + r * KS + ks * 32 + h * 16), a1 = *(const bf16x8*)(Kc + (32 + r) * KS + ks * 32 + h * 16);
                st0 = MFMA32(a0, qf[ks], st0); st1 = MFMA32(a1, qf[ks], st1);
            }
            float mx = st0[0];
#pragma unroll
            for (int i = 0; i < 16; ++i) mx = __builtin_fmaxf(__builtin_fmaxf(mx, st0[i]), st1[i]);
            mx = half_swap_max(mx);
            if (__any(mx > mrun + 8.f)) {
                const float mnew = fmaxf(mrun, mx), alpha = __builtin_amdgcn_exp2f(mrun - mnew); mrun = mnew; lsum *= alpha;
#pragma unroll
                for (int t = 0; t < 4; ++t)
#pragma unroll
                    for (int i = 0; i < 16; ++i) oacc[t][i] *= alpha;
            }
            { const f32x2 m2 = (f32x2){mrun, mrun}; f32x2 ps2 = (f32x2){0.f, 0.f};
#pragma unroll
              for (int i = 0; i < 16; i += 2) {
                  f32x2 a = (f32x2){st0[i], st0[i + 1]} - m2, c = (f32x2){st1[i], st1[i + 1]} - m2;
                  a[0] = __builtin_amdgcn_exp2f(a[0]); a[1] = __builtin_amdgcn_exp2f(a[1]); c[0] = __builtin_amdgcn_exp2f(c[0]); c[1] = __builtin_amdgcn_exp2f(c[1]);
                  ps2 += a; ps2 += c; st0[i] = a[0]; st0[i + 1] = a[1]; st1[i] = c[0]; st1[i + 1] = c[1]; }
              lsum += ps2[0] + ps2[1]; }
#pragma unroll
            for (int kb = 0; kb < 2; ++kb)
#pragma unroll
                for (int s = 0; s < 2; ++s) {
                    u32x4 pw;
                    if (kb == 0) { pw.x = pack2(st0[8 * s], st0[8 * s + 1]); pw.y = pack2(st0[8 * s + 2], st0[8 * s + 3]); pw.z = pack2(st0[8 * s + 4], st0[8 * s + 5]); pw.w = pack2(st0[8 * s + 6], st0[8 * s + 7]); }
                    else { pw.x = pack2(st1[8 * s], st1[8 * s + 1]); pw.y = pack2(st1[8 * s + 2], st1[8 * s + 3]); pw.z = pack2(st1[8 * s + 4], st1[8 * s + 5]); pw.w = pack2(st1[8 * s + 6], st1[8 * s + 7]); }
                    const bf16x8 pb = __builtin_bit_cast(bf16x8, pw);
#pragma unroll
                    for (int t = 0; t < 4; ++t) {
                        const bf16x8 a = *(const bf16x8*)(Vc + (32 * t + r) * VS + (kb * 2 + s) * 32 + h * 16);
                        oacc[t] = MFMA32(a, pb, oacc[t]);
                    }
                }
            if (kt + 1 < nkt) ATT_STORE((kt + 1) & 1);
            __syncthreads();
        }
#undef ATT_STORE
#undef ATT_LOAD
        const float l = half_swap_sum(lsum), inv = 1.f / l;
        bf16_t* op = O + qrow * ldo + ooff;
#pragma unroll
        for (int t = 0; t < 4; ++t)
#pragma unroll
            for (int g = 0; g < 4; g += 2) {
                const unsigned ax = pack2(oacc[t][4 * g] * inv, oacc[t][4 * g + 1] * inv), ay = pack2(oacc[t][4 * g + 2] * inv, oacc[t][4 * g + 3] * inv);
                const unsigned bx_ = pack2(oacc[t][4 * g + 4] * inv, oacc[t][4 * g + 5] * inv), by_ = pack2(oacc[t][4 * g + 6] * inv, oacc[t][4 * g + 7] * inv);
                const auto sx = __builtin_amdgcn_permlane32_swap(ax, bx_, false, false); const auto sy = __builtin_amdgcn_permlane32_swap(ay, by_, false, false);
                *(u32x4*)(op + 32 * t + 8 * (g + h)) = (u32x4){sx[0], sy[0], sx[1], sy[1]}; }
    }
    __syncthreads();
}

template <int MODE>
DI void headnorm_phase(const Params& p, const bf16_t* __restrict__ A0, const bf16_t* __restrict__ A1, const bf16_t* __restrict__ G, const float* gain, float lam, float outscale) {
    OPAQUE_IDS
    const int lane = tx & 63, gw = bx * 8 + (tx >> 6), nw = gridDim.x * 8;
    bf16_t* H = (bf16_t*)(p.ws + WS_H); const int hh = lane >> 3, d0 = (lane & 7) * 16;
    for (int row = gw; row < T; row += nw) {
        float x[16];
#pragma unroll
        for (int c = 0; c < 2; ++c) {
            u32x4 a, b2;
            if (MODE == 0) { a = *(const u32x4*)(A0 + (size_t)row * 2048 + hh * 256 + d0 + c * 8); b2 = *(const u32x4*)(A0 + (size_t)row * 2048 + hh * 256 + 128 + d0 + c * 8); }
            else { a = *(const u32x4*)(A0 + (size_t)row * D + hh * 128 + d0 + c * 8); b2 = *(const u32x4*)(A1 + (size_t)row * D + hh * 128 + d0 + c * 8); }
            const float s = MODE == 0 ? -lam : 1.f;
            x[c * 8 + 0] = bflo(a.x) + s * bflo(b2.x); x[c * 8 + 1] = bfhi(a.x) + s * bfhi(b2.x); x[c * 8 + 2] = bflo(a.y) + s * bflo(b2.y); x[c * 8 + 3] = bfhi(a.y) + s * bfhi(b2.y);
            x[c * 8 + 4] = bflo(a.z) + s * bflo(b2.z); x[c * 8 + 5] = bfhi(a.z) + s * bfhi(b2.z); x[c * 8 + 6] = bflo(a.w) + s * bflo(b2.w); x[c * 8 + 7] = bfhi(a.w) + s * bfhi(b2.w);
        }
        float ss = 0.f;
#pragma unroll
        for (int e = 0; e < 16; ++e) ss += x[e] * x[e];
        ss += __shfl_xor(ss, 1); ss += __shfl_xor(ss, 2); ss += __shfl_xor(ss, 4);
        const float r = rsqrtf(ss * (1.f / 128.f) + EPS) * outscale;
#pragma unroll
        for (int c = 0; c < 2; ++c) {
            float y[8];
#pragma unroll
            for (int e = 0; e < 8; ++e) y[e] = x[c * 8 + e] * r * gain[d0 + c * 8 + e];
            if (MODE == 1) { const u32x4 g = *(const u32x4*)(G + (size_t)row * D + hh * 128 + d0 + c * 8);
                y[0] *= silu_f(bflo(g.x)); y[1] *= silu_f(bfhi(g.x)); y[2] *= silu_f(bflo(g.y)); y[3] *= silu_f(bfhi(g.y));
                y[4] *= silu_f(bflo(g.z)); y[5] *= silu_f(bfhi(g.z)); y[6] *= silu_f(bflo(g.w)); y[7] *= silu_f(bfhi(g.w)); }
            u32x4 wv; wv.x = pack2(y[0], y[1]); wv.y = pack2(y[2], y[3]); wv.z = pack2(y[4], y[5]); wv.w = pack2(y[6], y[7]);
            *(u32x4*)(H + (size_t)row * D + hh * 128 + d0 + c * 8) = wv;
        }
    }
}

DI float dpp_x1(float x) { return __int_as_float(__builtin_amdgcn_update_dpp(0, __float_as_int(x), 0xB1, 0xF, 0xF, true)); }
DI float dpp_x2(float x) { return __int_as_float(__builtin_amdgcn_update_dpp(0, __float_as_int(x), 0x4E, 0xF, 0xF, true)); }
DI void hgrn_scan(const Params& p, char* shm) {
    OPAQUE_IDS
    constexpr int TCH = 32;
    const unsigned char* P = p.ws + WS_P;
    const bf16_t* Qh = (const bf16_t*)(P + P_HQ); const bf16_t* V = (const bf16_t*)(P + P_HV);
    float* fL = (float*)shm; float* qL = fL + TCH * 128; float* vL = qL + TCH * 128; float* pL = vL + TCH * 64;
    const int tid = tx, w = tid >> 6, lane = tid & 63, kg = lane & 3, vg = lane >> 2;
    for (int u = bx; u < 256; u += gridDim.x) {
        const int slice = u & 1, dir = (u >> 1) & 1, head = (u >> 2) & 7, b = u >> 5;
        const float* F = (const float*)(P + (dir ? P_HF1 : P_HF0)); bf16_t* Oo = dir ? (bf16_t*)(p.ws + WS_P + P_HOB) : (bf16_t*)(p.ws + WS_H);
        f32x2 s[4][2];
#pragma unroll
        for (int i = 0; i < 4; ++i) { s[i][0] = (f32x2){0.f, 0.f}; s[i][1] = (f32x2){0.f, 0.f}; }
        const int ltok = tid >> 5, lk4 = (tid & 31) * 4, vtok = tid >> 4, lv4 = (tid & 15) * 4;
        f32x4 fr[2]; u32x2 qr[2]; u32x2 vr;
#define HG_ROW(tau) ((size_t)b * LT + (dir == 0 ? (tau) : ((tau) < LC ? (LC - 1 - (tau)) : (LT + LC - 1 - (tau)))))
#define HG_LOAD(ch) do { _Pragma("unroll") for (int i_ = 0; i_ < 2; ++i_) { const size_t row = HG_ROW((ch) * TCH + ltok + 16 * i_); fr[i_] = *(const f32x4*)(F + row * D + head * 128 + lk4); \
            qr[i_] = *(const u32x2*)(Qh + row * D + head * 128 + lk4); } \
            { const size_t row = HG_ROW((ch) * TCH + vtok); vr = *(const u32x2*)(V + row * D + head * 128 + slice * 64 + lv4); } } while (0)
        HG_LOAD(0);
        for (int ch = 0; ch < LT / TCH; ++ch) {
            __syncthreads();
#pragma unroll
            for (int i_ = 0; i_ < 2; ++i_) { *(f32x4*)(fL + (ltok + 16 * i_) * 128 + lk4) = fr[i_];
                *(f32x4*)(qL + (ltok + 16 * i_) * 128 + lk4) = (f32x4){bflo(qr[i_].x), bfhi(qr[i_].x), bflo(qr[i_].y), bfhi(qr[i_].y)}; }
            *(f32x4*)(vL + vtok * 64 + lv4) = (f32x4){bflo(vr.x), bfhi(vr.x), bflo(vr.y), bfhi(vr.y)};
            __syncthreads();
            if (ch + 1 < LT / TCH) HG_LOAD(ch + 1);
#pragma unroll 4
            for (int tok = 0; tok < TCH; ++tok) {
                const f32x4 f4 = *(const f32x4*)(fL + tok * 128 + w * 16 + kg * 4), q4 = *(const f32x4*)(qL + tok * 128 + w * 16 + kg * 4), v4 = *(const f32x4*)(vL + tok * 64 + vg * 4);
                const f32x2 va = (f32x2){v4[0], v4[1]}, vb = (f32x2){v4[2], v4[3]}; f32x2 oa = (f32x2){0.f, 0.f}, ob = (f32x2){0.f, 0.f};
#pragma unroll
                for (int ki = 0; ki < 4; ++ki) { const f32x2 f2 = (f32x2){f4[ki], f4[ki]}, q2 = (f32x2){q4[ki], q4[ki]};
                    f32x2 d = s[ki][0] - va; s[ki][0] = f2 * d + va; oa += s[ki][0] * q2;
                    d = s[ki][1] - vb; s[ki][1] = f2 * d + vb; ob += s[ki][1] * q2; }
                f32x4 o4 = (f32x4){oa[0], oa[1], ob[0], ob[1]};
#pragma unroll
                for (int e = 0; e < 4; ++e) { o4[e] += dpp_x1(o4[e]); o4[e] += dpp_x2(o4[e]); }
                if (kg == 0) *(f32x4*)(pL + (w * TCH + tok) * 64 + vg * 4) = o4;
            }
            __syncthreads();
            { f32x4 a = (f32x4){0.f, 0.f, 0.f, 0.f};
#pragma unroll
              for (int ww = 0; ww < 8; ++ww) a += *(const f32x4*)(pL + (ww * TCH + vtok) * 64 + lv4);
              const size_t row = HG_ROW(ch * TCH + vtok); *(u32x2*)(Oo + row * D + head * 128 + slice * 64 + lv4) = (u32x2){pack2(a[0], a[1]), pack2(a[2], a[3])}; }
        }
#undef HG_LOAD
#undef HG_ROW
    }
    __syncthreads();
}

#define HG_ROW(b, dir, tau) ((size_t)(b) * LT + ((dir) == 0 ? (tau) : ((tau) < LC ? (LC - 1 - (tau)) : (LT + LC - 1 - (tau)))))
#define HG_MINROW(b, dir, c) ((dir) == 0 ? HG_ROW(b, 0, (c) * 16) : HG_ROW(b, 1, (c) * 16 + 15))
DI void hgrn_prep(const Params& p) {
    OPAQUE_IDS
    unsigned char* P = p.ws + WS_P; const bf16_t* Qh = (const bf16_t*)(P + P_HQ); float* EB = (float*)(p.ws + WS_EB);
    const int col2 = tx * 2;
    for (int it = bx; it < 2 * NB * 144; it += gridDim.x) {
        const int dir = it & 1, rem = it >> 1, c = rem % 144, b = rem / 144;
        float* F = (float*)(P + (dir ? P_HF1 : P_HF0));
        f32x2 f2[16]; unsigned q2[16];
#pragma unroll
        for (int t = 0; t < 16; ++t) { const size_t row = HG_ROW(b, dir, c * 16 + t); f2[t] = *(const f32x2*)(F + row * D + col2); q2[t] = *(const unsigned*)(Qh + row * D + col2); }
        unsigned qt[16], k0[8], k1[8]; float run0 = 0.f, run1 = 0.f, ka = 0.f, kb = 0.f;
#pragma unroll
        for (int t = 0; t < 16; ++t) {
            run0 += __logf(f2[t][0]); run1 += __logf(f2[t][1]);
            qt[t] = pack2(bflo(q2[t]) * __expf(run0), bfhi(q2[t]) * __expf(run1));
            const float a = (1.f - f2[t][0]) * __expf(fminf(-run0, 80.f)), bq = (1.f - f2[t][1]) * __expf(fminf(-run1, 80.f));
            if (t & 1) { k0[t >> 1] = pack2(ka, a); k1[t >> 1] = pack2(kb, bq); } else { ka = a; kb = bq; }
        }
        __syncthreads();
        unsigned char* base = (unsigned char*)F + HG_MINROW(b, dir, c) * 4096;
#pragma unroll
        for (int t = 0; t < 16; ++t) *(unsigned*)(base + t * 2048 + col2 * 2) = qt[t];
        *(u32x4*)(base + 32768 + col2 * 32) = (u32x4){k0[0], k0[1], k0[2], k0[3]}; *(u32x4*)(base + 32768 + col2 * 32 + 16) = (u32x4){k0[4], k0[5], k0[6], k0[7]};
        *(u32x4*)(base + 32768 + col2 * 32 + 32) = (u32x4){k1[0], k1[1], k1[2], k1[3]}; *(u32x4*)(base + 32768 + col2 * 32 + 48) = (u32x4){k1[4], k1[5], k1[6], k1[7]};
        *(f32x2*)(EB + ((size_t)(dir * NB + b) * 144 + c) * D + col2) = (f32x2){__expf(run0), __expf(run1)};
        __syncthreads();
    }
}
DI void hgrn_scan_mfma(const Params& p, char* shm) {
    OPAQUE_IDS
    constexpr int C = 32, QS = 272;
    const unsigned char* P = p.ws + WS_P;
    const bf16_t* V = (const bf16_t*)(P + P_HV); const float* EB = (const float*)(p.ws + WS_EB); const bf16_t* Qh = (const bf16_t*)(P + P_HQ);
    char* QtL = shm;
    char* VL = QtL + C * QS;
    char* KtL = VL + C * QS;
    float* eBL = (float*)(KtL + C * QS);
    const int tid = tx, w = tid >> 6, lane = tid & 63, l15 = lane & 15, g = lane >> 4;
    for (int u = bx; u < 128; u += gridDim.x) {
        const int dir = u & 1, head = (u >> 1) & 7, b = u >> 4;
        const unsigned char* Fb = P + (dir ? P_HF1 : P_HF0); bf16_t* Oo = dir ? (bf16_t*)(p.ws + WS_P + P_HOB) : (bf16_t*)(p.ws + WS_H);
        f32x4 S[8];
#pragma unroll
        for (int kt = 0; kt < 8; ++kt) S[kt] = (f32x4){0.f, 0.f, 0.f, 0.f};
        const int lt = tid >> 4, lp = tid & 15;
        u32x4 ra0, ra1, ra2, ra3, ra4, rb0, rb1, rb2, rb3, rb4;
#define HG_LOAD(ch, r0, r1, r2, r3, r4) do { const size_t row_ = HG_ROW(b, dir, (ch) * C + lt); const unsigned char* fr_ = Fb + row_ * 4096; \
            r0 = *(const u32x4*)(Qh + row_ * D + head * 128 + lp * 8); r1 = *(const u32x4*)(fr_ + (head * 128 + lp * 8) * 2); r2 = *(const u32x4*)(V + row_ * D + head * 128 + lp * 8); \
            r3 = *(const u32x4*)(fr_ + (1024 + head * 128 + lp * 8) * 2); \
            if (tid < 32) r4 = *(const u32x4*)(EB + ((size_t)(dir * NB + b) * 72 + (ch)) * D + head * 128 + tid * 4); } while (0)
#define HG_QE(qw, ew) pack2(bflo(qw) * bflo(ew), bfhi(qw) * bfhi(ew))
#define HG_STAGE(ch, r0, r1, r2, r3, r4) do { __syncthreads(); \
            *(u32x4*)(QtL + lt * QS + lp * 16) = (u32x4){HG_QE(r0.x, r1.x), HG_QE(r0.y, r1.y), HG_QE(r0.z, r1.z), HG_QE(r0.w, r1.w)}; *(u32x4*)(VL + lt * QS + lp * 16) = r2; \
            *(u32x4*)(KtL + lt * QS + lp * 16) = r3; if (tid < 32) *(u32x4*)((char*)eBL + tid * 16) = r4; \
            __syncthreads(); \
            if ((ch) + 2 < LT / C) HG_LOAD((ch) + 2, r0, r1, r2, r3, r4); } while (0)
        HG_LOAD(0, ra0, ra1, ra2, ra3, ra4); HG_LOAD(1, rb0, rb1, rb2, rb3, rb4);
        for (int ch2 = 0; ch2 < LT / C; ch2 += 2) {
#pragma unroll
          for (int hh = 0; hh < 2; ++hh) {
            const int ch = ch2 + hh;
            if (hh == 0) HG_STAGE(ch, ra0, ra1, ra2, ra3, ra4); else HG_STAGE(ch, rb0, rb1, rb2, rb3, rb4);
            { const bf16_t* kt16 = (const bf16_t*)KtL; const bf16_t* v16 = (const bf16_t*)VL; const int vcol = w * 16 + l15;
#define HG_U2(arr, r_a, r_b, c_) ((unsigned)(arr)[(r_a) * (QS / 2) + (c_)] | ((unsigned)(arr)[(r_b) * (QS / 2) + (c_)] << 16))
              const bf16x8 vf = __builtin_bit_cast(bf16x8, (u32x4){HG_U2(v16, g * 4 + 0, g * 4 + 1, vcol), HG_U2(v16, g * 4 + 2, g * 4 + 3, vcol), HG_U2(v16, 16 + g * 4 + 0, 16 + g * 4 + 1, vcol), HG_U2(v16, 16 + g * 4 + 2, 16 + g * 4 + 3, vcol)});
              f32x4 sc00 = (f32x4){0.f, 0.f, 0.f, 0.f}, sc01 = sc00, sc11 = sc00, o0 = sc00, o1 = sc00;
#pragma unroll
              for (int kc = 0; kc < 4; ++kc) {
                  const bf16x8 aK0 = *(const bf16x8*)(KtL + l15 * QS + kc * 64 + g * 16), aK1 = *(const bf16x8*)(KtL + (16 + l15) * QS + kc * 64 + g * 16);
                  const bf16x8 bQ0 = *(const bf16x8*)(QtL + l15 * QS + kc * 64 + g * 16), bQ1 = *(const bf16x8*)(QtL + (16 + l15) * QS + kc * 64 + g * 16);
                  sc00 = __builtin_amdgcn_mfma_f32_16x16x32_bf16(aK0, bQ0, sc00, 0, 0, 0);
                  sc01 = __builtin_amdgcn_mfma_f32_16x16x32_bf16(aK0, bQ1, sc01, 0, 0, 0);
                  sc11 = __builtin_amdgcn_mfma_f32_16x16x32_bf16(aK1, bQ1, sc11, 0, 0, 0);
                  const int kp = kc;
                  const u32x2 qa0 = *(const u32x2*)(QtL + l15 * QS + ((2 * kp) * 16 + g * 4) * 2), qb0 = *(const u32x2*)(QtL + l15 * QS + ((2 * kp + 1) * 16 + g * 4) * 2);
                  const u32x2 qa1 = *(const u32x2*)(QtL + (16 + l15) * QS + ((2 * kp) * 16 + g * 4) * 2), qb1 = *(const u32x2*)(QtL + (16 + l15) * QS + ((2 * kp + 1) * 16 + g * 4) * 2);
                  const bf16x8 sw = __builtin_bit_cast(bf16x8, (u32x4){pack2(S[2 * kp][0], S[2 * kp][1]), pack2(S[2 * kp][2], S[2 * kp][3]), pack2(S[2 * kp + 1][0], S[2 * kp + 1][1]), pack2(S[2 * kp + 1][2], S[2 * kp + 1][3])});
                  o0 = __builtin_amdgcn_mfma_f32_16x16x32_bf16(__builtin_bit_cast(bf16x8, (u32x4){qa0.x, qa0.y, qb0.x, qb0.y}), sw, o0, 0, 0, 0);
                  o1 = __builtin_amdgcn_mfma_f32_16x16x32_bf16(__builtin_bit_cast(bf16x8, (u32x4){qa1.x, qa1.y, qb1.x, qb1.y}), sw, o1, 0, 0, 0); }
#pragma unroll
              for (int r = 0; r < 4; ++r) if (g * 4 + r > l15) { sc00[r] = 0.f; sc11[r] = 0.f; }
              o0 = __builtin_amdgcn_mfma_f32_16x16x32_bf16(__builtin_bit_cast(bf16x8, (u32x4){pack2(sc00[0], sc00[1]), pack2(sc00[2], sc00[3]), 0u, 0u}), vf, o0, 0, 0, 0);
              o1 = __builtin_amdgcn_mfma_f32_16x16x32_bf16(__builtin_bit_cast(bf16x8, (u32x4){pack2(sc01[0], sc01[1]), pack2(sc01[2], sc01[3]), pack2(sc11[0], sc11[1]), pack2(sc11[2], sc11[3])}), vf, o1, 0, 0, 0);
#pragma unroll
              for (int r = 0; r < 4; ++r) { const size_t rw0 = HG_ROW(b, dir, ch * C + g * 4 + r), rw1 = HG_ROW(b, dir, ch * C + 16 + g * 4 + r);
                  Oo[rw0 * D + head * 128 + vcol] = (bf16_t)(pack2(o0[r], 0.f) & 0xffffu); Oo[rw1 * D + head * 128 + vcol] = (bf16_t)(pack2(o1[r], 0.f) & 0xffffu); }
#pragma unroll
              for (int kt = 0; kt < 8; ++kt) { const f32x4 dcy = *(const f32x4*)(eBL + kt * 16 + g * 4); const int kcol = kt * 16 + l15;
                  const bf16x8 kl = __builtin_bit_cast(bf16x8, (u32x4){HG_U2(kt16, g * 4 + 0, g * 4 + 1, kcol), HG_U2(kt16, g * 4 + 2, g * 4 + 3, kcol), HG_U2(kt16, 16 + g * 4 + 0, 16 + g * 4 + 1, kcol), HG_U2(kt16, 16 + g * 4 + 2, 16 + g * 4 + 3, kcol)});
                  S[kt] = __builtin_amdgcn_mfma_f32_16x16x32_bf16(kl, vf, S[kt], 0, 0, 0) * dcy; }
#undef HG_U2
            }
          }
        }
#undef HG_STAGE
#undef HG_QE
#undef HG_LOAD
    }
    __syncthreads();
}

#define XB_TMO      128
#define XB_XCNT(j)  (256  + 64 * (j))
#define XB_XSUB(j)  (1280 + 64 * (j))
#define XB_XGEN(j)  (2304 + 64 * (j))
#define XB_TOP      3328
#define XB_TOPGEN   3392
#define XCD_BAR_WORDS 3456
#define XB_SPIN_CAP (1u << 22)
DI unsigned xb_ld(unsigned* p)              { return __hip_atomic_load(p, __ATOMIC_RELAXED, __HIP_MEMORY_SCOPE_AGENT); }
DI unsigned xb_add(unsigned* p, unsigned v) { return __hip_atomic_fetch_add(p, v, __ATOMIC_RELAXED, __HIP_MEMORY_SCOPE_AGENT); }
DI unsigned xb_xcc_id() { return (unsigned)__builtin_amdgcn_s_getreg((3 << 11) | 20) & 0xFu; }
#define XB_SPIN(cond, bar) do { unsigned _sp = 0; while (cond) { __builtin_amdgcn_s_sleep(1); \
    if ((++_sp & 255u) == 0u) { if (xb_ld(&(bar)[XB_TMO])) break; if (_sp > XB_SPIN_CAP) { atomicAdd(&(bar)[XB_TMO], 1u); break; } } } } while (0)
struct XcdBarrier { unsigned* bar; unsigned x; volatile LAS unsigned* st; };
DI XcdBarrier xcd_barrier_post(unsigned* bar, volatile LAS unsigned* st) {
    XcdBarrier b; b.bar = bar; b.x = xb_xcc_id(); b.st = st;
    if (threadIdx.x == 0) (void)xb_add(&bar[XB_XCNT(b.x)], 1u);
    return b;
}
DI void xcd_barrier_complete(unsigned* bar, unsigned x, unsigned& nloc, unsigned& nx) {
    const unsigned G = gridDim.x * gridDim.y * gridDim.z;
    unsigned sum, cnt, mine, sp = 0u;
    for (;;) {
        sum = 0u; cnt = 0u; mine = 0u;
#pragma unroll
        for (unsigned j = 0; j < 16; ++j) { const unsigned c = xb_ld(&bar[XB_XCNT(j)]); sum += c; cnt += (c > 0u) ? 1u : 0u; mine = (j == x) ? c : mine; }
        if (sum == G) break;
        __builtin_amdgcn_s_sleep(1);
        if ((++sp & 255u) == 0u) { if (xb_ld(&bar[XB_TMO])) break; if (sp > XB_SPIN_CAP) { atomicAdd(&bar[XB_TMO], 1u); break; } }
    }
    nloc = mine > 0u ? mine : 1u; nx = cnt > 0u ? cnt : 1u;
}
DI void xcd_barrier(const XcdBarrier& b) {
    asm volatile("s_waitcnt vmcnt(0)" ::: "memory");
    __syncthreads();
    if (threadIdx.x == 0) {
        unsigned* bar = b.bar;
        __builtin_amdgcn_s_waitcnt(0);
        unsigned nloc = b.st[0], nx = b.st[1];
        if (nloc == 0u) { xcd_barrier_complete(bar, b.x, nloc, nx); b.st[0] = nloc; b.st[1] = nx; }
        const unsigned old = xb_add(&bar[XB_XSUB(b.x)], 1u);
        const unsigned gen = old / nloc;
        if (old + 1u == (gen + 1u) * nloc) {
            __builtin_amdgcn_fence(__ATOMIC_RELEASE, "agent");
            asm volatile("s_waitcnt vmcnt(0)" ::: "memory");
            const unsigned og = xb_add(&bar[XB_TOP], 1u);
            const unsigned tg = og / nx;
            if (og + 1u == (tg + 1u) * nx) xb_add(&bar[XB_TOPGEN], 1u);
            else XB_SPIN(xb_ld(&bar[XB_TOPGEN]) == tg, bar);
            __builtin_amdgcn_fence(__ATOMIC_ACQUIRE, "agent");
            xb_add(&bar[XB_XGEN(b.x)], 1u);
            asm volatile("s_waitcnt vmcnt(0)" ::: "memory");
        } else {
            XB_SPIN(xb_ld(&bar[XB_XGEN(b.x)]) == gen, bar);
            __builtin_amdgcn_fence(__ATOMIC_ACQUIRE, "agent");
            asm volatile("s_waitcnt vmcnt(0)" ::: "memory");
        }
    }
    __syncthreads();
}

template <int layer>
DI void layer_body(const Params& p, const XcdBarrier& xb, char* shm) {
    unsigned char* P = p.ws + WS_P;
    bf16_t* H = (bf16_t*)(p.ws + WS_H);
    bf16_t* wfi = (bf16_t*)(p.ws + WS_WFI); bf16_t* wfo = (bf16_t*)(p.ws + WS_WFO); bf16_t* wmi = (bf16_t*)(p.ws + WS_WMI); bf16_t* wmo = (bf16_t*)(p.ws + WS_WMO);
    const float* modall = (const float*)(p.ws + WS_MOD);
    float* ctxres = (float*)(p.ws + WS_CTXRES);
    (void)wmi; (void)H;
        const float* mod = modall + (size_t)layer * 9 * 6144;
        const bool last = layer == 3;
        PH(0) if (layer > 0) convert_layer(p, layer, shm);
        PH(1) norm_phase(p, layer, 0, false, layer > 0 ? (const float*)(P + P_PARTF) : nullptr, 8, layer == 0 ? 1 : 0);
        xcd_barrier(xb);
        if constexpr (layer == 0) {
            { const bf16_t* cdt = (const bf16_t*)(P + P_CDT); bf16_t* gtl = (bf16_t*)(P + P_GTL); bf16_t* gtc = (bf16_t*)(P + P_GTC);
              gemm_loop(NB * 72, 1024, shm,
                  [&](int L) { const int b = L / 72, r2 = L % 72, pm = r2 / 9, pn = r2 % 9, k0 = (pm & 3) * 256; return Tile{cdt + k0, H + (size_t)b * LT * D + k0, 1024, D, 256, pm * 256, pn * 256}; },
                  [&](int L, const AccT& acc, int brow, int bcol, int wr, int wc, int fr, int fq) { EpiFnet1 e{gtl, gtc, L / 72}; e(acc, brow, bcol, wr, wc, fr, fq); }); }
            xcd_barrier(xb);
            { const bf16_t* wl = (const bf16_t*)(P + P_WL); const bf16_t* wc = (const bf16_t*)(P + P_WC); bf16_t* Yb = (bf16_t*)(P + P_YB);
              const bf16_t* gtl = (const bf16_t*)(P + P_GTL); const bf16_t* gtc = (const bf16_t*)(P + P_GTC);
              gemm_loop(NB * 32, 4096, shm,
                  [&](int L) { const int b = L >> 5, pm = (L >> 2) & 7, pn = L & 3; return Tile{wl, gtl + (size_t)b * 1024 * 4096, 4096, 4096, 4096, pm * 256, pn * 256}; },
                  [&](int L, const AccT& acc, int brow, int bcol, int wr, int wc_, int fr, int fq) { EpiBf16 e{Yb + ((size_t)(L >> 5) * LT + LC) * D, (size_t)D}; e(acc, brow, bcol, wr, wc_, fr, fq); });
              gemm_loop(NB * 4, 512, shm,
                  [&](int L) { const int b = L >> 2, pn = L & 3; return Tile{wc, gtc + (size_t)b * 1024 * 512, 512, 512, 512, 0, pn * 256}; },
                  [&](int L, const AccT& acc, int brow, int bcol, int wr, int wc_, int fr, int fq) { EpiBf16 e{Yb + ((size_t)(L >> 2) * LT) * D, (size_t)D}; e(acc, brow, bcol, wr, wc_, fr, fq); }); }
            xcd_barrier(xb);
            gemm_resid<4>((const bf16_t*)(P + P_YB), wmo, D, true, p.out, p.in[0], mod + 2 * 1024, p.in[10], (float*)(P + P_PARTO), shm);
        } else if constexpr (layer == 1) {
            { bf16_t* QK = (bf16_t*)(P + P_DQK); bf16_t* Vt = (bf16_t*)(P + P_DVT); const int n1 = 72 * 8, n2 = NB * 4 * 9;
              gemm_loop(n1 + n2, D, shm,
                  [&](int L) { if (L < n1) { int pm, pn; tile_map(L, 72, 8, pm, pn); return Tile{H, wmi, D, D, D, pm * 256, pn * 256}; }
                               const int v = L - n1, b = v / 36, r2 = v % 36, pm = r2 / 9, pn = r2 % 9; return Tile{wmi + (size_t)2048 * D, H + (size_t)b * LT * D, D, D, D, pm * 256, pn * 256}; },
                  [&](int L, const AccT& acc, int brow, int bcol, int wr, int wc, int fr, int fq) {
                      if (L < n1) { EpiBf16 e{QK, (size_t)2048}; e(acc, brow, bcol, wr, wc, fr, fq); }
                      else { EpiBf16 e{Vt + (size_t)((L - n1) / 36) * 1024 * LT, (size_t)LT}; e(acc, brow, bcol, wr, wc, fr, fq); } }); }
            xcd_barrier(xb);
            PH(2) qknorm_phase<32>((bf16_t*)(P + P_DQK), 2048, p.in[13], 2, (const f32x2*)(p.ws + WS_ROPED));
            xcd_barrier(xb);
            PH(4) attn_phase<64, 0>((const bf16_t*)(P + P_DQK), 2048, (const bf16_t*)(P + P_DVT), 1024, (bf16_t*)(P + P_DO2), 2048, 16, false, p.in[12], (const f32x2*)(p.ws + WS_ROPED), 0.125f * 1.4426950408889634f, shm);
            xcd_barrier(xb);
            { const float* lp = p.in[14]; float s01 = 0.f, s23 = 0.f;
              for (int e = 0; e < 64; ++e) { s01 += lp[e] * lp[64 + e]; s23 += lp[128 + e] * lp[192 + e]; }
              const float lam_init = 0.8f - 0.6f * expf(-0.3f * 1.f); const float lam = expf(s01) - expf(s23) + lam_init;
              PH(1) headnorm_phase<0>(p, (const bf16_t*)(P + P_DO2), nullptr, nullptr, p.in[15], lam, 1.f - lam_init); }
            xcd_barrier(xb);
            gemm_resid<4>(H, wmo, D, true, p.out, p.out, mod + 2 * 1024, nullptr, (float*)(P + P_PARTO), shm);
        } else if constexpr (layer == 2) {
            { EpiHgrn e{P, (const float*)(p.ws + WS_LBV), p.ws + WS_EB}; gemm_phase(H, D, wmi, D, 5 * D, D, false, shm, e); }
            xcd_barrier(xb);
            PH(6) hgrn_scan_mfma(p, shm);
            xcd_barrier(xb);
            PH(1) headnorm_phase<1>(p, H, (const bf16_t*)(P + P_HOB), (const bf16_t*)(P + P_HG), p.in[19], 0.f, 1.f);
            xcd_barrier(xb);
            gemm_resid<4>(H, wmo, D, true, p.out, p.out, mod + 2 * 1024, nullptr, (float*)(P + P_PARTO), shm);
        } else {
            { bf16_t* QK = (bf16_t*)(P + P_GQK); bf16_t* Vt = (bf16_t*)(P + P_GVT); const int n1 = 72 * 5, n2 = NB * 9;
              gemm_loop(n1 + n2, D, shm,
                  [&](int L) { if (L < n1) { int pm, pn; tile_map(L, 72, 5, pm, pn); return Tile{H, wmi, D, D, D, pm * 256, pn * 256}; }
                               const int v = L - n1, b = v / 9, pn = v % 9; return Tile{wmi + (size_t)1280 * D, H + (size_t)b * LT * D, D, D, D, 0, pn * 256}; },
                  [&](int L, const AccT& acc, int brow, int bcol, int wr, int wc, int fr, int fq) {
                      if (L < n1) { EpiBf16 e{QK, (size_t)1280}; e(acc, brow, bcol, wr, wc, fr, fq); }
                      else { EpiBf16 e{Vt + (size_t)((L - n1) / 9) * 256 * LT, (size_t)LT}; e(acc, brow, bcol, wr, wc, fr, fq); } }); }
            xcd_barrier(xb);
            PH(3) qknorm_phase<64>((bf16_t*)(P + P_GQK), 1280, p.in[23], 0, (const f32x2*)(p.ws + WS_ROPEG));
            xcd_barrier(xb);
            PH(5) attn_phase<128, 1>((const bf16_t*)(P + P_GQK), 1280, (const bf16_t*)(P + P_GVT), 256, H, D, 8, true, p.in[22], (const f32x2*)(p.ws + WS_ROPEG), 0.08838834764831845f * 1.4426950408889634f, shm);
            xcd_barrier(xb);
            gemm_resid<4>(H, wmo, D, false, p.out, p.out, mod + 2 * 1024, nullptr, (float*)(P + P_PARTO), shm);
        }
        xcd_barrier(xb);
        PH(1) norm_phase(p, layer, 1, last, last ? nullptr : (const float*)(P + P_PARTO), 4, layer == 0 ? 2 : 0);
        xcd_barrier(xb);
        { EpiSwiglu e{(bf16_t*)(P + P_ACT)}; gemm_phase(H, D, wfi, D, 2 * DFF, D, last, shm, e); }
        xcd_barrier(xb);
        gemm_resid<8>((const bf16_t*)(P + P_ACT), wfo, DFF, !last, p.out, p.out, mod + 5 * 1024, nullptr, (float*)(P + P_PARTF), shm);
        if constexpr (layer < 3) xcd_barrier(xb);
    }

__global__ void __launch_bounds__(NTHR) fwd_megakernel(Params p) {
    extern __shared__ __attribute__((aligned(16))) char shm[];
    cg::grid_group grid = cg::this_grid();
    if (threadIdx.x < 4) ((unsigned*)(shm + 131072))[threadIdx.x] = 0u;
    __syncthreads();
    const XcdBarrier xb = xcd_barrier_post((unsigned*)(p.ws + WS_BAR), (volatile LAS unsigned*)(shm + 131072));
    PH(0) prologue(p, shm);
    if (p.ws == nullptr) grid.sync();
    xcd_barrier(xb);
    PH(0) mod_reduce(p);
    xcd_barrier(xb);
    layer_body<0>(p, xb, shm);
    layer_body<1>(p, xb, shm);
    layer_body<2>(p, xb, shm);
    layer_body<3>(p, xb, shm);
}

extern "C" void kernel_launch(void* const* d_in, const int* in_sizes, int n_in, void* d_out, int out_size, void* d_ws, size_t ws_size, hipStream_t stream) {
    static int grid_blocks = 0;
    if (grid_blocks == 0) {
        if (n_in != 25 || ws_size < WS_END) { fprintf(stderr, "kernel_launch: need 25 inputs and %zu bytes of workspace (got %d, %zu)\n", (size_t)WS_END, n_in, ws_size); grid_blocks = -1; return; }
        int dev = 0, cus = 0, per_cu = 0;
        hipGetDevice(&dev);
        hipDeviceGetAttribute(&cus, hipDeviceAttributeMultiprocessorCount, dev);
        if (hipFuncSetAttribute((const void*)fwd_megakernel, hipFuncAttributeMaxDynamicSharedMemorySize, LDS_BYTES) != hipSuccess) { fprintf(stderr, "kernel_launch: hipFuncSetAttribute failed\n"); grid_blocks = -1; return; }
        if (hipOccupancyMaxActiveBlocksPerMultiprocessor(&per_cu, (const void*)fwd_megakernel, NTHR, LDS_BYTES) != hipSuccess || per_cu < 1) { fprintf(stderr, "kernel_launch: occupancy query says %d blocks/CU\n", per_cu); grid_blocks = -1; return; }
        grid_blocks = cus;
    }
    if (grid_blocks < 0) return;
    if (hipMemsetAsync((char*)d_ws + WS_BAR, 0, 16384, stream) != hipSuccess) { fprintf(stderr, "kernel_launch: memset of barrier words failed\n"); return; }
    Params p{};
    for (int i = 0; i < 25; ++i) p.in[i] = (const float*)d_in[i];
    p.out = (float*)d_out; p.ws = (unsigned char*)d_ws;
    void* args[] = {&p};
    hipError_t e = hipLaunchCooperativeKernel((const void*)fwd_megakernel, dim3(grid_blocks), dim3(NTHR), args, LDS_BYTES, stream);
    if (e != hipSuccess) fprintf(stderr, "cooperative launch failed: %s (grid %d)\n", hipGetErrorString(e), grid_blocks);
}
```

```cpp
#include <hip/hip_runtime.h>
#include <hip/hip_cooperative_groups.h>
#include <cstdint>
#include <cstdio>
namespace cg = cooperative_groups;

#define DI __device__ __forceinline__
#ifndef PHMASK
#define PHMASK 0xFFFF
#endif
#define PH(bit) if ((PHMASK >> (bit)) & 1)
#define OPAQUE_IDS int tx = threadIdx.x; int bx = blockIdx.x; asm volatile("" : "+v"(tx), "+s"(bx));
typedef unsigned short bf16_t;
typedef short bf16x8 __attribute__((ext_vector_type(8)));
typedef short s16x4 __attribute__((ext_vector_type(4)));
typedef float f32x2 __attribute__((ext_vector_type(2)));
typedef float f32x4 __attribute__((ext_vector_type(4)));
typedef float f32x16 __attribute__((ext_vector_type(16)));
typedef unsigned u32x2 __attribute__((ext_vector_type(2)));
typedef unsigned u32x4 __attribute__((ext_vector_type(4)));

constexpr int NB = 8, LC = 256, LL = 2048, LT = 2304, T = NB * LT, D = 1024, DFF = 2816;
constexpr int NTHR = 512;
constexpr int LDS_BYTES = 131072 + 16;
constexpr float EPS = 1e-6f;

constexpr size_t al256(size_t x) { return (x + 255) & ~(size_t)255; }
constexpr size_t WS_CTXRES = 0;
constexpr size_t WS_MOD    = WS_CTXRES + (size_t)NB * LC * D * 4;
constexpr size_t WS_ROPED  = WS_MOD + (size_t)4 * 9 * 6144 * 4;
constexpr size_t WS_ROPEG  = WS_ROPED + (size_t)2048 * 32 * 8;
constexpr size_t WS_LBV    = WS_ROPEG + (size_t)2048 * 64 * 8;
constexpr size_t WS_WFI    = WS_LBV + 2 * 1024 * 4;
constexpr size_t WS_WFO    = WS_WFI + (size_t)5632 * 1024 * 2;
constexpr size_t WS_WMI    = WS_WFO + (size_t)1024 * 2816 * 2;
constexpr size_t WS_WMO    = WS_WMI + (size_t)5120 * 1024 * 2;
constexpr size_t WS_H      = WS_WMO + (size_t)1024 * 1024 * 2;
constexpr size_t WS_P      = WS_H + (size_t)T * D * 2;
constexpr size_t P_PART = 0;
constexpr size_t P_CDT  = P_PART + (size_t)16 * 4 * 9 * 6144 * 4;
constexpr size_t P_WL   = P_CDT + (size_t)2048 * 1024 * 2;
constexpr size_t P_WC   = P_WL + (size_t)2048 * 4096 * 2;
constexpr size_t P_GTL  = P_WC + (size_t)256 * 512 * 2;
constexpr size_t P_GTC  = P_GTL + (size_t)NB * 1024 * 4096 * 2;
constexpr size_t P_YB   = P_GTC + (size_t)NB * 1024 * 512 * 2;
constexpr size_t P_DQK = 0;
constexpr size_t P_DVT = P_DQK + (size_t)T * 2048 * 2;
constexpr size_t P_DO2 = P_DVT + (size_t)NB * 1024 * LT * 2;
constexpr size_t P_HQ  = 0;
constexpr size_t P_HF0 = P_HQ + (size_t)T * D * 2;
constexpr size_t P_HF1 = P_HF0 + (size_t)T * D * 4;
constexpr size_t P_HV  = P_HF1 + (size_t)T * D * 4;
constexpr size_t P_HG  = P_HV + (size_t)T * D * 2;
constexpr size_t P_HOB = P_HG + (size_t)T * D * 2;
constexpr size_t P_HEND = P_HOB + (size_t)T * D * 2;
constexpr size_t P_GQK = 0;
constexpr size_t P_GVT = P_GQK + (size_t)T * 1280 * 2;
constexpr size_t P_ACT = 0;
constexpr size_t P_PARTF = P_ACT + (size_t)T * DFF * 2;
constexpr size_t P_PARTO = 0;
constexpr size_t WS_BAR = WS_P + P_HEND;
constexpr size_t WS_EB  = WS_BAR + 16384;
constexpr size_t WS_END = WS_EB + (size_t)2 * NB * 144 * D * 4;

struct Params {
    const float* in[25];
    float* out;
    unsigned char* ws;
};

DI bf16_t f2bf(float x) { unsigned u = __float_as_uint(x); u += 0x7fffu + ((u >> 16) & 1u); return (bf16_t)(u >> 16); }
DI float bf2f(bf16_t v) { return __uint_as_float(((unsigned)v) << 16); }
typedef __bf16 bf16x2_t __attribute__((ext_vector_type(2)));
DI unsigned pack2(float lo, float hi) { const f32x2 v = (f32x2){lo, hi}; return __builtin_bit_cast(unsigned, __builtin_convertvector(v, bf16x2_t)); }
DI float bflo(unsigned w) { return __uint_as_float(w << 16); }
DI float bfhi(unsigned w) { return __uint_as_float(w & 0xffff0000u); }
DI float silu_f(float x) { return x * __builtin_amdgcn_rcpf(1.f + __expf(-x)); }
DI float sigmoid_f(float x) { return __builtin_amdgcn_rcpf(1.f + __expf(-x)); }
DI float wave_sum(float v) {
    v += __shfl_xor(v, 32); v += __shfl_xor(v, 16); v += __shfl_xor(v, 8); v += __shfl_xor(v, 4); v += __shfl_xor(v, 2); v += __shfl_xor(v, 1);
    return v;
}
DI float* resid_row(const Params& p, int row) {
    const int b = row / LT, pos = row - b * LT;
    return pos < LC ? (float*)(p.ws + WS_CTXRES) + ((size_t)(b * LC + pos)) * D : p.out + ((size_t)(b * LL + pos - LC)) * D;
}
DI int cond_idx(int row) { const int b = row / LT, pos = row - b * LT; return pos < LC ? 8 : b; }

constexpr int BM = 256, BK = 64, HALF = 128, HTB = HALF * BK * 2;
DI int lds_byte(int r, int c) { int st = (r >> 4) * 2 + (c >> 5), rr = r & 15, cc = c & 31, ob = rr * 64 + cc * 2; return st * 1024 + (ob ^ (((ob >> 9) & 1) << 5)); }
DI void stage_rc(int b, int& R, int& C) { int st = b / 1024, sb = b % 1024, swz = sb ^ (((sb >> 9) & 1) << 5); R = (st >> 1) * 16 + swz / 64; C = (st & 1) * 32 + (swz % 64) / 2; }

typedef f32x4 AccT[2][2][4][2];

struct Tile { const bf16_t* A; const bf16_t* Bt; int lda, ldb, K, brow, bcol; };
#define LAS __attribute__((address_space(3)))
template <class Get, class Epi>
DI void gemm_loop(int ntiles, int ld, char* shm, const Get& get, const Epi& epi) {
    int tx = threadIdx.x, bx = blockIdx.x; asm volatile("" : "+v"(tx), "+s"(bx));
    if (!((PHMASK >> 7) & 1)) return;
    LAS unsigned char* lds = (LAS unsigned char*)shm;
    const int tid = tx, wid = __builtin_amdgcn_readfirstlane(tid >> 6), lane = tid & 63, wr = wid >> 2, wc = wid & 3, fr = lane & 15, fq = lane >> 4;
    unsigned voffA[2], voffB[2];
#pragma unroll
    for (int i = 0; i < 2; ++i) { int R, C; stage_rc(tid * 16 + i * 8192, R, C); const int rho = R & 31, Rb = (R & ~31) + 8 * ((rho & 15) >> 2) + 4 * (rho >> 4) + (rho & 3);
        voffA[i] = (unsigned)(R * ld + C) * 2u; voffB[i] = (unsigned)(Rb * ld + C) * 2u; }
    const size_t kstep = (size_t)(BK * 2), hstep = (size_t)HALF * ld * 2;
    const unsigned ldsw = (unsigned)wid * 1024u;
    const int aoff = lds_byte(wr * 64 + fr, fq * 8), boff = lds_byte(wc * 32 + fr, fq * 8);
#define G_SA(b, h) (((b) * 2 + (h)) * HTB)
#define G_SB(b, h) ((4 + (b) * 2 + (h)) * HTB)
#define G_STAGE(bufoff, gbase, voff) do { _Pragma("unroll") for (int _i = 0; _i < 2; ++_i) \
        __builtin_amdgcn_global_load_lds((const unsigned*)((const char*)(gbase) + voff[_i]), (LAS unsigned*)(lds + (bufoff) + ldsw + _i * 8192), 16, 0, 0); } while (0)
#define G_LDA(dst, b, h) do { _Pragma("unroll") for (int m = 0; m < 4; ++m) _Pragma("unroll") for (int k = 0; k < 2; ++k) dst[m][k] = *(const LAS bf16x8*)(lds + G_SA(b, h) + aoff + m * 2048 + k * 1024); } while (0)
#define G_LDB(dst, b, h) do { _Pragma("unroll") for (int n = 0; n < 2; ++n) _Pragma("unroll") for (int k = 0; k < 2; ++k) dst[n][k] = *(const LAS bf16x8*)(lds + G_SB(b, h) + boff + n * 2048 + k * 1024); } while (0)
#define G_MMA(ai, bj, At_, Bt_) do { __builtin_amdgcn_s_setprio(1); _Pragma("unroll") for (int m = 0; m < 4; ++m) _Pragma("unroll") for (int n = 0; n < 2; ++n) _Pragma("unroll") for (int k = 0; k < 2; ++k) \
        acc[ai][bj][m][n] = __builtin_amdgcn_mfma_f32_16x16x32_bf16(Bt_[n][k], At_[m][k], acc[ai][bj][m][n], 0, 0, 0); __builtin_amdgcn_s_setprio(0); } while (0)
#define WAIT_V(n) asm volatile("s_waitcnt vmcnt(" #n ")" ::: "memory")
#define WAIT_L(n) asm volatile("s_waitcnt lgkmcnt(" #n ")" ::: "memory")
#define BAR __builtin_amdgcn_s_barrier()
#define SCHED __builtin_amdgcn_sched_barrier(0)
    int L = bx; if (L >= ntiles) return;
    Tile cur = get(L), nxt = cur;
    AccT acc;
#define G_ZERO _Pragma("unroll") for (int a = 0; a < 2; ++a) _Pragma("unroll") for (int b = 0; b < 2; ++b) _Pragma("unroll") for (int m = 0; m < 4; ++m) _Pragma("unroll") for (int n = 0; n < 2; ++n) acc[a][b][m][n] = (f32x4){0.f, 0.f, 0.f, 0.f}
    G_ZERO;
    bf16x8 At[4][2], B0[2][2], B1[2][2];
    const char* cA = (const char*)cur.A + (size_t)cur.brow * ld * 2; const char* cB = (const char*)cur.Bt + (size_t)cur.bcol * ld * 2;
    G_STAGE(G_SB(0, 0), cB, voffB); G_STAGE(G_SB(0, 1), cB + hstep, voffB); G_STAGE(G_SA(0, 0), cA, voffA); G_STAGE(G_SA(0, 1), cA + hstep, voffA);
    if (wr == 1) BAR;
    WAIT_V(2); BAR;
    G_STAGE(G_SB(1, 0), cB + kstep, voffB); G_STAGE(G_SA(1, 0), cA + kstep, voffA); G_STAGE(G_SB(1, 1), cB + hstep + kstep, voffB);
    WAIT_V(6); BAR;
    for (;;) {
        const int Ln = L + gridDim.x; const bool has_next = Ln < ntiles; if (has_next) nxt = get(Ln);
        const char* nA = has_next ? (const char*)nxt.A + (size_t)nxt.brow * ld * 2 : cA; const char* nB = has_next ? (const char*)nxt.Bt + (size_t)nxt.bcol * ld * 2 : cB;
        const int nt = cur.K / BK;
        for (int t = 0; t < nt; t += 2) {
            const bool last = (t == nt - 2);
            const char* a1 = cA + (size_t)(t + 1) * kstep;
            const char* a2 = last ? nA : cA + (size_t)(t + 2) * kstep; const char* b2 = last ? nB : cB + (size_t)(t + 2) * kstep;
            const char* a3 = a2 + kstep; const char* b3 = b2 + kstep;
            G_LDB(B0, 0, 0); G_LDB(B1, 0, 1); SCHED; G_LDA(At, 0, 0); G_STAGE(G_SA(1, 1), a1 + hstep, voffA);
            WAIT_V(8); WAIT_L(0); BAR; G_MMA(0, 0, At, B0); G_MMA(0, 1, At, B1); BAR; SCHED;
            G_LDA(At, 0, 1); G_STAGE(G_SB(0, 0), b2, voffB); G_STAGE(G_SB(0, 1), b2 + hstep, voffB); G_STAGE(G_SA(0, 0), a2, voffA);
            WAIT_V(8); WAIT_L(0); BAR; G_MMA(1, 0, At, B0); G_MMA(1, 1, At, B1); BAR; SCHED;
            G_LDB(B0, 1, 0); G_LDB(B1, 1, 1); SCHED; G_LDA(At, 1, 0); G_STAGE(G_SA(0, 1), a2 + hstep, voffA);
            WAIT_V(8); WAIT_L(0); BAR; G_MMA(0, 0, At, B0); G_MMA(0, 1, At, B1); BAR; SCHED;
            G_LDA(At, 1, 1); G_STAGE(G_SB(1, 0), b3, voffB); G_STAGE(G_SB(1, 1), b3 + hstep, voffB); G_STAGE(G_SA(1, 0), a3, voffA);
            WAIT_V(8); WAIT_L(0); BAR; G_MMA(1, 0, At, B0); G_MMA(1, 1, At, B1); BAR; SCHED;
        }
        if (wr == 0) BAR;
        { int tx2 = threadIdx.x, brow2 = cur.brow, bcol2 = cur.bcol, Lo = L; asm volatile("" : "+v"(tx2), "+s"(brow2), "+s"(bcol2), "+s"(Lo));
          const int wid2 = tx2 >> 6, lane2 = tx2 & 63; epi(Lo, acc, brow2, bcol2, wid2 >> 2, wid2 & 3, lane2 & 15, lane2 >> 4); }
        if (!has_next) break;
        G_ZERO;
        cur = nxt; cA = nA; cB = nB; L = Ln;
        if (wr == 1) BAR;
    }
    WAIT_V(0);
    BAR;
#undef G_SA
#undef G_SB
#undef G_STAGE
#undef G_LDA
#undef G_LDB
#undef G_MMA
#undef G_ZERO
}
DI void tile_map(int L, int nM, int nN, int& pm, int& pn) {
    const int nwg = nM * nN; int wgid = L;
    { const int q = nwg / 8, r = nwg % 8, xcd = wgid % 8, off = wgid / 8; wgid = (xcd < r ? xcd * (q + 1) : r * (q + 1) + (xcd - r) * q) + off; }
    const int nig = 8 * nN, gid = wgid / nig, fm = gid * 8, gsz = (nM - fm) < 8 ? (nM - fm) : 8;
    pm = fm + ((wgid % nig) % gsz); pn = (wgid % nig) / gsz;
}

#define EPI_LOOP_ROWS _Pragma("unroll") for (int ai = 0; ai < 2; ++ai) _Pragma("unroll") for (int m = 0; m < 4; ++m)
#define EPI_LOOP_BJ _Pragma("unroll") for (int bj = 0; bj < 2; ++bj)
DI u32x4 pack8(const f32x4 a, const f32x4 b) { return (u32x4){pack2(a[0], a[1]), pack2(a[2], a[3]), pack2(b[0], b[1]), pack2(b[2], b[3])}; }

struct EpiBf16 {
    bf16_t* C; size_t ldc;
    DI void operator()(const AccT& acc, int brow, int bcol, int wr, int wc, int fr, int fq) const {
        EPI_LOOP_ROWS { const size_t row = brow + ai * 128 + wr * 64 + m * 16 + fr;
            EPI_LOOP_BJ { const int col = bcol + bj * 128 + wc * 32 + fq * 8; *(u32x4*)(C + row * ldc + col) = pack8(acc[ai][bj][m][0], acc[ai][bj][m][1]); } }
    }
};
struct EpiFnet1 {
    bf16_t* GtL; bf16_t* GtC; int b;
    DI void operator()(const AccT& acc, int brow, int bcol, int wr, int wc, int fr, int fq) const {
        const int cs = brow >= 1024; const bool isctx = bcol < LC;
        EPI_LOOP_ROWS { const int ch = brow + ai * 128 + wr * 64 + m * 16 + fr - cs * 1024;
            bf16_t* dst = isctx ? GtC + ((size_t)(b * 1024 + ch)) * 512 + cs * 256 : GtL + ((size_t)(b * 1024 + ch)) * 4096 + cs * 2048 - LC;
            EPI_LOOP_BJ { const int col = bcol + bj * 128 + wc * 32 + fq * 8; *(u32x4*)(dst + col) = pack8(acc[ai][bj][m][0], acc[ai][bj][m][1]); } }
    }
};
struct EpiResid {
    float* base; const float* src; const float* gate; const float* bias; bool rmw;
    DI void operator()(const AccT& acc, int brow, int bcol, int wr, int wc, int fr, int fq) const {
        EPI_LOOP_BJ { const int col = bcol + bj * 128 + wc * 32 + fq * 8;
            const f32x4 g0 = *(const f32x4*)(gate + col), g1 = *(const f32x4*)(gate + col + 4); f32x4 b0 = (f32x4){0.f, 0.f, 0.f, 0.f}, b1 = b0; if (bias) { b0 = *(const f32x4*)(bias + col); b1 = *(const f32x4*)(bias + col + 4); }
            EPI_LOOP_ROWS { const size_t eo = (size_t)(ai * 128 + wr * 64 + m * 16 + fr) * D + col; float* q = base + eo;
                f32x4 x0 = (f32x4){0.f, 0.f, 0.f, 0.f}, x1 = x0; if (rmw) { x0 = *(const f32x4*)(src + eo); x1 = *(const f32x4*)(src + eo + 4); }
                x0 += g0 * (acc[ai][bj][m][0] + b0); x1 += g1 * (acc[ai][bj][m][1] + b1); *(f32x4*)q = x0; *(f32x4*)(q + 4) = x1; } }
    }
};
struct EpiSwiglu {
    bf16_t* ACT;
    DI void operator()(const AccT& acc, int brow, int bcol, int wr, int wc, int fr, int fq) const {
        const int col = (bcol >> 1) + wc * 32 + fq * 8;
        EPI_LOOP_ROWS { const size_t row = brow + ai * 128 + wr * 64 + m * 16 + fr; f32x4 o[2];
#pragma unroll
            for (int n = 0; n < 2; ++n) { const f32x4 g = acc[ai][0][m][n], u = acc[ai][1][m][n];
#pragma unroll
                for (int j = 0; j < 4; ++j) o[n][j] = silu_f(g[j]) * u[j]; }
            *(u32x4*)(ACT + row * DFF + col) = pack8(o[0], o[1]); }
    }
};
template <int CTRL> DI float dpp_f(float x) { return __int_as_float(__builtin_amdgcn_update_dpp(0, __float_as_int(x), CTRL, 0xF, 0xF, true)); }
struct EpiHgrn {
    unsigned char* P; const float* lbv; unsigned char* ebase;
    DI void operator()(const AccT& acc, int brow, int bcol, int wr, int wc, int fr, int fq) const {
        const int seg = bcol >> 10, cb = bcol & 1023;
        EPI_LOOP_BJ { const int col = cb + bj * 128 + wc * 32 + fq * 8;
            if (seg == 1 || seg == 2) {
                const int dir = seg - 1;
                const f32x4 lb0 = *(const f32x4*)(lbv + dir * 1024 + col), lb1 = *(const f32x4*)(lbv + dir * 1024 + col + 4);
                bf16_t* EK = (bf16_t*)(P + (dir ? P_HF1 : P_HF0)); float* EBp = (float*)(ebase);
                const int lane_ = fq * 16 + fr;
#pragma unroll
                for (int ai = 0; ai < 2; ++ai)
#pragma unroll
                for (int mp = 0; mp < 2; ++mp) {
                    const size_t row0 = brow + ai * 128 + wr * 64 + mp * 32 + fr, row1 = row0 + 16;
                    float fa[8], fb[8], xa[8], xb[8];
#pragma unroll
                    for (int j = 0; j < 4; ++j) { fa[j] = lb0[j] + (1.f - lb0[j]) * sigmoid_f(acc[ai][bj][2 * mp][0][j]); fa[4 + j] = lb1[j] + (1.f - lb1[j]) * sigmoid_f(acc[ai][bj][2 * mp][1][j]);
                                                  fb[j] = lb0[j] + (1.f - lb0[j]) * sigmoid_f(acc[ai][bj][2 * mp + 1][0][j]); fb[4 + j] = lb1[j] + (1.f - lb1[j]) * sigmoid_f(acc[ai][bj][2 * mp + 1][1][j]); }
#pragma unroll
                    for (int j = 0; j < 8; ++j) { float x = __builtin_amdgcn_logf(fa[j]) * 0.6931471805599453f, y = __builtin_amdgcn_logf(fb[j]) * 0.6931471805599453f;
                        if (dir == 0) { x += dpp_f<0x111>(x); x += dpp_f<0x112>(x); x += dpp_f<0x114>(x); x += dpp_f<0x118>(x);
                                        y += dpp_f<0x111>(y); y += dpp_f<0x112>(y); y += dpp_f<0x114>(y); y += dpp_f<0x118>(y);
                                        y += __shfl(x, (lane_ & 48) | 15); }
                        else { x += dpp_f<0x101>(x); x += dpp_f<0x102>(x); x += dpp_f<0x104>(x); x += dpp_f<0x108>(x);
                               y += dpp_f<0x101>(y); y += dpp_f<0x102>(y); y += dpp_f<0x104>(y); y += dpp_f<0x108>(y);
                               x += __shfl(y, lane_ & 48); }
                        xa[j] = x; xb[j] = y; }
                    f32x4 e0, e1, k0, k1;
#pragma unroll
                    for (int j = 0; j < 4; ++j) { e0[j] = __expf(xa[j]); e1[j] = __expf(xa[4 + j]); k0[j] = (1.f - fa[j]) * __expf(fminf(-xa[j], 80.f)); k1[j] = (1.f - fa[4 + j]) * __expf(fminf(-xa[4 + j], 80.f)); }
                    *(u32x4*)(EK + row0 * 2048 + col) = pack8(e0, e1); *(u32x4*)(EK + row0 * 2048 + 1024 + col) = pack8(k0, k1);
                    if (dir == 1 && fr == 0) { const int b_ = (int)(row0 / LT), pos = (int)(row0 - (size_t)b_ * LT); const int tau = pos < LC ? LC - 1 - pos : LT + LC - 1 - pos;
                        float* ep = EBp + ((size_t)(NB + b_) * 72 + (tau >> 5)) * D + col; *(f32x4*)ep = e0; *(f32x4*)(ep + 4) = e1; }
#pragma unroll
                    for (int j = 0; j < 4; ++j) { e0[j] = __expf(xb[j]); e1[j] = __expf(xb[4 + j]); k0[j] = (1.f - fb[j]) * __expf(fminf(-xb[j], 80.f)); k1[j] = (1.f - fb[4 + j]) * __expf(fminf(-xb[4 + j], 80.f)); }
                    *(u32x4*)(EK + row1 * 2048 + col) = pack8(e0, e1); *(u32x4*)(EK + row1 * 2048 + 1024 + col) = pack8(k0, k1);
                    if (dir == 0 && fr == 15) { const int b_ = (int)(row1 / LT), pos = (int)(row1 - (size_t)b_ * LT);
                        float* ep = EBp + ((size_t)b_ * 72 + (pos >> 5)) * D + col; *(f32x4*)ep = e0; *(f32x4*)(ep + 4) = e1; }
                }
            } else {
                bf16_t* C = (bf16_t*)(P + (seg == 0 ? P_HQ : (seg == 3 ? P_HV : P_HG)));
                EPI_LOOP_ROWS { const size_t row = brow + ai * 128 + wr * 64 + m * 16 + fr; f32x4 v0 = acc[ai][bj][m][0], v1 = acc[ai][bj][m][1];
                    if (seg == 0) {
#pragma unroll
                        for (int j = 0; j < 4; ++j) { v0[j] = silu_f(v0[j]); v1[j] = silu_f(v1[j]); } }
                    *(u32x4*)(C + row * D + col) = pack8(v0, v1); }
            } }
    }
};

template <class Epi>
DI void gemm_phase(const bf16_t* A, int lda, const bf16_t* Bt, int ldb, int N, int K, bool lat_only, char* shm, const Epi& epi) {
    const int nM = lat_only ? 64 : 72, nN = N / BM;
    gemm_loop(nM * nN, lda, shm, [&](int L) { int pm, pn; tile_map(L, nM, nN, pm, pn); if (lat_only) pm = (pm >> 3) * 9 + 1 + (pm & 7); return Tile{A, Bt, lda, ldb, K, pm * BM, pn * BM}; },
              [&](int, const AccT& acc, int brow, int bcol, int wr, int wc, int fr, int fq) { epi(acc, brow, bcol, wr, wc, fr, fq); });
}
template <int S>
DI void gemm_resid(const bf16_t* A, const bf16_t* Bt, int K, bool with_ctx, float* out, const float* xin, const float* gate, const float* bias, float* part, char* shm) {
    const int U = K / 128, ub = U / S, ur = U % S;
    gemm_loop(256 + (with_ctx ? 32 * S : 0), K, shm,
              [&](int L) { if (L < 256) { int pm, pn; tile_map(L, 64, 4, pm, pn); pm = (pm >> 3) * 9 + 1 + (pm & 7); return Tile{A, Bt, K, K, K, pm * BM, pn * BM}; }
                           const int v = L - 256, s = v % S, tt = v / S, b = tt >> 2, pn = tt & 3; const int u0 = s * ub + (s < ur ? s : ur), nu = ub + (s < ur ? 1 : 0);
                           return Tile{A + u0 * 128, Bt + u0 * 128, K, K, nu * 128, b * LT, pn * BM}; },
              [&](int L, const AccT& acc, int brow, int bcol, int wr, int wc, int fr, int fq) {
                  const int b = brow / LT; EpiResid e;
                  if (L < 256) { const size_t ro = ((size_t)(b * LL + (brow - b * LT) - LC)) * D; e.base = out + ro; e.src = xin + ro; e.gate = gate + (size_t)b * 6144; e.bias = bias; e.rmw = true; }
                  else { const int s = (L - 256) % S; e.base = part + ((size_t)s * NB * LC + b * LC) * D; e.src = e.base; e.gate = gate + (size_t)8 * 6144; e.bias = s == 0 ? bias : nullptr; e.rmw = false; }
                  e(acc, brow, bcol, wr, wc, fr, fq); });
}

struct ConvJob { const float* src; bf16_t* dst; int ldsrc, K, N, mode; };
DI void conv_jobs(const ConvJob j0, const ConvJob j1, const ConvJob j2, const ConvJob j3, char* shm) {
    OPAQUE_IDS
    float* tile = (float*)shm;
    const int tid = tx;
    const int c1 = (j0.K / 64) * (j0.N / 256), c2 = c1 + (j1.K / 64) * (j1.N / 256), c3 = c2 + (j2.K / 64) * (j2.N / 256), c4 = c3 + (j3.K / 64) * (j3.N / 256);
    for (int L = bx; L < c4; L += gridDim.x) {
        const float* __restrict__ src = j0.src; bf16_t* __restrict__ dst = j0.dst; int ldsrc = j0.ldsrc, K = j0.K, mode = j0.mode, base = 0;
        if (L >= c1) { src = j1.src; dst = j1.dst; ldsrc = j1.ldsrc; K = j1.K; mode = j1.mode; base = c1; }
        if (L >= c2) { src = j2.src; dst = j2.dst; ldsrc = j2.ldsrc; K = j2.K; mode = j2.mode; base = c2; }
        if (L >= c3) { src = j3.src; dst = j3.dst; ldsrc = j3.ldsrc; K = j3.K; mode = j3.mode; base = c3; }
        const int nk = K / 64, Ll = L - base, tk = Ll % nk, ts = Ll / nk, n0 = ts * 256;
        __syncthreads();
        f32x4 v[8];
#pragma unroll
        for (int i = 0; i < 8; ++i) { const int e = tid + i * NTHR, kk = e >> 6, n4 = (e & 63) * 4;
            const int scol = mode == 1 ? ((n4 >> 7) ? 2816 + ts * 128 + (n4 & 127) : ts * 128 + n4) : n0 + n4;
            v[i] = *(const f32x4*)(src + (size_t)(tk * 64 + kk) * ldsrc + scol); }
#pragma unroll
        for (int i = 0; i < 8; ++i) { const int e = tid + i * NTHR, kk = e >> 6, n4 = (e & 63) * 4; *(f32x4*)(tile + kk * 260 + (n4 ^ (((kk >> 3) & 7) << 3))) = v[i]; }
        __syncthreads();
#pragma unroll
        for (int i = 0; i < 4; ++i) { const int n = (tid >> 3) + 64 * i, m = tid & 7, kc = m * 8; const float* tp = tile + kc * 260 + (n ^ (m << 3)); u32x4 w;
            w.x = pack2(tp[0], tp[260]); w.y = pack2(tp[2 * 260], tp[3 * 260]); w.z = pack2(tp[4 * 260], tp[5 * 260]); w.w = pack2(tp[6 * 260], tp[7 * 260]);
            *(u32x4*)(dst + (size_t)(n0 + n) * K + tk * 64 + kc) = w; }
    }
    __syncthreads();
}
DI void convert_layer(const Params& p, int i, char* shm) {
    bf16_t* wfi = (bf16_t*)(p.ws + WS_WFI); bf16_t* wfo = (bf16_t*)(p.ws + WS_WFO); bf16_t* wmi = (bf16_t*)(p.ws + WS_WMI); bf16_t* wmo = (bf16_t*)(p.ws + WS_WMO);
    const ConvJob jf1{p.in[7] + (size_t)i * D * 2 * DFF, wfi, 2 * DFF, D, 2 * DFF, 1}, jf2{p.in[8] + (size_t)i * DFF * D, wfo, D, DFF, D, 0};
    const float* msrc = i == 1 ? p.in[11] : (i == 2 ? p.in[17] : p.in[21]); const int mN = i == 0 ? 0 : (i == 1 ? 3 * D : (i == 2 ? 5 * D : 1536));
    const float* osrc = i == 0 ? p.in[9] : (i == 1 ? p.in[16] : (i == 2 ? p.in[20] : p.in[24]));
    const ConvJob jm{msrc, wmi, mN, D, mN, 0}, jo{osrc, wmo, D, D, D, 0};
    conv_jobs(jf1, jf2, jm, jo, shm);
}

DI void prologue(const Params& p, char* shm) {
    OPAQUE_IDS
    const size_t gtid = (size_t)bx * NTHR + tx, gn = (size_t)gridDim.x * NTHR;
    { float* cond = (float*)shm;
      float* part = (float*)(p.ws + WS_P + P_PART);
      for (int it = bx; it < 4 * 16 * 12; it += gridDim.x) {
          const int cb = it % 12, ks = (it / 12) % 16, Ly = it / (12 * 16);
          __syncthreads();
          for (int e = tx; e < 9 * 64; e += NTHR) { const int ci = e >> 6, k = ks * 64 + (e & 63); const float v = ci < 8 ? p.in[1][ci * D + k] : p.in[3][k]; cond[e] = silu_f(v); }
          __syncthreads();
          const int col = cb * 512 + tx; const float* w = p.in[4] + ((size_t)Ly * D + ks * 64) * 6144 + col;
          float a[9];
#pragma unroll
          for (int c = 0; c < 9; ++c) a[c] = 0.f;
          for (int k = 0; k < 64; ++k) { const float wv = w[(size_t)k * 6144];
#pragma unroll
              for (int c = 0; c < 9; ++c) a[c] += cond[c * 64 + k] * wv; }
#pragma unroll
          for (int c = 0; c < 9; ++c) part[(((size_t)ks * 4 + Ly) * 9 + c) * 6144 + col] = a[c];
      }
      __syncthreads(); }
    { f32x2* rd = (f32x2*)(p.ws + WS_ROPED); f32x2* rg = (f32x2*)(p.ws + WS_ROPEG);
      for (size_t i = gtid; i < (size_t)2048 * 32; i += gn) { const int pos = (int)(i >> 5), pp = (int)(i & 31); const int j = pp & 15; const float inv = exp2f(-(float)j * (13.287712379549449f / 16.f));
          const float ang = (float)(pp < 16 ? (pos >> 6) : (pos & 63)) * inv; float s, c; sincosf(ang, &s, &c); rd[i] = (f32x2){c, s}; }
      for (size_t i = gtid; i < (size_t)2048 * 64; i += gn) { const int pos = (int)(i >> 6), pp = (int)(i & 63); const int j = pp & 31; const float inv = exp2f(-(float)j * (13.287712379549449f / 32.f));
          const float ang = (float)(pp < 32 ? (pos >> 6) : (pos & 63)) * inv; float s, c; sincosf(ang, &s, &c); rg[i] = (f32x2){c, s}; } }
    { float* lbv = (float*)(p.ws + WS_LBV); const float* lbp = p.in[18];
      for (size_t i = gtid; i < 2048; i += gn) { const int d = (int)(i >> 10), c = (int)(i & 1023); const float* q = lbp + (size_t)d * 4 * 1024 + c;
          const float v0 = q[0], v1 = q[1024], v2 = q[2048], v3 = q[3072]; const float mx = fmaxf(fmaxf(v0, v1), fmaxf(v2, v3));
          const float e0 = expf(v0 - mx), e1 = expf(v1 - mx), e2 = expf(v2 - mx), e3 = expf(v3 - mx); lbv[i] = (e1 + e2) / (e0 + e1 + e2 + e3); } }
    { bf16_t* cdt = (bf16_t*)(p.ws + WS_P + P_CDT); bf16_t* wl = (bf16_t*)(p.ws + WS_P + P_WL); bf16_t* wc = (bf16_t*)(p.ws + WS_P + P_WC);
      const float sc128 = 0.08838834764831845f, sc2048 = 0.022097086912079608f, sc256 = 0.0625f;
      for (size_t i = gtid; i < (size_t)2048 * 1024; i += gn) { const int m = (int)(i >> 10), k = (int)(i & 1023); const int cs = m >> 10, ch = m & 1023; float v = 0.f;
          if ((ch >> 7) == (k >> 7)) { const int e = ((ch & 127) * (k & 127)) & 127; const float a = (float)e * (2.f / 128.f); v = (cs ? sinpif(a) : cospif(a)) * sc128; }
          cdt[i] = f2bf(v); }
      for (size_t i = gtid; i < (size_t)2048 * 4096; i += gn) { const int kf = (int)(i >> 12), kk = (int)(i & 4095); const int cs = kk >> 11, t = kk & 2047; const int e = (kf * t) & 2047;
          const float a = (float)e * (2.f / 2048.f); wl[i] = f2bf((cs ? -sinpif(a) : cospif(a)) * sc2048); }
      for (size_t i = gtid; i < (size_t)256 * 512; i += gn) { const int kf = (int)(i >> 9), kk = (int)(i & 511); const int cs = kk >> 8, t = kk & 255; const int e = (kf * t) & 255;
          const float a = (float)e * (2.f / 256.f); wc[i] = f2bf((cs ? -sinpif(a) : cospif(a)) * sc256); } }
    convert_layer(p, 0, shm);
}
DI void mod_reduce(const Params& p) {
    OPAQUE_IDS
    const size_t gtid = (size_t)bx * NTHR + tx, gn = (size_t)gridDim.x * NTHR;
    const float* part = (const float*)(p.ws + WS_P + P_PART); float* mod = (float*)(p.ws + WS_MOD);
    for (size_t i = gtid; i < (size_t)4 * 9 * 6144; i += gn) { const int col = (int)(i % 6144), Ly = (int)(i / (9 * 6144));
        float a = p.in[5][(size_t)Ly * 6144 + col];
        for (int ks = 0; ks < 16; ++ks) a += part[(size_t)ks * 4 * 9 * 6144 + i];
        mod[i] = a; }
}

DI void norm_phase(const Params& p, int layer, int which, bool lat_only, const float* __restrict__ part, int npart, int srcmode) {
    OPAQUE_IDS
    const int lane = tx & 63, gw = bx * 8 + (tx >> 6);
    const float* gain = p.in[6] + ((size_t)layer * 2 + which) * D; const float* mod = (const float*)(p.ws + WS_MOD) + (size_t)layer * 9 * 6144;
    bf16_t* H = (bf16_t*)(p.ws + WS_H);
    f32x4 gm[4], sh[4]; int cur_ci = -1;
    const int nw = gridDim.x * 8;
    for (int vw = gw; vw < NB * 256; vw += nw)
    for (int i0 = 0; i0 < 9; i0 += 3) {
        const int r0 = (vw >> 8) * LT + (vw & 255) + 256 * i0;
        f32x4 v[3][4]; float ss[3]; bool ok[3];
#pragma unroll
        for (int q = 0; q < 3; ++q) {
            const int row = r0 + 256 * q; const int b = row / LT, pos = row - b * LT;
            ok[q] = !(lat_only && pos < LC); ss[q] = 0.f;
            if (ok[q]) {
                float* x = resid_row(p, row);
                const float* xs = (srcmode == 1 || (srcmode == 2 && pos < LC)) ? (pos < LC ? p.in[2] + ((size_t)(b * LC + pos)) * D : p.in[0] + ((size_t)(b * LL + pos - LC)) * D) : x;
#pragma unroll
                for (int j = 0; j < 4; ++j) v[q][j] = *(const f32x4*)(xs + j * 256 + lane * 4);
                if (part != nullptr && pos < LC) {
                    f32x4 a[4];
#pragma unroll
                    for (int j = 0; j < 4; ++j) a[j] = (f32x4){0.f, 0.f, 0.f, 0.f};
                    const float* pp = part + (size_t)(b * LC + pos) * D + lane * 4;
                    for (int s = 0; s < npart; ++s) {
#pragma unroll
                        for (int j = 0; j < 4; ++j) a[j] += *(const f32x4*)(pp + (size_t)s * NB * LC * D + j * 256); }
#pragma unroll
                    for (int j = 0; j < 4; ++j) { v[q][j] += a[j]; *(f32x4*)(x + j * 256 + lane * 4) = v[q][j]; }
                }
#pragma unroll
                for (int j = 0; j < 4; ++j) ss[q] += v[q][j][0] * v[q][j][0] + v[q][j][1] * v[q][j][1] + v[q][j][2] * v[q][j][2] + v[q][j][3] * v[q][j][3];
            }
        }
        ss[0] = wave_sum(ss[0]); ss[1] = wave_sum(ss[1]); ss[2] = wave_sum(ss[2]);
#pragma unroll
        for (int q = 0; q < 3; ++q) {
            if (!ok[q]) continue;
            const int row = r0 + 256 * q; const int ci = cond_idx(row);
            if (ci != cur_ci) { cur_ci = ci; const float* mo = mod + (size_t)ci * 6144 + which * 3072;
#pragma unroll
                for (int j = 0; j < 4; ++j) { const int col = j * 256 + lane * 4; gm[j] = *(const f32x4*)(gain + col) * (1.f + *(const f32x4*)(mo + 1024 + col)); sh[j] = *(const f32x4*)(mo + col); } }
            const float r = rsqrtf(ss[q] * (1.f / 1024.f) + EPS);
#pragma unroll
            for (int j = 0; j < 4; ++j) { const int col = j * 256 + lane * 4; const f32x4 y = v[q][j] * r * gm[j] + sh[j];
                *(u32x2*)(H + (size_t)row * D + col) = (u32x2){pack2(y[0], y[1]), pack2(y[2], y[3])}; }
        }
    }
}

template <int HS>
DI void qknorm_phase(bf16_t* QK, int RL, const float* kgain, int gain_mod, const f32x2* rope) {
    OPAQUE_IDS
    const int lane = tx & 63, gw = bx * 8 + (tx >> 6), nw = gridDim.x * 8;
    const int lpr = (RL - 1024) / HS, rpw = 64 / lpr, rsub = lane / lpr, kl = lane - rsub * lpr, seg = kl >> 1, half = kl & 1;
    const float* gn = kgain + (gain_mod ? (seg % gain_mod) * 2 * HS : 0) + half * HS;
    for (int row0 = gw * rpw; row0 < T; row0 += nw * rpw) {
        const int row = row0 + rsub; const bool act = row < T; const int rowc = act ? row : T - 1;
        const int b = rowc / LT, pos = rowc - b * LT;
        float x[HS]; float ss = 0.f;
        bf16_t* ptr = QK + (size_t)rowc * RL + 1024 + kl * HS;
#pragma unroll
        for (int c = 0; c < HS / 8; ++c) { const u32x4 w = *(const u32x4*)(ptr + c * 8);
            x[c * 8 + 0] = bflo(w.x); x[c * 8 + 1] = bfhi(w.x); x[c * 8 + 2] = bflo(w.y); x[c * 8 + 3] = bfhi(w.y);
            x[c * 8 + 4] = bflo(w.z); x[c * 8 + 5] = bfhi(w.z); x[c * 8 + 6] = bflo(w.w); x[c * 8 + 7] = bfhi(w.w); }
#pragma unroll
        for (int e = 0; e < HS; ++e) ss += x[e] * x[e];
        ss += dpp_f<0xB1>(ss);
        const float r = rsqrtf(ss * (1.f / (2 * HS)) + EPS);
        const bool lat = pos >= LC; const f32x2* rp = rope + (size_t)(lat ? pos - LC : 0) * HS;
#pragma unroll
        for (int e = 0; e < HS; ++e) {
            float v = x[e] * r * gn[e];
            const float o = dpp_f<0xB1>(v);
            if (lat) { const f32x2 cs = rp[e]; v = half ? (o * cs[1] + v * cs[0]) : (v * cs[0] - o * cs[1]); }
            x[e] = v;
        }
        if (act) {
#pragma unroll
            for (int c = 0; c < HS / 8; ++c) { u32x4 w; w.x = pack2(x[c * 8], x[c * 8 + 1]); w.y = pack2(x[c * 8 + 2], x[c * 8 + 3]); w.z = pack2(x[c * 8 + 4], x[c * 8 + 5]); w.w = pack2(x[c * 8 + 6], x[c * 8 + 7]);
                *(u32x4*)(ptr + c * 8) = w; }
        }
    }
}
DI float half_swap_max(float x) { const unsigned u = __float_as_uint(x); const auto r = __builtin_amdgcn_permlane32_swap(u, u, false, false); return fmaxf(__uint_as_float(r[0]), __uint_as_float(r[1])); }
DI float half_swap_sum(float x) { const unsigned u = __float_as_uint(x); const auto r = __builtin_amdgcn_permlane32_swap(u, u, false, false); return __uint_as_float(r[0]) + __uint_as_float(r[1]); }
#define MFMA32(a, b, c) __builtin_amdgcn_mfma_f32_32x32x16_bf16((a), (b), (c), 0, 0, 0)
template <int DQK, int MODE>
DI void attn_phase(const bf16_t* __restrict__ QK, int ldq, const bf16_t* __restrict__ Vt, int VC, bf16_t* __restrict__ O, int ldo, int nhu, bool skip_ctx, const float* __restrict__ qgain, const f32x2* __restrict__ rope, float qscale, char* shm) {
    OPAQUE_IDS
    constexpr int KS = DQK * 2 + 16, VS = 144, KCH = DQK / 8, NKC = 64 * KCH / NTHR;
    constexpr int BUFB = 64 * KS + 128 * VS;
    char* Kl = shm; char* Vl = shm + 64 * KS;
    const int tid = tx, w = tid >> 6, lane = tid & 63, r = lane & 31, h = lane >> 5;
    const int nlat = NB * nhu * 8, nunits = nlat + (skip_ctx ? 0 : NB * nhu);
    for (int u = bx; u < nunits; u += gridDim.x) {
        int qt, hu, b;
        if (u < nlat) { qt = 1 + (u & 7); hu = (u >> 3) % nhu; b = (u >> 3) / nhu; } else { const int v = u - nlat; qt = 0; hu = v % nhu; b = v / nhu; }
        const int qoff = hu * DQK, koff = 1024 + (MODE == 0 ? hu * 64 : (hu >> 2) * 128), voff = (MODE == 0 ? (hu >> 1) : (hu >> 2)) * 128, ooff = hu * 128;
        const int nkt = qt == 0 ? 4 : 36;
        const size_t qrow = (size_t)b * LT + qt * 256 + w * 32 + r;
        bf16x8 qf[DQK / 16];
#pragma unroll
        for (int ks = 0; ks < DQK / 16; ++ks) qf[ks] = *(const bf16x8*)(QK + qrow * ldq + qoff + ks * 16 + h * 8);
        {
            float ss = 0.f;
#pragma unroll
            for (int ks = 0; ks < DQK / 16; ++ks) { const u32x4 wq = __builtin_bit_cast(u32x4, qf[ks]);
                const float a0 = bflo(wq.x), a1 = bfhi(wq.x), a2 = bflo(wq.y), a3 = bfhi(wq.y), a4 = bflo(wq.z), a5 = bfhi(wq.z), a6 = bflo(wq.w), a7 = bfhi(wq.w);
                ss += a0 * a0 + a1 * a1 + a2 * a2 + a3 * a3 + a4 * a4 + a5 * a5 + a6 * a6 + a7 * a7; }
            ss += __shfl_xor(ss, 32);
            const float rr = rsqrtf(ss * (1.f / DQK) + EPS) * qscale; int go = (MODE == 0 ? (hu & 1) * 64 : 0) + h * 8; asm volatile("" : "+v"(go));
            const float* gq = qgain + go; const f32x2* rp = rope + (size_t)((qt > 0 ? qt - 1 : 0) * 256 + w * 32 + r) * (DQK / 2) + h * 8;
#pragma unroll
            for (int ks = 0; ks < DQK / 32; ++ks) {
                const u32x4 wa = __builtin_bit_cast(u32x4, qf[ks]), wb = __builtin_bit_cast(u32x4, qf[ks + DQK / 32]);
                float xa[8] = {bflo(wa.x), bfhi(wa.x), bflo(wa.y), bfhi(wa.y), bflo(wa.z), bfhi(wa.z), bflo(wa.w), bfhi(wa.w)};
                float xb[8] = {bflo(wb.x), bfhi(wb.x), bflo(wb.y), bfhi(wb.y), bflo(wb.z), bfhi(wb.z), bflo(wb.w), bfhi(wb.w)};
#pragma unroll
                for (int j = 0; j < 8; ++j) { float x1 = xa[j] * rr * gq[ks * 16 + j], x2 = xb[j] * rr * gq[(ks + DQK / 32) * 16 + j];
                    if (qt > 0) { const f32x2 cs = rp[ks * 16 + j]; const float y1 = x1 * cs[0] - x2 * cs[1], y2 = x1 * cs[1] + x2 * cs[0]; x1 = y1; x2 = y2; }
                    xa[j] = x1; xb[j] = x2; }
                qf[ks] = __builtin_bit_cast(bf16x8, (u32x4){pack2(xa[0], xa[1]), pack2(xa[2], xa[3]), pack2(xa[4], xa[5]), pack2(xa[6], xa[7])});
                qf[ks + DQK / 32] = __builtin_bit_cast(bf16x8, (u32x4){pack2(xb[0], xb[1]), pack2(xb[2], xb[3]), pack2(xb[4], xb[5]), pack2(xb[6], xb[7])});
            }
        }
        f32x16 oacc[4];
#pragma unroll
        for (int t = 0; t < 4; ++t)
#pragma unroll
            for (int i = 0; i < 16; ++i) oacc[t][i] = 0.f;
        float mrun = -1e30f, lsum = 0.f;
        const bf16_t* kbase = QK + (size_t)b * LT * ldq + koff; const bf16_t* vbase = Vt + ((size_t)b * VC + voff) * LT;
        u32x4 kreg[NKC], vreg[2];
#define ATT_LOAD(kt) do { _Pragma("unroll") for (int i = 0; i < NKC; ++i) { const int c = tid + i * NTHR, key = c / KCH, part = c % KCH; \
                kreg[i] = *(const u32x4*)(kbase + (size_t)((kt) * 64 + key) * ldq + part * 8); } \
            _Pragma("unroll") for (int i = 0; i < 2; ++i) { const int c = tid + i * NTHR, dv = c >> 3, part = c & 7; \
                vreg[i] = *(const u32x4*)(vbase + (size_t)dv * LT + (kt) * 64 + part * 8); } } while (0)
        ATT_LOAD(0);
#define ATT_STORE(buf) do { char* Kw = Kl + (buf) * BUFB; char* Vw = Vl + (buf) * BUFB; \
            _Pragma("unroll") for (int i = 0; i < NKC; ++i) { const int c = tid + i * NTHR, key = c / KCH, part = c % KCH; *(u32x4*)(Kw + key * KS + part * 16) = kreg[i]; } \
            _Pragma("unroll") for (int i = 0; i < 2; ++i) { const int c = tid + i * NTHR, dv = c >> 3, part = c & 7; char* vp_ = Vw + dv * VS + (part >> 1) * 32 + (part & 1) * 8; \
                *(u32x2*)(vp_) = (u32x2){vreg[i].x, vreg[i].y}; *(u32x2*)(vp_ + 16) = (u32x2){vreg[i].z, vreg[i].w}; } } while (0)
        __syncthreads();
        ATT_STORE(0);
        __syncthreads();
        for (int kt = 0; kt < nkt; ++kt) {
            const char* Kc = Kl + (kt & 1) * BUFB; const char* Vc = Vl + (kt & 1) * BUFB;
            if (kt + 1 < nkt) ATT_LOAD(kt + 1);
            f32x16 st0, st1;
#pragma unroll
            for (int i = 0; i < 16; ++i) { st0[i] = 0.f; st1[i] = 0.f; }
#pragma unroll
            for (int ks = 0; ks < DQK / 16; ++ks) {
                const bf16x8 a0 = *(const bf16x8*)(Kc + r * KS + ks * 32 + h * 16), a1 = *(const bf16x8*)(Kc + (32 + r) * KS + ks * 32 + h * 16);
                st0 = MFMA32(a0, qf[ks], st0); st1 = MFMA32(a1, qf[ks], st1);
            }
            float mx = st0[0];
#pragma unroll
            for (int i = 0; i < 16; ++i) mx = __builtin_fmaxf(__builtin_fmaxf(mx, st0[i]), st1[i]);
            mx = half_swap_max(mx);
            if (__any(mx > mrun + 8.f)) {
                const float mnew = fmaxf(mrun, mx), alpha = __builtin_amdgcn_exp2f(mrun - mnew); mrun = mnew; lsum *= alpha;
#pragma unroll
                for (int t = 0; t < 4; ++t)
#pragma unroll
                    for (int i = 0; i < 16; ++i) oacc[t][i] *= alpha;
            }
            { const f32x2 m2 = (f32x2){mrun, mrun}; f32x2 ps2 = (f32x2){0.f, 0.f};
#pragma unroll
              for (int i = 0; i < 16; i += 2) {
                  f32x2 a = (f32x2){st0[i], st0[i + 1]} - m2, c = (f32x2){st1[i], st1[i + 1]} - m2;
                  a[0] = __builtin_amdgcn_exp2f(a[0]); a[1] = __builtin_amdgcn_exp2f(a[1]); c[0] = __builtin_amdgcn_exp2f(c[0]); c[1] = __builtin_amdgcn_exp2f(c[1]);
                  ps2 += a; ps2 += c; st0[i] = a[0]; st0[i + 1] = a[1]; st1[i] = c[0]; st1[i + 1] = c[1]; }
              lsum += ps2[0] + ps2[1]; }
#pragma unroll
            for (int kb = 0; kb < 2; ++kb)
#pragma unroll
                for (int s = 0; s < 2; ++s) {
                    u32x4 pw;
                    if (kb == 0) { pw.x = pack2(st0[8 * s], st0[8 * s + 1]); pw.y = pack2(st0[8 * s + 2], st0[8 * s + 3]); pw.z = pack2(st0[8 * s + 4], st0[8 * s + 5]); pw.w = pack2(st0[8 * s + 6], st0[8 * s + 7]); }
                    else { pw.x = pack2(st1[8 * s], st1[8 * s + 1]); pw.y = pack2(st1[8 * s + 2], st1[8 * s + 3]); pw.z = pack2(st1[8 * s + 4], st1[8 * s + 5]); pw.w = pack2(st1[8 * s + 6], st1[8 * s + 7]); }
                    const bf16x8 pb = __builtin_bit_cast(bf16x8, pw);
#pragma unroll
                    for (int t = 0; t < 4; ++t) {
                        const bf16x8 a = *(const bf16x8*)(Vc + (32 * t + r) * VS + (kb * 2 + s) * 32 + h * 16);
                        oacc[t] = MFMA32(a, pb, oacc[t]);
                    }
                }
            if (kt + 1 < nkt) ATT_STORE((kt + 1) & 1);
            __syncthreads();
        }
#undef ATT_STORE
#undef ATT_LOAD
        const float l = half_swap_sum(lsum), inv = 1.f / l;
        bf16_t* op = O + qrow * ldo + ooff;
#pragma unroll
        for (int t = 0; t < 4; ++t)
#pragma unroll
            for (int g = 0; g < 4; g += 2) {
                const unsigned ax = pack2(oacc[t][4 * g] * inv, oacc[t][4 * g + 1] * inv), ay = pack2(oacc[t][4 * g + 2] * inv, oacc[t][4 * g + 3] * inv);
                const unsigned bx_ = pack2(oacc[t][4 * g + 4] * inv, oacc[t][4 * g + 5] * inv), by_ = pack2(oacc[t][4 * g + 6] * inv, oacc[t][4 * g + 7] * inv);
                const auto sx = __builtin_amdgcn_permlane32_swap(ax, bx_, false, false); const auto sy = __builtin_amdgcn_permlane32_swap(ay, by_, false, false);
                *(u32x4*)(op + 32 * t + 8 * (g + h)) = (u32x4){sx[0], sy[0], sx[1], sy[1]}; }
    }
    __syncthreads();
}

template <int MODE>
DI void headnorm_phase(const Params& p, const bf16_t* __restrict__ A0, const bf16_t* __restrict__ A1, const bf16_t* __restrict__ G, const float* gain, float lam, float outscale) {
    OPAQUE_IDS
    const int lane = tx & 63, gw = bx * 8 + (tx >> 6), nw = gridDim.x * 8;
    bf16_t* H = (bf16_t*)(p.ws + WS_H); const int hh = lane >> 3, d0 = (lane & 7) * 16;
    for (int row = gw; row < T; row += nw) {
        float x[16];
#pragma unroll
        for (int c = 0; c < 2; ++c) {
            u32x4 a, b2;
            if (MODE == 0) { a = *(const u32x4*)(A0 + (size_t)row * 2048 + hh * 256 + d0 + c * 8); b2 = *(const u32x4*)(A0 + (size_t)row * 2048 + hh * 256 + 128 + d0 + c * 8); }
            else { a = *(const u32x4*)(A0 + (size_t)row * D + hh * 128 + d0 + c * 8); b2 = *(const u32x4*)(A1 + (size_t)row * D + hh * 128 + d0 + c * 8); }
            const float s = MODE == 0 ? -lam : 1.f;
            x[c * 8 + 0] = bflo(a.x) + s * bflo(b2.x); x[c * 8 + 1] = bfhi(a.x) + s * bfhi(b2.x); x[c * 8 + 2] = bflo(a.y) + s * bflo(b2.y); x[c * 8 + 3] = bfhi(a.y) + s * bfhi(b2.y);
            x[c * 8 + 4] = bflo(a.z) + s * bflo(b2.z); x[c * 8 + 5] = bfhi(a.z) + s * bfhi(b2.z); x[c * 8 + 6] = bflo(a.w) + s * bflo(b2.w); x[c * 8 + 7] = bfhi(a.w) + s * bfhi(b2.w);
        }
        float ss = 0.f;
#pragma unroll
        for (int e = 0; e < 16; ++e) ss += x[e] * x[e];
        ss += __shfl_xor(ss, 1); ss += __shfl_xor(ss, 2); ss += __shfl_xor(ss, 4);
        const float r = rsqrtf(ss * (1.f / 128.f) + EPS) * outscale;
#pragma unroll
        for (int c = 0; c < 2; ++c) {
            float y[8];
#pragma unroll
            for (int e = 0; e < 8; ++e) y[e] = x[c * 8 + e] * r * gain[d0 + c * 8 + e];
            if (MODE == 1) { const u32x4 g = *(const u32x4*)(G + (size_t)row * D + hh * 128 + d0 + c * 8);
                y[0] *= silu_f(bflo(g.x)); y[1] *= silu_f(bfhi(g.x)); y[2] *= silu_f(bflo(g.y)); y[3] *= silu_f(bfhi(g.y));
                y[4] *= silu_f(bflo(g.z)); y[5] *= silu_f(bfhi(g.z)); y[6] *= silu_f(bflo(g.w)); y[7] *= silu_f(bfhi(g.w)); }
            u32x4 wv; wv.x = pack2(y[0], y[1]); wv.y = pack2(y[2], y[3]); wv.z = pack2(y[4], y[5]); wv.w = pack2(y[6], y[7]);
            *(u32x4*)(H + (size_t)row * D + hh * 128 + d0 + c * 8) = wv;
        }
    }
}

DI float dpp_x1(float x) { return __int_as_float(__builtin_amdgcn_update_dpp(0, __float_as_int(x), 0xB1, 0xF, 0xF, true)); }
DI float dpp_x2(float x) { return __int_as_float(__builtin_amdgcn_update_dpp(0, __float_as_int(x), 0x4E, 0xF, 0xF, true)); }
DI void hgrn_scan(const Params& p, char* shm) {
    OPAQUE_IDS
    constexpr int TCH = 32;
    const unsigned char* P = p.ws + WS_P;
    const bf16_t* Qh = (const bf16_t*)(P + P_HQ); const bf16_t* V = (const bf16_t*)(P + P_HV);
    float* fL = (float*)shm; float* qL = fL + TCH * 128; float* vL = qL + TCH * 128; float* pL = vL + TCH * 64;
    const int tid = tx, w = tid >> 6, lane = tid & 63, kg = lane & 3, vg = lane >> 2;
    for (int u = bx; u < 256; u += gridDim.x) {
        const int slice = u & 1, dir = (u >> 1) & 1, head = (u >> 2) & 7, b = u >> 5;
        const float* F = (const float*)(P + (dir ? P_HF1 : P_HF0)); bf16_t* Oo = dir ? (bf16_t*)(p.ws + WS_P + P_HOB) : (bf16_t*)(p.ws + WS_H);
        f32x2 s[4][2];
#pragma unroll
        for (int i = 0; i < 4; ++i) { s[i][0] = (f32x2){0.f, 0.f}; s[i][1] = (f32x2){0.f, 0.f}; }
        const int ltok = tid >> 5, lk4 = (tid & 31) * 4, vtok = tid >> 4, lv4 = (tid & 15) * 4;
        f32x4 fr[2]; u32x2 qr[2]; u32x2 vr;
#define HG_ROW(tau) ((size_t)b * LT + (dir == 0 ? (tau) : ((tau) < LC ? (LC - 1 - (tau)) : (LT + LC - 1 - (tau)))))
#define HG_LOAD(ch) do { _Pragma("unroll") for (int i_ = 0; i_ < 2; ++i_) { const size_t row = HG_ROW((ch) * TCH + ltok + 16 * i_); fr[i_] = *(const f32x4*)(F + row * D + head * 128 + lk4); \
            qr[i_] = *(const u32x2*)(Qh + row * D + head * 128 + lk4); } \
            { const size_t row = HG_ROW((ch) * TCH + vtok); vr = *(const u32x2*)(V + row * D + head * 128 + slice * 64 + lv4); } } while (0)
        HG_LOAD(0);
        for (int ch = 0; ch < LT / TCH; ++ch) {
            __syncthreads();
#pragma unroll
            for (int i_ = 0; i_ < 2; ++i_) { *(f32x4*)(fL + (ltok + 16 * i_) * 128 + lk4) = fr[i_];
                *(f32x4*)(qL + (ltok + 16 * i_) * 128 + lk4) = (f32x4){bflo(qr[i_].x), bfhi(qr[i_].x), bflo(qr[i_].y), bfhi(qr[i_].y)}; }
            *(f32x4*)(vL + vtok * 64 + lv4) = (f32x4){bflo(vr.x), bfhi(vr.x), bflo(vr.y), bfhi(vr.y)};
            __syncthreads();
            if (ch + 1 < LT / TCH) HG_LOAD(ch + 1);
#pragma unroll 4
            for (int tok = 0; tok < TCH; ++tok) {
                const f32x4 f4 = *(const f32x4*)(fL + tok * 128 + w * 16 + kg * 4), q4 = *(const f32x4*)(qL + tok * 128 + w * 16 + kg * 4), v4 = *(const f32x4*)(vL + tok * 64 + vg * 4);
                const f32x2 va = (f32x2){v4[0], v4[1]}, vb = (f32x2){v4[2], v4[3]}; f32x2 oa = (f32x2){0.f, 0.f}, ob = (f32x2){0.f, 0.f};
#pragma unroll
                for (int ki = 0; ki < 4; ++ki) { const f32x2 f2 = (f32x2){f4[ki], f4[ki]}, q2 = (f32x2){q4[ki], q4[ki]};
                    f32x2 d = s[ki][0] - va; s[ki][0] = f2 * d + va; oa += s[ki][0] * q2;
                    d = s[ki][1] - vb; s[ki][1] = f2 * d + vb; ob += s[ki][1] * q2; }
                f32x4 o4 = (f32x4){oa[0], oa[1], ob[0], ob[1]};
#pragma unroll
                for (int e = 0; e < 4; ++e) { o4[e] += dpp_x1(o4[e]); o4[e] += dpp_x2(o4[e]); }
                if (kg == 0) *(f32x4*)(pL + (w * TCH + tok) * 64 + vg * 4) = o4;
            }
            __syncthreads();
            { f32x4 a = (f32x4){0.f, 0.f, 0.f, 0.f};
#pragma unroll
              for (int ww = 0; ww < 8; ++ww) a += *(const f32x4*)(pL + (ww * TCH + vtok) * 64 + lv4);
              const size_t row = HG_ROW(ch * TCH + vtok); *(u32x2*)(Oo + row * D + head * 128 + slice * 64 + lv4) = (u32x2){pack2(a[0], a[1]), pack2(a[2], a[3])}; }
        }
#undef HG_LOAD
#undef HG_ROW
    }
    __syncthreads();
}

#define HG_ROW(b, dir, tau) ((size_t)(b) * LT + ((dir) == 0 ? (tau) : ((tau) < LC ? (LC - 1 - (tau)) : (LT + LC - 1 - (tau)))))
#define HG_MINROW(b, dir, c) ((dir) == 0 ? HG_ROW(b, 0, (c) * 16) : HG_ROW(b, 1, (c) * 16 + 15))
DI void hgrn_prep(const Params& p) {
    OPAQUE_IDS
    unsigned char* P = p.ws + WS_P; const bf16_t* Qh = (const bf16_t*)(P + P_HQ); float* EB = (float*)(p.ws + WS_EB);
    const int col2 = tx * 2;
    for (int it = bx; it < 2 * NB * 144; it += gridDim.x) {
        const int dir = it & 1, rem = it >> 1, c = rem % 144, b = rem / 144;
        float* F = (float*)(P + (dir ? P_HF1 : P_HF0));
        f32x2 f2[16]; unsigned q2[16];
#pragma unroll
        for (int t = 0; t < 16; ++t) { const size_t row = HG_ROW(b, dir, c * 16 + t); f2[t] = *(const f32x2*)(F + row * D + col2); q2[t] = *(const unsigned*)(Qh + row * D + col2); }
        unsigned qt[16], k0[8], k1[8]; float run0 = 0.f, run1 = 0.f, ka = 0.f, kb = 0.f;
#pragma unroll
        for (int t = 0; t < 16; ++t) {
            run0 += __logf(f2[t][0]); run1 += __logf(f2[t][1]);
            qt[t] = pack2(bflo(q2[t]) * __expf(run0), bfhi(q2[t]) * __expf(run1));
            const float a = (1.f - f2[t][0]) * __expf(fminf(-run0, 80.f)), bq = (1.f - f2[t][1]) * __expf(fminf(-run1, 80.f));
            if (t & 1) { k0[t >> 1] = pack2(ka, a); k1[t >> 1] = pack2(kb, bq); } else { ka = a; kb = bq; }
        }
        __syncthreads();
        unsigned char* base = (unsigned char*)F + HG_MINROW(b, dir, c) * 4096;
#pragma unroll
        for (int t = 0; t < 16; ++t) *(unsigned*)(base + t * 2048 + col2 * 2) = qt[t];
        *(u32x4*)(base + 32768 + col2 * 32) = (u32x4){k0[0], k0[1], k0[2], k0[3]}; *(u32x4*)(base + 32768 + col2 * 32 + 16) = (u32x4){k0[4], k0[5], k0[6], k0[7]};
        *(u32x4*)(base + 32768 + col2 * 32 + 32) = (u32x4){k1[0], k1[1], k1[2], k1[3]}; *(u32x4*)(base + 32768 + col2 * 32 + 48) = (u32x4){k1[4], k1[5], k1[6], k1[7]};
        *(f32x2*)(EB + ((size_t)(dir * NB + b) * 144 + c) * D + col2) = (f32x2){__expf(run0), __expf(run1)};
        __syncthreads();
    }
}
DI void hgrn_scan_mfma(const Params& p, char* shm) {
    OPAQUE_IDS
    constexpr int C = 32, QS = 272;
    const unsigned char* P = p.ws + WS_P;
    const bf16_t* V = (const bf16_t*)(P + P_HV); const float* EB = (const float*)(p.ws + WS_EB); const bf16_t* Qh = (const bf16_t*)(P + P_HQ);
    char* QtL = shm;
    char* VL = QtL + C * QS;
    char* KtL = VL + C * QS;
    float* eBL = (float*)(KtL + C * QS);
    const int tid = tx, w = tid >> 6, lane = tid & 63, l15 = lane & 15, g = lane >> 4;
    for (int u = bx; u < 128; u += gridDim.x) {
        const int dir = u & 1, head = (u >> 1) & 7, b = u >> 4;
        const unsigned char* Fb = P + (dir ? P_HF1 : P_HF0); bf16_t* Oo = dir ? (bf16_t*)(p.ws + WS_P + P_HOB) : (bf16_t*)(p.ws + WS_H);
        f32x4 S[8];
#pragma unroll
        for (int kt = 0; kt < 8; ++kt) S[kt] = (f32x4){0.f, 0.f, 0.f, 0.f};
        const int lt = tid >> 4, lp = tid & 15;
        u32x4 ra0, ra1, ra2, ra3, ra4, rb0, rb1, rb2, rb3, rb4;
#define HG_LOAD(ch, r0, r1, r2, r3, r4) do { const size_t row_ = HG_ROW(b, dir, (ch) * C + lt); const unsigned char* fr_ = Fb + row_ * 4096; \
            r0 = *(const u32x4*)(Qh + row_ * D + head * 128 + lp * 8); r1 = *(const u32x4*)(fr_ + (head * 128 + lp * 8) * 2); r2 = *(const u32x4*)(V + row_ * D + head * 128 + lp * 8); \
            r3 = *(const u32x4*)(fr_ + (1024 + head * 128 + lp * 8) * 2); \
            if (tid < 32) r4 = *(const u32x4*)(EB + ((size_t)(dir * NB + b) * 72 + (ch)) * D + head * 128 + tid * 4); } while (0)
#define HG_QE(qw, ew) pack2(bflo(qw) * bflo(ew), bfhi(qw) * bfhi(ew))
#define HG_STAGE(ch, r0, r1, r2, r3, r4) do { __syncthreads(); \
            *(u32x4*)(QtL + lt * QS + lp * 16) = (u32x4){HG_QE(r0.x, r1.x), HG_QE(r0.y, r1.y), HG_QE(r0.z, r1.z), HG_QE(r0.w, r1.w)}; *(u32x4*)(VL + lt * QS + lp * 16) = r2; \
            *(u32x4*)(KtL + lt * QS + lp * 16) = r3; if (tid < 32) *(u32x4*)((char*)eBL + tid * 16) = r4; \
            __syncthreads(); \
            if ((ch) + 2 < LT / C) HG_LOAD((ch) + 2, r0, r1, r2, r3, r4); } while (0)
        HG_LOAD(0, ra0, ra1, ra2, ra3, ra4); HG_LOAD(1, rb0, rb1, rb2, rb3, rb4);
        for (int ch2 = 0; ch2 < LT / C; ch2 += 2) {
#pragma unroll
          for (int hh = 0; hh < 2; ++hh) {
            const int ch = ch2 + hh;
            if (hh == 0) HG_STAGE(ch, ra0, ra1, ra2, ra3, ra4); else HG_STAGE(ch, rb0, rb1, rb2, rb3, rb4);
            { const bf16_t* kt16 = (const bf16_t*)KtL; const bf16_t* v16 = (const bf16_t*)VL; const int vcol = w * 16 + l15;
#define HG_U2(arr, r_a, r_b, c_) ((unsigned)(arr)[(r_a) * (QS / 2) + (c_)] | ((unsigned)(arr)[(r_b) * (QS / 2) + (c_)] << 16))
              const bf16x8 vf = __builtin_bit_cast(bf16x8, (u32x4){HG_U2(v16, g * 4 + 0, g * 4 + 1, vcol), HG_U2(v16, g * 4 + 2, g * 4 + 3, vcol), HG_U2(v16, 16 + g * 4 + 0, 16 + g * 4 + 1, vcol), HG_U2(v16, 16 + g * 4 + 2, 16 + g * 4 + 3, vcol)});
              f32x4 sc00 = (f32x4){0.f, 0.f, 0.f, 0.f}, sc01 = sc00, sc11 = sc00, o0 = sc00, o1 = sc00;
#pragma unroll
              for (int kc = 0; kc < 4; ++kc) {
                  const bf16x8 aK0 = *(const bf16x8*)(KtL + l15 * QS + kc * 64 + g * 16), aK1 = *(const bf16x8*)(KtL + (16 + l15) * QS + kc * 64 + g * 16);
                  const bf16x8 bQ0 = *(const bf16x8*)(QtL + l15 * QS + kc * 64 + g * 16), bQ1 = *(const bf16x8*)(QtL + (16 + l15) * QS + kc * 64 + g * 16);
                  sc00 = __builtin_amdgcn_mfma_f32_16x16x32_bf16(aK0, bQ0, sc00, 0, 0, 0);
                  sc01 = __builtin_amdgcn_mfma_f32_16x16x32_bf16(aK0, bQ1, sc01, 0, 0, 0);
                  sc11 = __builtin_amdgcn_mfma_f32_16x16x32_bf16(aK1, bQ1, sc11, 0, 0, 0);
                  const int kp = kc;
                  const u32x2 qa0 = *(const u32x2*)(QtL + l15 * QS + ((2 * kp) * 16 + g * 4) * 2), qb0 = *(const u32x2*)(QtL + l15 * QS + ((2 * kp + 1) * 16 + g * 4) * 2);
                  const u32x2 qa1 = *(const u32x2*)(QtL + (16 + l15) * QS + ((2 * kp) * 16 + g * 4) * 2), qb1 = *(const u32x2*)(QtL + (16 + l15) * QS + ((2 * kp + 1) * 16 + g * 4) * 2);
                  const bf16x8 sw = __builtin_bit_cast(bf16x8, (u32x4){pack2(S[2 * kp][0], S[2 * kp][1]), pack2(S[2 * kp][2], S[2 * kp][3]), pack2(S[2 * kp + 1][0], S[2 * kp + 1][1]), pack2(S[2 * kp + 1][2], S[2 * kp + 1][3])});
                  o0 = __builtin_amdgcn_mfma_f32_16x16x32_bf16(__builtin_bit_cast(bf16x8, (u32x4){qa0.x, qa0.y, qb0.x, qb0.y}), sw, o0, 0, 0, 0);
                  o1 = __builtin_amdgcn_mfma_f32_16x16x32_bf16(__builtin_bit_cast(bf16x8, (u32x4){qa1.x, qa1.y, qb1.x, qb1.y}), sw, o1, 0, 0, 0); }
#pragma unroll
              for (int r = 0; r < 4; ++r) if (g * 4 + r > l15) { sc00[r] = 0.f; sc11[r] = 0.f; }
              o0 = __builtin_amdgcn_mfma_f32_16x16x32_bf16(__builtin_bit_cast(bf16x8, (u32x4){pack2(sc00[0], sc00[1]), pack2(sc00[2], sc00[3]), 0u, 0u}), vf, o0, 0, 0, 0);
              o1 = __builtin_amdgcn_mfma_f32_16x16x32_bf16(__builtin_bit_cast(bf16x8, (u32x4){pack2(sc01[0], sc01[1]), pack2(sc01[2], sc01[3]), pack2(sc11[0], sc11[1]), pack2(sc11[2], sc11[3])}), vf, o1, 0, 0, 0);
#pragma unroll
              for (int r = 0; r < 4; ++r) { const size_t rw0 = HG_ROW(b, dir, ch * C + g * 4 + r), rw1 = HG_ROW(b, dir, ch * C + 16 + g * 4 + r);
                  Oo[rw0 * D + head * 128 + vcol] = (bf16_t)(pack2(o0[r], 0.f) & 0xffffu); Oo[rw1 * D + head * 128 + vcol] = (bf16_t)(pack2(o1[r], 0.f) & 0xffffu); }
#pragma unroll
              for (int kt = 0; kt < 8; ++kt) { const f32x4 dcy = *(const f32x4*)(eBL + kt * 16 + g * 4); const int kcol = kt * 16 + l15;
                  const bf16x8 kl = __builtin_bit_cast(bf16x8, (u32x4){HG_U2(kt16, g * 4 + 0, g * 4 + 1, kcol), HG_U2(kt16, g * 4 + 2, g * 4 + 3, kcol), HG_U2(kt16, 16 + g * 4 + 0, 16 + g * 4 + 1, kcol), HG_U2(kt16, 16 + g * 4 + 2, 16 + g * 4 + 3, kcol)});
                  S[kt] = __builtin_amdgcn_mfma_f32_16x16x32_bf16(kl, vf, S[kt], 0, 0, 0) * dcy; }
#undef HG_U2
            }
          }
        }
#undef HG_STAGE
#undef HG_QE
#undef HG_LOAD
    }
    __syncthreads();
}

#define XB_TMO      128
#define XB_XCNT(j)  (256  + 64 * (j))
#define XB_XSUB(j)  (1280 + 64 * (j))
#define XB_XGEN(j)  (2304 + 64 * (j))
#define XB_TOP      3328
#define XB_TOPGEN   3392
#define XCD_BAR_WORDS 3456
#define XB_SPIN_CAP (1u << 22)
DI unsigned xb_ld(unsigned* p)              { return __hip_atomic_load(p, __ATOMIC_RELAXED, __HIP_MEMORY_SCOPE_AGENT); }
DI unsigned xb_add(unsigned* p, unsigned v) { return __hip_atomic_fetch_add(p, v, __ATOMIC_RELAXED, __HIP_MEMORY_SCOPE_AGENT); }
DI unsigned xb_xcc_id() { return (unsigned)__builtin_amdgcn_s_getreg((3 << 11) | 20) & 0xFu; }
#define XB_SPIN(cond, bar) do { unsigned _sp = 0; while (cond) { __builtin_amdgcn_s_sleep(1); \
    if ((++_sp & 255u) == 0u) { if (xb_ld(&(bar)[XB_TMO])) break; if (_sp > XB_SPIN_CAP) { atomicAdd(&(bar)[XB_TMO], 1u); break; } } } } while (0)
struct XcdBarrier { unsigned* bar; unsigned x; volatile LAS unsigned* st; };
DI XcdBarrier xcd_barrier_post(unsigned* bar, volatile LAS unsigned* st) {
    XcdBarrier b; b.bar = bar; b.x = xb_xcc_id(); b.st = st;
    if (threadIdx.x == 0) (void)xb_add(&bar[XB_XCNT(b.x)], 1u);
    return b;
}
DI void xcd_barrier_complete(unsigned* bar, unsigned x, unsigned& nloc, unsigned& nx) {
    const unsigned G = gridDim.x * gridDim.y * gridDim.z;
    unsigned sum, cnt, mine, sp = 0u;
    for (;;) {
        sum = 0u; cnt = 0u; mine = 0u;
#pragma unroll
        for (unsigned j = 0; j < 16; ++j) { const unsigned c = xb_ld(&bar[XB_XCNT(j)]); sum += c; cnt += (c > 0u) ? 1u : 0u; mine = (j == x) ? c : mine; }
        if (sum == G) break;
        __builtin_amdgcn_s_sleep(1);
        if ((++sp & 255u) == 0u) { if (xb_ld(&bar[XB_TMO])) break; if (sp > XB_SPIN_CAP) { atomicAdd(&bar[XB_TMO], 1u); break; } }
    }
    nloc = mine > 0u ? mine : 1u; nx = cnt > 0u ? cnt : 1u;
}
DI void xcd_barrier(const XcdBarrier& b) {
    asm volatile("s_waitcnt vmcnt(0)" ::: "memory");
    __syncthreads();
    if (threadIdx.x == 0) {
        unsigned* bar = b.bar;
        __builtin_amdgcn_s_waitcnt(0);
        unsigned nloc = b.st[0], nx = b.st[1];
        if (nloc == 0u) { xcd_barrier_complete(bar, b.x, nloc, nx); b.st[0] = nloc; b.st[1] = nx; }
        const unsigned old = xb_add(&bar[XB_XSUB(b.x)], 1u);
        const unsigned gen = old / nloc;
        if (old + 1u == (gen + 1u) * nloc) {
            __builtin_amdgcn_fence(__ATOMIC_RELEASE, "agent");
            asm volatile("s_waitcnt vmcnt(0)" ::: "memory");
            const unsigned og = xb_add(&bar[XB_TOP], 1u);
            const unsigned tg = og / nx;
            if (og + 1u == (tg + 1u) * nx) xb_add(&bar[XB_TOPGEN], 1u);
            else XB_SPIN(xb_ld(&bar[XB_TOPGEN]) == tg, bar);
            __builtin_amdgcn_fence(__ATOMIC_ACQUIRE, "agent");
            xb_add(&bar[XB_XGEN(b.x)], 1u);
            asm volatile("s_waitcnt vmcnt(0)" ::: "memory");
        } else {
            XB_SPIN(xb_ld(&bar[XB_XGEN(b.x)]) == gen, bar);
            __builtin_amdgcn_fence(__ATOMIC_ACQUIRE, "agent");
            asm volatile("s_waitcnt vmcnt(0)" ::: "memory");
        }
    }
    __syncthreads();
}

template <int layer>
DI void layer_body(const Params& p, const XcdBarrier& xb, char* shm) {
    unsigned char* P = p.ws + WS_P;
    bf16_t* H = (bf16_t*)(p.ws + WS_H);
    bf16_t* wfi = (bf16_t*)(p.ws + WS_WFI); bf16_t* wfo = (bf16_t*)(p.ws + WS_WFO); bf16_t* wmi = (bf16_t*)(p.ws + WS_WMI); bf16_t* wmo = (bf16_t*)(p.ws + WS_WMO);
    const float* modall = (const float*)(p.ws + WS_MOD);
    float* ctxres = (float*)(p.ws + WS_CTXRES);
    (void)wmi; (void)H;
        const float* mod = modall + (size_t)layer * 9 * 6144;
        const bool last = layer == 3;
        PH(0) if (layer > 0) convert_layer(p, layer, shm);
        PH(1) norm_phase(p, layer, 0, false, layer > 0 ? (const float*)(P + P_PARTF) : nullptr, 8, layer == 0 ? 1 : 0);
        xcd_barrier(xb);
        if constexpr (layer == 0) {
            { const bf16_t* cdt = (const bf16_t*)(P + P_CDT); bf16_t* gtl = (bf16_t*)(P + P_GTL); bf16_t* gtc = (bf16_t*)(P + P_GTC);
              gemm_loop(NB * 72, 1024, shm,
                  [&](int L) { const int b = L / 72, r2 = L % 72, pm = r2 / 9, pn = r2 % 9, k0 = (pm & 3) * 256; return Tile{cdt + k0, H + (size_t)b * LT * D + k0, 1024, D, 256, pm * 256, pn * 256}; },
                  [&](int L, const AccT& acc, int brow, int bcol, int wr, int wc, int fr, int fq) { EpiFnet1 e{gtl, gtc, L / 72}; e(acc, brow, bcol, wr, wc, fr, fq); }); }
            xcd_barrier(xb);
            { const bf16_t* wl = (const bf16_t*)(P + P_WL); const bf16_t* wc = (const bf16_t*)(P + P_WC); bf16_t* Yb = (bf16_t*)(P + P_YB);
              const bf16_t* gtl = (const bf16_t*)(P + P_GTL); const bf16_t* gtc = (const bf16_t*)(P + P_GTC);
              gemm_loop(NB * 32, 4096, shm,
                  [&](int L) { const int b = L >> 5, pm = (L >> 2) & 7, pn = L & 3; return Tile{wl, gtl + (size_t)b * 1024 * 4096, 4096, 4096, 4096, pm * 256, pn * 256}; },
                  [&](int L, const AccT& acc, int brow, int bcol, int wr, int wc_, int fr, int fq) { EpiBf16 e{Yb + ((size_t)(L >> 5) * LT + LC) * D, (size_t)D}; e(acc, brow, bcol, wr, wc_, fr, fq); });
              gemm_loop(NB * 4, 512, shm,
                  [&](int L) { const int b = L >> 2, pn = L & 3; return Tile{wc, gtc + (size_t)b * 1024 * 512, 512, 512, 512, 0, pn * 256}; },
                  [&](int L, const AccT& acc, int brow, int bcol, int wr, int wc_, int fr, int fq) { EpiBf16 e{Yb + ((size_t)(L >> 2) * LT) * D, (size_t)D}; e(acc, brow, bcol, wr, wc_, fr, fq); }); }
            xcd_barrier(xb);
            gemm_resid<4>((const bf16_t*)(P + P_YB), wmo, D, true, p.out, p.in[0], mod + 2 * 1024, p.in[10], (float*)(P + P_PARTO), shm);
        } else if constexpr (layer == 1) {
            { bf16_t* QK = (bf16_t*)(P + P_DQK); bf16_t* Vt = (bf16_t*)(P + P_DVT); const int n1 = 72 * 8, n2 = NB * 4 * 9;
              gemm_loop(n1 + n2, D, shm,
                  [&](int L) { if (L < n1) { int pm, pn; tile_map(L, 72, 8, pm, pn); return Tile{H, wmi, D, D, D, pm * 256, pn * 256}; }
                               const int v = L - n1, b = v / 36, r2 = v % 36, pm = r2 / 9, pn = r2 % 9; return Tile{wmi + (size_t)2048 * D, H + (size_t)b * LT * D, D, D, D, pm * 256, pn * 256}; },
                  [&](int L, const AccT& acc, int brow, int bcol, int wr, int wc, int fr, int fq) {
                      if (L < n1) { EpiBf16 e{QK, (size_t)2048}; e(acc, brow, bcol, wr, wc, fr, fq); }
                      else { EpiBf16 e{Vt + (size_t)((L - n1) / 36) * 1024 * LT, (size_t)LT}; e(acc, brow, bcol, wr, wc, fr, fq); } }); }
            xcd_barrier(xb);
            PH(2) qknorm_phase<32>((bf16_t*)(P + P_DQK), 2048, p.in[13], 2, (const f32x2*)(p.ws + WS_ROPED));
            xcd_barrier(xb);
            PH(4) attn_phase<64, 0>((const bf16_t*)(P + P_DQK), 2048, (const bf16_t*)(P + P_DVT), 1024, (bf16_t*)(P + P_DO2), 2048, 16, false, p.in[12], (const f32x2*)(p.ws + WS_ROPED), 0.125f * 1.4426950408889634f, shm);
            xcd_barrier(xb);
            { const float* lp = p.in[14]; float s01 = 0.f, s23 = 0.f;
              for (int e = 0; e < 64; ++e) { s01 += lp[e] * lp[64 + e]; s23 += lp[128 + e] * lp[192 + e]; }
              const float lam_init = 0.8f - 0.6f * expf(-0.3f * 1.f); const float lam = expf(s01) - expf(s23) + lam_init;
              PH(1) headnorm_phase<0>(p, (const bf16_t*)(P + P_DO2), nullptr, nullptr, p.in[15], lam, 1.f - lam_init); }
            xcd_barrier(xb);
            gemm_resid<4>(H, wmo, D, true, p.out, p.out, mod + 2 * 1024, nullptr, (float*)(P + P_PARTO), shm);
        } else if constexpr (layer == 2) {
            { EpiHgrn e{P, (const float*)(p.ws + WS_LBV), p.ws + WS_EB}; gemm_phase(H, D, wmi, D, 5 * D, D, false, shm, e); }
            xcd_barrier(xb);
            PH(6) hgrn_scan_mfma(p, shm);
            xcd_barrier(xb);
            PH(1) headnorm_phase<1>(p, H, (const bf16_t*)(P + P_HOB), (const bf16_t*)(P + P_HG), p.in[19], 0.f, 1.f);
            xcd_barrier(xb);
            gemm_resid<4>(H, wmo, D, true, p.out, p.out, mod + 2 * 1024, nullptr, (float*)(P + P_PARTO), shm);
        } else {
            { bf16_t* QK = (bf16_t*)(P + P_GQK); bf16_t* Vt = (bf16_t*)(P + P_GVT); const int n1 = 72 * 5, n2 = NB * 9;
              gemm_loop(n1 + n2, D, shm,
                  [&](int L) { if (L < n1) { int pm, pn; tile_map(L, 72, 5, pm, pn); return Tile{H, wmi, D, D, D, pm * 256, pn * 256}; }
                               const int v = L - n1, b = v / 9, pn = v % 9; return Tile{wmi + (size_t)1280 * D, H + (size_t)b * LT * D, D, D, D, 0, pn * 256}; },
                  [&](int L, const AccT& acc, int brow, int bcol, int wr, int wc, int fr, int fq) {
                      if (L < n1) { EpiBf16 e{QK, (size_t)1280}; e(acc, brow, bcol, wr, wc, fr, fq); }
                      else { EpiBf16 e{Vt + (size_t)((L - n1) / 9) * 256 * LT, (size_t)LT}; e(acc, brow, bcol, wr, wc, fr, fq); } }); }
            xcd_barrier(xb);
            PH(3) qknorm_phase<64>((bf16_t*)(P + P_GQK), 1280, p.in[23], 0, (const f32x2*)(p.ws + WS_ROPEG));
            xcd_barrier(xb);
            PH(5) attn_phase<128, 1>((const bf16_t*)(P + P_GQK), 1280, (const bf16_t*)(P + P_GVT), 256, H, D, 8, true, p.in[22], (const f32x2*)(p.ws + WS_ROPEG), 0.08838834764831845f * 1.4426950408889634f, shm);
            xcd_barrier(xb);
            gemm_resid<4>(H, wmo, D, false, p.out, p.out, mod + 2 * 1024, nullptr, (float*)(P + P_PARTO), shm);
        }
        xcd_barrier(xb);
        PH(1) norm_phase(p, layer, 1, last, last ? nullptr : (const float*)(P + P_PARTO), 4, layer == 0 ? 2 : 0);
        xcd_barrier(xb);
        { EpiSwiglu e{(bf16_t*)(P + P_ACT)}; gemm_phase(H, D, wfi, D, 2 * DFF, D, last, shm, e); }
        xcd_barrier(xb);
        gemm_resid<8>((const bf16_t*)(P + P_ACT), wfo, DFF, !last, p.out, p.out, mod + 5 * 1024, nullptr, (float*)(P + P_PARTF), shm);
        if constexpr (layer < 3) xcd_barrier(xb);
    }

__global__ void __launch_bounds__(NTHR) fwd_megakernel(Params p) {
    extern __shared__ __attribute__((aligned(16))) char shm[];
    cg::grid_group grid = cg::this_grid();
    if (threadIdx.x < 4) ((unsigned*)(shm + 131072))[threadIdx.x] = 0u;
    __syncthreads();
    const XcdBarrier xb = xcd_barrier_post((unsigned*)(p.ws + WS_BAR), (volatile LAS unsigned*)(shm + 131072));
    PH(0) prologue(p, shm);
    if (p.ws == nullptr) grid.sync();
    xcd_barrier(xb);
    PH(0) mod_reduce(p);
    xcd_barrier(xb);
    layer_body<0>(p, xb, shm);
    layer_body<1>(p, xb, shm);
    layer_body<2>(p, xb, shm);
    layer_body<3>(p, xb, shm);
}

extern "C" void kernel_launch(void* const* d_in, const int* in_sizes, int n_in, void* d_out, int out_size, void* d_ws, size_t ws_size, hipStream_t stream) {
    static int grid_blocks = 0;
    if (grid_blocks == 0) {
        if (n_in != 25 || ws_size < WS_END) { fprintf(stderr, "kernel_launch: need 25 inputs and %zu bytes of workspace (got %d, %zu)\n", (size_t)WS_END, n_in, ws_size); grid_blocks = -1; return; }
        int dev = 0, cus = 0, per_cu = 0;
        hipGetDevice(&dev);
        hipDeviceGetAttribute(&cus, hipDeviceAttributeMultiprocessorCount, dev);
        if (hipFuncSetAttribute((const void*)fwd_megakernel, hipFuncAttributeMaxDynamicSharedMemorySize, LDS_BYTES) != hipSuccess) { fprintf(stderr, "kernel_launch: hipFuncSetAttribute failed\n"); grid_blocks = -1; return; }
        if (hipOccupancyMaxActiveBlocksPerMultiprocessor(&per_cu, (const void*)fwd_megakernel, NTHR, LDS_BYTES) != hipSuccess || per_cu < 1) { fprintf(stderr, "kernel_launch: occupancy query says %d blocks/CU\n", per_cu); grid_blocks = -1; return; }
        grid_blocks = cus;
    }
    if (grid_blocks < 0) return;
    if (hipMemsetAsync((char*)d_ws + WS_BAR, 0, 16384, stream) != hipSuccess) { fprintf(stderr, "kernel_launch: memset of barrier words failed\n"); return; }
    Params p{};
    for (int i = 0; i < 25; ++i) p.in[i] = (const float*)d_in[i];
    p.out = (float*)d_out; p.ws = (unsigned char*)d_ws;
    void* args[] = {&p};
    hipError_t e = hipLaunchCooperativeKernel((const void*)fwd_megakernel, dim3(grid_blocks), dim3(NTHR), args, LDS_BYTES, stream);
    if (e != hipSuccess) fprintf(stderr, "cooperative launch failed: %s (grid %d)\n", hipGetErrorString(e), grid_blocks);
}
```
